# Optimizing an MI355X kernel written in HIP

```python
import math
import jax, jax.numpy as jnp
from jax import lax
import numpy as np

D_MODEL = 1024
BATCH = 32
SEQ = 2048
DEPTH = 1

N_META = 16
HG_HEADS = 4
HG_HEAD_DIM = 128
D_HG = HG_HEADS * HG_HEAD_DIM
HG_CHUNK = 64
D_LRU = D_MODEL
LRU_BLOCKS = 8
LRU_BLOCK = D_LRU // LRU_BLOCKS
CONV_WIDTH = 4
LRU_C = 8.0
N_GROUPS = 4
EXPERTS_PER_GROUP = 8
N_EXPERTS = N_GROUPS * EXPERTS_PER_GROUP
TOP_K = 2
D_EXPERT = 512
MOE_BLOCK = 512
EPS = 1e-6
SPLIT_SIZES = (D_HG, D_HG, D_HG, D_HG, D_LRU, D_LRU, D_MODEL, D_MODEL)
D_IN = sum(SPLIT_SIZES)

kernel_name = "hybrid_hgrn2_rglru_hmoe_block"


def rmsnorm(x, g):
    xf = x.astype(jnp.float32)
    y = xf * lax.rsqrt(jnp.mean(xf * xf, axis=-1, keepdims=True) + EPS)
    return (y * g.astype(jnp.float32)).astype(x.dtype)


def hgrn2_chunked(q, k, v, log_f):
    B, T, H, DK = q.shape
    DV = v.shape[-1]
    C = HG_CHUNK
    NC = T // C

    def to_chunks(a):
        return a.reshape(B, NC, C, H, a.shape[-1]).transpose(1, 0, 3, 2, 4)

    qc, kc, vc, gc = to_chunks(q), to_chunks(k), to_chunks(v), to_chunks(log_f)
    causal = jnp.tril(jnp.ones((C, C), dtype=bool))[:, :, None]

    def step(S, inp):
        qb, kb, vb, gb = inp
        G = jnp.cumsum(gb, axis=2)
        diff = G[:, :, :, None, :] - G[:, :, None, :, :]
        decay = jnp.exp(jnp.where(causal, diff, -jnp.inf))
        scores = jnp.einsum('bhtd,bhsd,bhtsd->bhts', qb, kb, decay)
        o = (jnp.einsum('bhts,bhsv->bhtv', scores, vb)
             + jnp.einsum('bhtd,bhdv->bhtv', qb * jnp.exp(G), S))
        G_end = G[:, :, -1:, :]
        S_new = (jnp.exp(G_end[:, :, 0, :])[..., None] * S
                 + jnp.einsum('bhsd,bhsv->bhdv', kb * jnp.exp(G_end - G), vb))
        return S_new, o

    S0 = jnp.zeros((B, H, DK, DV), jnp.float32)
    _, o = lax.scan(step, S0, (qc, kc, vc, gc))
    return o.transpose(1, 0, 3, 2, 4).reshape(B, T, H, DV)


def hgrn2_branch(q_pre, f_pre, i_pre, og_pre, lb, norm_g):
    B, T, _ = q_pre.shape
    f32 = jnp.float32
    lb = lb.astype(f32)
    fp = f_pre.astype(f32)
    f = lb + (1.0 - lb) * jax.nn.sigmoid(fp)
    log_f = jnp.log(f)
    k = (1.0 - lb) * jax.nn.sigmoid(-fp)
    pad = (-N_META) % HG_CHUNK

    def prep(a):
        a = jnp.pad(a.astype(f32), ((0, 0), (pad, 0), (0, 0)))
        return a.reshape(B, T + pad, HG_HEADS, HG_HEAD_DIM)

    o = hgrn2_chunked(prep(q_pre), prep(k), prep(i_pre), prep(log_f))[:, pad:]
    o = o * lax.rsqrt(jnp.mean(o * o, axis=-1, keepdims=True) + EPS)
    o = o * norm_g.astype(f32).reshape(HG_HEADS, HG_HEAD_DIM)
    o = o.reshape(B, T, D_HG) * jax.nn.sigmoid(og_pre.astype(f32))
    return o.astype(q_pre.dtype)


def rglru_branch(xb, yb, conv_w, conv_b, w_r, b_r, w_i, b_i, lam):
    B, T, _ = xb.shape
    f32 = jnp.float32
    xc = lax.conv_general_dilated(
        xb, conv_w[:, None, :].astype(xb.dtype), window_strides=(1,),
        padding=[(CONV_WIDTH - 1, 0)], dimension_numbers=('NWC', 'WIO', 'NWC'),
        feature_group_count=D_LRU) + conv_b.astype(xb.dtype)
    xh = xc.reshape(B, T, LRU_BLOCKS, LRU_BLOCK)
    r = jax.nn.sigmoid(jnp.einsum('btni,nij->btnj', xh, w_r).reshape(B, T, D_LRU).astype(f32)
                       + b_r.astype(f32))
    i = jax.nn.sigmoid(jnp.einsum('btni,nij->btnj', xh, w_i).reshape(B, T, D_LRU).astype(f32)
                       + b_i.astype(f32))
    log_a = -LRU_C * r * jax.nn.softplus(-lam.astype(f32))
    a = jnp.exp(log_a)
    u = jnp.sqrt(-jnp.expm1(2.0 * log_a)) * (i * xc.astype(f32))

    def combine(left, right):
        a_l, b_l = left
        a_r, b_r2 = right
        return a_l * a_r, a_r * b_l + b_r2

    _, h = lax.associative_scan(combine, (a, u), axis=1)
    return (h * jax.nn.gelu(yb.astype(f32))).astype(xb.dtype)


def hier_moe(h, w_group, b_group, w_router, b_router, w_gate, w_up, w_down):
    B, T, D = h.shape
    N = B * T
    f32 = jnp.float32
    hf = h.reshape(N, D)
    group_logits = (hf @ w_group).astype(f32) + b_group.astype(f32)
    p_group = jax.nn.softmax(group_logits, axis=-1)
    g_sel = jnp.argmax(group_logits, axis=-1).astype(jnp.int32)
    p_sel = jnp.take_along_axis(p_group, g_sel[:, None], axis=-1)
    exp_logits = jnp.einsum('nd,gde->nge', hf, w_router).astype(f32) + b_router.astype(f32)
    sel_logits = jnp.take_along_axis(exp_logits, g_sel[:, None, None], axis=1)[:, 0]
    top_vals, top_idx = lax.top_k(sel_logits, TOP_K)
    weights = p_sel * jax.nn.softmax(top_vals, axis=-1)
    expert_ids = g_sel[:, None] * EXPERTS_PER_GROUP + top_idx.astype(jnp.int32)

    A = N * TOP_K
    e_flat = expert_ids.reshape(A)
    w_flat = weights.reshape(A)
    tok_flat = jnp.arange(A, dtype=jnp.int32) // TOP_K
    order = jnp.argsort(e_flat)
    e_sorted = e_flat[order]
    counts = jnp.zeros((N_EXPERTS,), jnp.int32).at[e_flat].add(1)
    starts = jnp.cumsum(counts) - counts
    pcounts = (counts + MOE_BLOCK - 1) // MOE_BLOCK * MOE_BLOCK
    pends = jnp.cumsum(pcounts)
    pstarts = pends - pcounts
    dest = pstarts[e_sorted] + (jnp.arange(A, dtype=jnp.int32) - starts[e_sorted])
    n_blocks = -(-A // MOE_BLOCK) + N_EXPERTS
    n_slots = n_blocks * MOE_BLOCK
    slot_tok = jnp.zeros((n_slots,), jnp.int32).at[dest].set(tok_flat[order])
    slot_w = jnp.zeros((n_slots,), f32).at[dest].set(w_flat[order])
    block_start = jnp.arange(n_blocks, dtype=jnp.int32) * MOE_BLOCK
    block_expert = jnp.minimum(jnp.searchsorted(pends, block_start, side='right'),
                               N_EXPERTS - 1).astype(jnp.int32)

    def run_block(args):
        toks, wts, e = args
        xb = hf[toks]
        y = (jax.nn.silu(xb @ w_gate[e]) * (xb @ w_up[e])) @ w_down[e]
        return y * wts[:, None].astype(y.dtype)

    ys = lax.map(run_block, (slot_tok.reshape(n_blocks, MOE_BLOCK),
                             slot_w.reshape(n_blocks, MOE_BLOCK), block_expert))
    out = jnp.zeros((N, D), h.dtype).at[slot_tok].add(ys.reshape(n_slots, D).astype(h.dtype))
    return out.reshape(B, T, D)


def mixer(hn, w_in, lb, hg_norm_g, conv_w, conv_b, w_r, b_r, w_i, b_i, lam, w_up_a, w_up_b, w_out):
    proj = hn @ w_in
    idx = [int(c) for c in np.cumsum(SPLIT_SIZES)[:-1]]
    q_pre, f_pre, i_pre, og_pre, lx, ly, ga, gb = jnp.split(proj, idx, axis=-1)
    o_a = hgrn2_branch(q_pre, f_pre, i_pre, og_pre, lb, hg_norm_g)
    o_b = rglru_branch(lx, ly, conv_w, conv_b, w_r, b_r, w_i, b_i, lam)
    merged = jax.nn.sigmoid(ga) * (o_a @ w_up_a) + jax.nn.sigmoid(gb) * (o_b @ w_up_b)
    return merged @ w_out


def setup_inputs(seed: int = 0) -> dict:
    key = jax.random.key(seed)
    ks = jax.random.split(key, 26)
    f32 = jnp.float32
    nrm = lambda k, shape, scale: jax.random.normal(k, shape, f32) * scale
    u = jax.random.uniform(ks[13], (DEPTH, D_LRU), f32, minval=0.9, maxval=0.999)
    a0 = u ** (1.0 / LRU_C)
    return {
        "x": nrm(ks[0], (BATCH, SEQ, D_MODEL), 1.0),
        "meta_tokens": nrm(ks[1], (N_META, D_MODEL), 1.0),
        "norm1_g": 1.0 + nrm(ks[2], (DEPTH, D_MODEL), 0.02),
        "w_in": nrm(ks[3], (DEPTH, D_MODEL, D_IN), D_MODEL ** -0.5),
        "hg_lower_bounds": nrm(ks[4], (DEPTH + 1, D_HG), 0.1),
        "hg_norm_g": 1.0 + nrm(ks[5], (DEPTH, D_HG), 0.02),
        "conv_w": nrm(ks[6], (DEPTH, CONV_WIDTH, D_LRU), CONV_WIDTH ** -0.5),
        "conv_b": nrm(ks[7], (DEPTH, D_LRU), 0.01),
        "lru_w_r": nrm(ks[8], (DEPTH, LRU_BLOCKS, LRU_BLOCK, LRU_BLOCK), LRU_BLOCK ** -0.5),
        "lru_b_r": nrm(ks[9], (DEPTH, D_LRU), 0.01),
        "lru_w_i": nrm(ks[10], (DEPTH, LRU_BLOCKS, LRU_BLOCK, LRU_BLOCK), LRU_BLOCK ** -0.5),
        "lru_b_i": nrm(ks[11], (DEPTH, D_LRU), 0.01),
        "lru_lambda": jnp.log(a0) - jnp.log1p(-a0),
        "w_up_a": nrm(ks[14], (DEPTH, D_HG, D_MODEL), D_HG ** -0.5),
        "w_up_b": nrm(ks[15], (DEPTH, D_LRU, D_MODEL), D_LRU ** -0.5),
        "w_out": nrm(ks[16], (DEPTH, D_MODEL, D_MODEL), D_MODEL ** -0.5),
        "norm2_g": 1.0 + nrm(ks[17], (DEPTH, D_MODEL), 0.02),
        "w_group": nrm(ks[18], (DEPTH, D_MODEL, N_GROUPS), D_MODEL ** -0.5),
        "b_group": nrm(ks[19], (DEPTH, N_GROUPS), 0.01),
        "w_router": nrm(ks[20], (DEPTH, N_GROUPS, D_MODEL, EXPERTS_PER_GROUP), D_MODEL ** -0.5),
        "b_router": nrm(ks[21], (DEPTH, N_GROUPS, EXPERTS_PER_GROUP), 0.01),
        "w_gate": nrm(ks[22], (DEPTH, N_EXPERTS, D_MODEL, D_EXPERT), D_MODEL ** -0.5),
        "w_up": nrm(ks[23], (DEPTH, N_EXPERTS, D_MODEL, D_EXPERT), D_MODEL ** -0.5),
        "w_down": nrm(ks[24], (DEPTH, N_EXPERTS, D_EXPERT, D_MODEL), D_EXPERT ** -0.5),
        "final_g": 1.0 + nrm(ks[25], (D_MODEL,), 0.02),
    }


def reference(x, meta_tokens, norm1_g, w_in, hg_lower_bounds, hg_norm_g, conv_w, conv_b,
              lru_w_r, lru_b_r, lru_w_i, lru_b_i, lru_lambda, w_up_a, w_up_b, w_out,
              norm2_g, w_group, b_group, w_router, b_router, w_gate, w_up, w_down, final_g):
    B = x.shape[0]
    meta = jnp.broadcast_to(meta_tokens[None].astype(x.dtype), (B, N_META, D_MODEL))
    h = jnp.concatenate([meta, x], axis=1)
    lbs = jnp.cumsum(jax.nn.softmax(hg_lower_bounds.astype(jnp.float32), axis=0), axis=0)
    for l in range(DEPTH):
        mix = mixer(rmsnorm(h, norm1_g[l]), w_in[l], lbs[l], hg_norm_g[l], conv_w[l], conv_b[l],
                    lru_w_r[l], lru_b_r[l], lru_w_i[l], lru_b_i[l], lru_lambda[l],
                    w_up_a[l], w_up_b[l], w_out[l])
        h = h + mix.astype(h.dtype)
        ffn = hier_moe(rmsnorm(h, norm2_g[l]), w_group[l], b_group[l], w_router[l], b_router[l],
                       w_gate[l], w_up[l], w_down[l])
        h = h + ffn.astype(h.dtype)
    return rmsnorm(h, final_g)[:, N_META:]
```

```cpp
#include <hip/hip_runtime.h>
#include <cstdio>
#include <cstdint>

#ifndef NLAUNCH
#define NLAUNCH 9
#endif

#define LAS __attribute__((address_space(3)))
typedef unsigned short bf16_t;
typedef short bf16x8 __attribute__((ext_vector_type(8)));
typedef float f32x4 __attribute__((ext_vector_type(4)));
typedef float f32x2 __attribute__((ext_vector_type(2)));
typedef unsigned u32x4 __attribute__((ext_vector_type(4)));
typedef unsigned u32x2 __attribute__((ext_vector_type(2)));

namespace {
constexpr int NB = 32, SEQ = 2048, NMETA = 16, D = 1024, NTOK = NB * SEQ;
constexpr int TSEQ = SEQ + NMETA;
constexpr int DIN = 6144, DHG = 512, NE = 32, DE = 512;
constexpr int C_Q = 0, C_F = 512, C_I = 1024, C_OG = 1536, C_LX = 2048, C_LY = 3072, C_GA = 4096, C_GB = 5120;
constexpr int KUP = 1536;
constexpr float EPS = 1e-6f;
constexpr int NTHREADS = 512;
constexpr int LDS_BYTES = 144 * 1024;
constexpr int ACT_ROWS = 139264;
constexpr int LCAP = 65536;

constexpr size_t MiB = 1024ull * 1024ull;
constexpr size_t WS_PROJ = 0;
constexpr size_t WS_H2   = 0;
constexpr size_t WS_Y    = 128 * MiB;
constexpr size_t WS_ACT  = 384 * MiB;
constexpr size_t WS_LTK  = 520 * MiB;
constexpr size_t WS_LW   = 528 * MiB;
constexpr size_t WS_HN   = 768 * MiB;
constexpr size_t WS_W    = 896 * MiB;
constexpr size_t WS_WIN  = WS_W;
constexpr size_t WS_WUP  = WS_WIN + (size_t)DIN * D * 2;
constexpr size_t WS_WOUT = WS_WUP + (size_t)D * KUP * 2;
constexpr size_t WS_WGU  = WS_WOUT + (size_t)D * D * 2;
constexpr size_t WS_WD   = WS_WGU + (size_t)NE * 1024 * D * 2;
constexpr size_t WS_WR   = WS_WD + (size_t)NE * D * DE * 2;
constexpr size_t WS_CTL  = WS_WR + 128 * 1024;
constexpr size_t CTL_BAR = 0, CTL_CNT = 16384;
constexpr size_t CTL_ZERO_BYTES = 16384 + 256;
constexpr size_t WS_SSQ  = WS_CTL + 32768;
constexpr size_t WS_PROJM = WS_SSQ + (size_t)NTOK * 4;
constexpr size_t WS_LB   = WS_PROJM + (size_t)NMETA * DIN * 4;
constexpr size_t WS_END  = WS_LB + 4096;

struct Params {
    const float *x, *meta, *norm1_g, *w_in, *hg_lb, *hg_norm_g, *conv_w, *conv_b, *w_r, *b_r, *w_i, *b_i, *lam, *w_up_a, *w_up_b, *w_out,
                *norm2_g, *w_group, *b_group, *w_router, *b_router, *w_gate, *w_up, *w_down, *final_g;
    float* out; unsigned char* ws;
    int ph_lo, ph_hi;
};

__device__ __forceinline__ float bf2f(bf16_t b) { return __uint_as_float(((unsigned)b) << 16); }
__device__ __forceinline__ unsigned cvt_pk_bf16(float lo, float hi) { unsigned r; asm volatile("v_cvt_pk_bf16_f32 %0, %1, %2" : "=v"(r) : "v"(lo), "v"(hi)); return r; }
__device__ __forceinline__ bf16_t f2bf(float f) { return (bf16_t)(cvt_pk_bf16(f, 0.f) & 0xffffu); }
__device__ __forceinline__ float sigmoidf_(float x) { return 1.0f / (1.0f + __expf(-x)); }
__device__ __forceinline__ float gelu_tanh(float y) { const float z = 0.7978845608028654f * (y + 0.044715f * y * y * y); const float t = 1.0f - 2.0f / (1.0f + __expf(2.0f * z)); return 0.5f * y * (1.0f + t); }
__device__ __forceinline__ float wave_sum(float v) {
#pragma unroll
    for (int o = 32; o > 0; o >>= 1) v += __shfl_xor(v, o);
    return v;
}
__device__ __forceinline__ int perm32(int rho) { const int n = rho >> 4, i = rho & 15; return 8 * (i >> 2) + 4 * n + (i & 3); }

struct Unit { const char* A; const char* B; int pm, pn, e, cnt; };

struct DenseOrder {
    const char* A; const char* B; int nN, nunits, G, c; size_t a_tile, b_tile;
    __device__ void init(const void* A_, size_t lda_b, const void* B_, size_t ldb_b, int M, int N, int G_, int c_) {
        A = (const char*)A_; B = (const char*)B_; nN = N / 256; nunits = (M / 256) * nN; G = G_; c = c_; a_tile = 256 * lda_b; b_tile = 256 * ldb_b; }
    __device__ __forceinline__ bool next(int i, Unit& u) const {
        const int L = i * G + c; if (L >= nunits) return false;
        u.pm = L / nN; u.pn = L % nN; u.e = 0; u.cnt = 256; u.A = A + (size_t)u.pm * a_tile; u.B = B + (size_t)u.pn * b_tile; return true; }
    __device__ __forceinline__ unsigned row_off(const Unit&, int) const { return 0u; }
};

struct MoeOrder {
    const char* A; const char* B; const int* ltk; const volatile LAS int* tpre; int nN, nunits, G, c; size_t b_exp, b_tile, a_row; bool gather;
    __device__ __forceinline__ bool next(int i, Unit& u) const {
        const int L = i * G + c; if (L >= nunits) return false;
        const int tile = L / nN; u.pn = L % nN;
        int e = 0;
#pragma unroll 1
        while (e < NE - 1 && tile >= tpre[e + 1]) ++e;
        u.e = e; u.pm = tile - tpre[e]; u.cnt = tpre[40 + e] - u.pm * 256;
        u.B = B + (size_t)e * b_exp + (size_t)u.pn * b_tile;
        u.A = gather ? A : A + (size_t)tile * 256 * a_row; return true; }
    __device__ __forceinline__ unsigned row_off(const Unit& u, int r) const {
        const int idx = u.pm * 256 + r; const int tk = (r < u.cnt) ? ltk[(size_t)u.e * LCAP + idx] : 0; return (unsigned)(tk >> 1) * (unsigned)a_row; }
};

template <class Epi, class Sched, bool GATHER, int KMID>
__device__ __forceinline__ void gemm_simple(unsigned lda_b, unsigned ldb_b, int K, const Sched& S, const Epi& E) {
    const int tid = threadIdx.x, wid = tid >> 6, lane = tid & 63, wr = wid >> 2, wc = wid & 3, fr = lane & 15, fq = lane >> 4;
    for (int i = 0;; ++i) {
        Unit u; if (!S.next(i, u)) break;
        f32x4 acc[2][2][4][2];
#pragma unroll
        for (int a = 0; a < 2; ++a)
#pragma unroll
            for (int b = 0; b < 2; ++b)
#pragma unroll
                for (int m = 0; m < 4; ++m)
#pragma unroll
                    for (int n = 0; n < 2; ++n) acc[a][b][m][n] = (f32x4){0.f, 0.f, 0.f, 0.f};
        unsigned aoff[2][4], boff[2][2];
#pragma unroll
        for (int a = 0; a < 2; ++a)
#pragma unroll
            for (int m = 0; m < 4; ++m) { const int r = 128 * a + 64 * wr + 16 * m + fr; aoff[a][m] = (GATHER ? S.row_off(u, r) : (unsigned)r * lda_b) + fq * 16; }
#pragma unroll
        for (int b = 0; b < 2; ++b)
#pragma unroll
            for (int n = 0; n < 2; ++n) { const int wrow = 128 * b + 32 * wc + perm32(16 * n + fr); boff[b][n] = (unsigned)wrow * ldb_b + fq * 16; }
#define GS_KLOOP(k0, k1) _Pragma("unroll 1") for (int k = (k0); k < (k1); k += 32) { \
            bf16x8 av[2][4], bv[2][2]; \
            _Pragma("unroll") for (int a = 0; a < 2; ++a) _Pragma("unroll") for (int m = 0; m < 4; ++m) av[a][m] = *(const bf16x8*)(u.A + aoff[a][m] + k * 2); \
            _Pragma("unroll") for (int b = 0; b < 2; ++b) _Pragma("unroll") for (int n = 0; n < 2; ++n) bv[b][n] = *(const bf16x8*)(u.B + boff[b][n] + k * 2); \
            _Pragma("unroll") for (int a = 0; a < 2; ++a) _Pragma("unroll") for (int b = 0; b < 2; ++b) _Pragma("unroll") for (int m = 0; m < 4; ++m) _Pragma("unroll") for (int n = 0; n < 2; ++n) \
                acc[a][b][m][n] = __builtin_amdgcn_mfma_f32_16x16x32_bf16(bv[b][n], av[a][m], acc[a][b][m][n], 0, 0, 0); }
        if (KMID > 0) { GS_KLOOP(0, KMID) E.mid(acc, u, wr, wc, fr, fq); GS_KLOOP(KMID, K) } else { GS_KLOOP(0, K) }
#undef GS_KLOOP
        E(acc, u, wr, wc, fr, fq);
    }
}

struct EpiStoreBf16 {
    bf16_t* O; int ldc;
    __device__ __forceinline__ void mid(f32x4 (&)[2][2][4][2], const Unit&, int, int, int, int) const {}
    __device__ __forceinline__ void operator()(const f32x4 (&acc)[2][2][4][2], const Unit& u, int wr, int wc, int fr, int fq) const {
        const int row0 = u.pm * 256 + wr * 64 + fr, col0 = u.pn * 256 + wc * 32 + 8 * fq;
#pragma unroll
        for (int ai = 0; ai < 2; ++ai)
#pragma unroll
            for (int m = 0; m < 4; ++m) { bf16_t* rowp = O + (size_t)(row0 + ai * 128 + m * 16) * ldc + col0;
#pragma unroll
                for (int bj = 0; bj < 2; ++bj) { const f32x4 v0 = acc[ai][bj][m][0], v1 = acc[ai][bj][m][1];
                    u32x4 w; w.x = cvt_pk_bf16(v0[0], v0[1]); w.y = cvt_pk_bf16(v0[2], v0[3]); w.z = cvt_pk_bf16(v1[0], v1[1]); w.w = cvt_pk_bf16(v1[2], v1[3]);
                    *(u32x4*)(rowp + bj * 128) = w; } }
    }
};

__device__ __forceinline__ void unpack8(const u32x4 w, float (&f)[8]) {
    f[0] = __uint_as_float(w.x << 16); f[1] = __uint_as_float(w.x & 0xffff0000u); f[2] = __uint_as_float(w.y << 16); f[3] = __uint_as_float(w.y & 0xffff0000u);
    f[4] = __uint_as_float(w.z << 16); f[5] = __uint_as_float(w.z & 0xffff0000u); f[6] = __uint_as_float(w.w << 16); f[7] = __uint_as_float(w.w & 0xffff0000u);
}

struct EpiMerge {
    bf16_t* O; const bf16_t* proj;
    __device__ __forceinline__ void mid(f32x4 (&acc)[2][2][4][2], const Unit& u, int wr, int wc, int fr, int fq) const {
        const int row0 = u.pm * 256 + wr * 64 + fr, col0 = u.pn * 256 + wc * 32 + 8 * fq;
#pragma unroll
        for (int ai = 0; ai < 2; ++ai)
#pragma unroll
            for (int m = 0; m < 4; ++m) { int rr = row0 + ai * 128 + m * 16; asm volatile("" : "+v"(rr)); const bf16_t* rowp = proj + (size_t)rr * DIN + col0;
#pragma unroll
                for (int bj = 0; bj < 2; ++bj) { float ga[8], gb[8]; unpack8(*(const u32x4*)(rowp + C_GA + bj * 128), ga); unpack8(*(const u32x4*)(rowp + C_GB + bj * 128), gb);
#pragma unroll
                    for (int j = 0; j < 8; ++j) { const float ratio = (1.0f + __expf(-gb[j])) / (1.0f + __expf(-ga[j])); acc[ai][bj][m][j >> 2][j & 3] *= ratio; } }
                asm volatile("" ::: "memory"); }
    }
    __device__ __forceinline__ void operator()(const f32x4 (&acc)[2][2][4][2], const Unit& u, int wr, int wc, int fr, int fq) const {
        const int row0 = u.pm * 256 + wr * 64 + fr, col0 = u.pn * 256 + wc * 32 + 8 * fq;
#pragma unroll
        for (int ai = 0; ai < 2; ++ai)
#pragma unroll
            for (int m = 0; m < 4; ++m) { int rr = row0 + ai * 128 + m * 16; asm volatile("" : "+v"(rr)); const size_t r = (size_t)rr;
#pragma unroll
                for (int bj = 0; bj < 2; ++bj) { float gb[8], v[8]; unpack8(*(const u32x4*)(proj + r * DIN + col0 + C_GB + bj * 128), gb);
#pragma unroll
                    for (int j = 0; j < 8; ++j) v[j] = acc[ai][bj][m][j >> 2][j & 3] * sigmoidf_(gb[j]);
                    u32x4 w; w.x = cvt_pk_bf16(v[0], v[1]); w.y = cvt_pk_bf16(v[2], v[3]); w.z = cvt_pk_bf16(v[4], v[5]); w.w = cvt_pk_bf16(v[6], v[7]);
                    *(u32x4*)(O + r * D + col0 + bj * 128) = w; }
                asm volatile("" ::: "memory"); }
    }
};

struct EpiResid {
    bf16_t* O; const float* x; float* ssq;
    __device__ __forceinline__ void mid(f32x4 (&)[2][2][4][2], const Unit&, int, int, int, int) const {}
    __device__ __forceinline__ void operator()(const f32x4 (&acc)[2][2][4][2], const Unit& u, int wr, int wc, int fr, int fq) const {
        const int row0 = u.pm * 256 + wr * 64 + fr, col0 = u.pn * 256 + wc * 32 + 8 * fq;
#pragma unroll
        for (int ai = 0; ai < 2; ++ai)
#pragma unroll
            for (int m = 0; m < 4; ++m) { const size_t r = (size_t)(row0 + ai * 128 + m * 16); float ss = 0.f;
#pragma unroll
                for (int bj = 0; bj < 2; ++bj) { const f32x4 x0 = *(const f32x4*)(x + r * D + col0 + bj * 128), x1 = *(const f32x4*)(x + r * D + col0 + bj * 128 + 4);
                    const f32x4 v0 = acc[ai][bj][m][0] + x0, v1 = acc[ai][bj][m][1] + x1;
                    ss += (v0[0] * v0[0] + v0[1] * v0[1]) + (v0[2] * v0[2] + v0[3] * v0[3]) + (v1[0] * v1[0] + v1[1] * v1[1]) + (v1[2] * v1[2] + v1[3] * v1[3]);
                    u32x4 w; w.x = cvt_pk_bf16(v0[0], v0[1]); w.y = cvt_pk_bf16(v0[2], v0[3]); w.z = cvt_pk_bf16(v1[0], v1[1]); w.w = cvt_pk_bf16(v1[2], v1[3]);
                    *(u32x4*)(O + r * D + col0 + bj * 128) = w; }
                ss += __shfl_xor(ss, 16); ss += __shfl_xor(ss, 32);
                if (fq == 0) atomicAdd(ssq + r, ss); }
    }
};

struct EpiAct {
    bf16_t* act; const int* ltk; const float* ssq; const volatile LAS int* tpre;
    __device__ __forceinline__ void mid(f32x4 (&)[2][2][4][2], const Unit&, int, int, int, int) const {}
    __device__ __forceinline__ void operator()(const f32x4 (&acc)[2][2][4][2], const Unit& u, int wr, int wc, int fr, int fq) const {
        const int tile = tpre[u.e] + u.pm; const int col0 = u.pn * 128 + wc * 32 + 8 * fq;
#pragma unroll
        for (int ai = 0; ai < 2; ++ai)
#pragma unroll
            for (int m = 0; m < 4; ++m) { const int rr = ai * 128 + wr * 64 + m * 16 + fr;
                const int tk = (rr < u.cnt) ? ltk[(size_t)u.e * LCAP + u.pm * 256 + rr] : 0;
                const float rstd = rsqrtf(ssq[tk >> 1] * (1.0f / D) + EPS);
                float v[8];
#pragma unroll
                for (int j = 0; j < 8; ++j) { const float g = acc[ai][0][m][j >> 2][j & 3] * rstd, up = acc[ai][1][m][j >> 2][j & 3] * rstd; v[j] = g * sigmoidf_(g) * up; }
                u32x4 w; w.x = cvt_pk_bf16(v[0], v[1]); w.y = cvt_pk_bf16(v[2], v[3]); w.z = cvt_pk_bf16(v[4], v[5]); w.w = cvt_pk_bf16(v[6], v[7]);
                *(u32x4*)(act + ((size_t)tile * 256 + rr) * DE + col0) = w; }
    }
};

struct EpiDown {
    bf16_t* y; const int* ltk; const float* lw;
    __device__ __forceinline__ void mid(f32x4 (&)[2][2][4][2], const Unit&, int, int, int, int) const {}
    __device__ __forceinline__ void operator()(const f32x4 (&acc)[2][2][4][2], const Unit& u, int wr, int wc, int fr, int fq) const {
        const int col0 = u.pn * 256 + wc * 32 + 8 * fq;
#pragma unroll
        for (int ai = 0; ai < 2; ++ai)
#pragma unroll
            for (int m = 0; m < 4; ++m) { const int rr = ai * 128 + wr * 64 + m * 16 + fr;
                if (rr < u.cnt) { const size_t li = (size_t)u.e * LCAP + u.pm * 256 + rr; const int tk = ltk[li]; const float wt = lw[li];
#pragma unroll
                    for (int bj = 0; bj < 2; ++bj) { const f32x4 v0 = acc[ai][bj][m][0] * wt, v1 = acc[ai][bj][m][1] * wt;
                        u32x4 w; w.x = cvt_pk_bf16(v0[0], v0[1]); w.y = cvt_pk_bf16(v0[2], v0[3]); w.z = cvt_pk_bf16(v1[0], v1[1]); w.w = cvt_pk_bf16(v1[2], v1[3]);
                        *(u32x4*)(y + (size_t)tk * D + col0 + bj * 128) = w; } } }
    }
};

__device__ __forceinline__ void tr_tile(const float* src, int ld_src, bf16_t* dst, int ld_dst, int k0, int n0, int drow0, const float* scale, LAS float* tile) {
    const int tid = threadIdx.x;
    { const int kk = tid >> 4, n4 = (tid & 15) * 4;
#pragma unroll
      for (int p = 0; p < 2; ++p) { const int k = kk + 32 * p; const f32x4 v = *(const f32x4*)(src + (size_t)(k0 + k) * ld_src + n0 + n4); const float s = scale ? scale[k0 + k] : 1.0f;
          tile[k * 65 + n4 + 0] = v[0] * s; tile[k * 65 + n4 + 1] = v[1] * s; tile[k * 65 + n4 + 2] = v[2] * s; tile[k * 65 + n4 + 3] = v[3] * s; } }
    __syncthreads();
    { const int nn = tid >> 3, k8 = (tid & 7) * 8; float f[8];
#pragma unroll
      for (int j = 0; j < 8; ++j) f[j] = tile[(k8 + j) * 65 + nn];
      u32x4 w; w.x = cvt_pk_bf16(f[0], f[1]); w.y = cvt_pk_bf16(f[2], f[3]); w.z = cvt_pk_bf16(f[4], f[5]); w.w = cvt_pk_bf16(f[6], f[7]);
      *(u32x4*)(dst + (size_t)(drow0 + nn) * ld_dst + k0 + k8) = w; }
    __syncthreads();
}

__device__ void p0_prologue(const Params& P, LAS unsigned char* lds, int bid, int nb) {
    const int tid = threadIdx.x, wid = tid >> 6, lane = tid & 63;
    unsigned char* ws = P.ws;
    LAS float* tile = (LAS float*)lds;
    constexpr int T_IN = 16 * 96, T_UPA = 8 * 16, T_UPB = 16 * 16, T_OUT = 16 * 16, T_G = NE * 16 * 8, T_U = NE * 16 * 8, T_D = NE * 8 * 16;
    constexpr int T_TOTAL = T_IN + T_UPA + T_UPB + T_OUT + T_G + T_U + T_D;
    for (int t = bid; t < T_TOTAL; t += nb) {
        int j = t;
        if (j < T_IN) { const int kt = j / 96, ntl = j % 96; tr_tile(P.w_in, DIN, (bf16_t*)(ws + WS_WIN), D, kt * 64, ntl * 64, ntl * 64, nullptr, tile); continue; }
        j -= T_IN;
        if (j < T_UPA) { const int kt = j / 16, ntl = j % 16; tr_tile(P.w_up_a, D, (bf16_t*)(ws + WS_WUP), KUP, kt * 64, ntl * 64, ntl * 64, nullptr, tile); continue; }
        j -= T_UPA;
        if (j < T_UPB) { const int kt = j / 16, ntl = j % 16; tr_tile(P.w_up_b, D, (bf16_t*)(ws + WS_WUP) + 512, KUP, kt * 64, ntl * 64, ntl * 64, nullptr, tile); continue; }
        j -= T_UPB;
        if (j < T_OUT) { const int kt = j / 16, ntl = j % 16; tr_tile(P.w_out, D, (bf16_t*)(ws + WS_WOUT), D, kt * 64, ntl * 64, ntl * 64, nullptr, tile); continue; }
        j -= T_OUT;
        if (j < T_G + T_U) { const bool up = j >= T_G; if (up) j -= T_G; const int e = j / 128, r = j % 128, kt = r / 8, ntl = r % 8; const int c0 = ntl * 64;
            const int drow = (c0 >> 7) * 256 + (c0 & 127) + (up ? 128 : 0);
            tr_tile((up ? P.w_up : P.w_gate) + (size_t)e * D * DE, DE, (bf16_t*)(ws + WS_WGU) + (size_t)e * 1024 * D, D, kt * 64, c0, drow, P.norm2_g, tile); continue; }
        j -= T_G + T_U;
        { const int e = j / 128, r = j % 128, kt = r / 16, ntl = r % 16;
          tr_tile(P.w_down + (size_t)e * DE * D, D, (bf16_t*)(ws + WS_WD) + (size_t)e * D * DE, DE, kt * 64, ntl * 64, ntl * 64, nullptr, tile); }
    }
    { bf16_t* hn = (bf16_t*)(ws + WS_HN);
      for (int r = bid * 8 + wid; r < NTOK; r += nb * 8) {
          const float* xr = P.x + (size_t)r * D + lane * 16; f32x4 v[4]; float ss = 0.f;
#pragma unroll
          for (int q = 0; q < 4; ++q) { v[q] = *(const f32x4*)(xr + 4 * q); ss += v[q][0] * v[q][0] + v[q][1] * v[q][1] + v[q][2] * v[q][2] + v[q][3] * v[q][3]; }
          ss = wave_sum(ss); const float rstd = rsqrtf(ss * (1.0f / D) + EPS);
          float f[16];
#pragma unroll
          for (int q = 0; q < 4; ++q) { const f32x4 g = *(const f32x4*)(P.norm1_g + lane * 16 + 4 * q);
#pragma unroll
              for (int j = 0; j < 4; ++j) f[4 * q + j] = v[q][j] * rstd * g[j]; }
          u32x4 w0, w1; w0.x = cvt_pk_bf16(f[0], f[1]); w0.y = cvt_pk_bf16(f[2], f[3]); w0.z = cvt_pk_bf16(f[4], f[5]); w0.w = cvt_pk_bf16(f[6], f[7]);
          w1.x = cvt_pk_bf16(f[8], f[9]); w1.y = cvt_pk_bf16(f[10], f[11]); w1.z = cvt_pk_bf16(f[12], f[13]); w1.w = cvt_pk_bf16(f[14], f[15]);
          *(u32x4*)(hn + (size_t)r * D + lane * 16) = w0; *(u32x4*)(hn + (size_t)r * D + lane * 16 + 8) = w1; } }
    { LAS float* hm = (LAS float*)lds;
      LAS float* red = (LAS float*)(lds + 65536);
      float* projm = (float*)(ws + WS_PROJM);
      bool have = false;
      for (int cg = nb - 1 - bid; cg < DIN / 64; cg += nb) {
          if (!have) { __syncthreads();
              for (int r = wid; r < NMETA; r += 8) { const float* mr = P.meta + (size_t)r * D; float ss = 0.f;
                  for (int k = lane; k < D; k += 64) { const float v = mr[k]; ss += v * v; }
                  ss = wave_sum(ss); const float rstd = rsqrtf(ss * (1.0f / D) + EPS);
                  for (int k = lane; k < D; k += 64) hm[r * D + k] = mr[k] * rstd * P.norm1_g[k]; }
              have = true; __syncthreads(); }
          const int c = tid & 63, ks = tid >> 6; float a[16];
#pragma unroll
          for (int r = 0; r < 16; ++r) a[r] = 0.f;
          for (int k = ks * 128; k < ks * 128 + 128; ++k) { const float w = P.w_in[(size_t)k * DIN + cg * 64 + c];
#pragma unroll
              for (int r = 0; r < 16; ++r) a[r] += hm[r * D + k] * w; }
#pragma unroll
          for (int r = 0; r < 16; ++r) red[(ks * 16 + r) * 64 + c] = a[r];
          __syncthreads();
          for (int o = tid; o < 16 * 64; o += NTHREADS) { const int r = o >> 6, cc = o & 63; float s = 0.f;
#pragma unroll
              for (int q = 0; q < 8; ++q) s += red[(q * 16 + r) * 64 + cc];
              projm[(size_t)r * DIN + cg * 64 + cc] = s; }
          __syncthreads(); } }
    { float* lb = (float*)(ws + WS_LB);
      for (int d = bid * NTHREADS + tid; d < DHG; d += nb * NTHREADS) lb[d] = sigmoidf_(P.hg_lb[d] - P.hg_lb[DHG + d]);
      bf16_t* wrt = (bf16_t*)(ws + WS_WR);
      for (int o = bid * NTHREADS + tid; o < 48 * D; o += nb * NTHREADS) { const int j = o / D, k = o % D; float v = 0.f;
          if (j < 4) v = P.w_group[(size_t)k * 4 + j] * P.norm2_g[k];
          else if (j < 36) { const int g = (j - 4) >> 3, e = (j - 4) & 7; v = P.w_router[((size_t)g * D + k) * 8 + e] * P.norm2_g[k]; }
          wrt[o] = f2bf(v); }
      float* ssq = (float*)(ws + WS_SSQ);
      for (int o = bid * NTHREADS + tid; o < NTOK; o += nb * NTHREADS) ssq[o] = 0.f; }
}

__device__ __forceinline__ float ldproj(const Params& P, int b, int s, int col) {
    if (s < NMETA) return ((const float*)(P.ws + WS_PROJM))[(size_t)s * DIN + col];
    return bf2f(((const bf16_t*)(P.ws + WS_PROJ))[((size_t)b * SEQ + (s - NMETA)) * DIN + col]);
}

__device__ void hgrn_simple(const Params& P, LAS unsigned char* lds, int unit) {
    constexpr int TC = 32;
    const int tid = threadIdx.x, wid = tid >> 6, lane = tid & 63, b = unit >> 2, h = unit & 3, v = tid & 127, dg = tid >> 7;
    LAS float* fb = (LAS float*)lds; LAS float* kb = fb + TC * 128; LAS float* qb = kb + TC * 128; LAS float* vb = qb + TC * 128; LAS float* op = vb + TC * 128;
    const float* lbp = (const float*)(P.ws + WS_LB);
    bf16_t* oab = (bf16_t*)P.out;
    float S[32];
#pragma unroll
    for (int j = 0; j < 32; ++j) S[j] = 0.f;
    for (int c0 = 0; c0 < TSEQ; c0 += TC) {
        const int len = (TSEQ - c0) < TC ? (TSEQ - c0) : TC;
        __syncthreads();
        for (int idx = tid; idx < len * 128; idx += NTHREADS) { const int t = idx >> 7, d = idx & 127, s = c0 + t;
            const float q = ldproj(P, b, s, C_Q + h * 128 + d), fp = ldproj(P, b, s, C_F + h * 128 + d), iv = ldproj(P, b, s, C_I + h * 128 + d);
            const float lb = lbp[h * 128 + d];
            fb[idx] = lb + (1.0f - lb) * sigmoidf_(fp); kb[idx] = (1.0f - lb) * sigmoidf_(-fp); qb[idx] = q; vb[idx] = iv; }
        __syncthreads();
        for (int t = 0; t < len; ++t) { const float vv = vb[t * 128 + v]; float o = 0.f;
#pragma unroll
            for (int j4 = 0; j4 < 8; ++j4) { const f32x4 f4 = *(const LAS f32x4*)(fb + t * 128 + dg * 32 + j4 * 4), k4 = *(const LAS f32x4*)(kb + t * 128 + dg * 32 + j4 * 4), q4 = *(const LAS f32x4*)(qb + t * 128 + dg * 32 + j4 * 4);
#pragma unroll
                for (int j = 0; j < 4; ++j) { S[j4 * 4 + j] = f4[j] * S[j4 * 4 + j] + k4[j] * vv; o += S[j4 * 4 + j] * q4[j]; } }
            op[(t * 4 + dg) * 128 + v] = o; }
        __syncthreads();
        for (int t = wid; t < len; t += 8) { const int s = c0 + t; if (s < NMETA) continue;
            const float o0 = op[(t * 4 + 0) * 128 + lane] + op[(t * 4 + 1) * 128 + lane] + op[(t * 4 + 2) * 128 + lane] + op[(t * 4 + 3) * 128 + lane];
            const float o1 = op[(t * 4 + 0) * 128 + lane + 64] + op[(t * 4 + 1) * 128 + lane + 64] + op[(t * 4 + 2) * 128 + lane + 64] + op[(t * 4 + 3) * 128 + lane + 64];
            const float ss = wave_sum(o0 * o0 + o1 * o1); const float rstd = rsqrtf(ss * (1.0f / 128.0f) + EPS);
            const size_t row = (size_t)b * SEQ + (s - NMETA);
            const float g0 = P.hg_norm_g[h * 128 + lane], g1 = P.hg_norm_g[h * 128 + lane + 64];
            const float og0 = ldproj(P, b, s, C_OG + h * 128 + lane), og1 = ldproj(P, b, s, C_OG + h * 128 + lane + 64);
            oab[row * KUP + h * 128 + lane] = f2bf(o0 * rstd * g0 * sigmoidf_(og0));
            oab[row * KUP + h * 128 + lane + 64] = f2bf(o1 * rstd * g1 * sigmoidf_(og1)); }
    }
}

__device__ void lru_simple(const Params& P, LAS unsigned char* lds, int unit) {
    constexpr int TC = 64;
    const int tid = threadIdx.x, b = unit >> 3, n = unit & 7, c = tid & 127, tq = tid >> 7, ch = n * 128 + c;
    LAS float* xin = (LAS float*)lds;
    LAS float* xc = xin + (TC + 3) * 128;
    LAS float* ab = xc + TC * 128;
    LAS float* ub = ab + TC * 128;
    bf16_t* oab = (bf16_t*)P.out;
    const float cw0 = P.conv_w[0 * D + ch], cw1 = P.conv_w[1 * D + ch], cw2 = P.conv_w[2 * D + ch], cw3 = P.conv_w[3 * D + ch], cb = P.conv_b[ch];
    const float br = P.b_r[ch], bi = P.b_i[ch];
    const float lamv = P.lam[ch]; const float sp = (lamv > 15.f) ? __expf(-lamv) : log1pf(__expf(-lamv));
    const float* wr = P.w_r + (size_t)n * 128 * 128; const float* wi = P.w_i + (size_t)n * 128 * 128;
    float hcar = 0.f;
    for (int c0 = 0; c0 < TSEQ; c0 += TC) {
        const int len = (TSEQ - c0) < TC ? (TSEQ - c0) : TC;
        __syncthreads();
        for (int idx = tid; idx < (len + 3) * 128; idx += NTHREADS) { const int t = idx >> 7, cc = idx & 127, s = c0 + t - 3;
            xin[idx] = (s >= 0) ? ldproj(P, b, s, C_LX + n * 128 + cc) : 0.f; }
        __syncthreads();
        for (int t = tq; t < len; t += 4) xc[t * 128 + c] = cw0 * xin[t * 128 + c] + cw1 * xin[(t + 1) * 128 + c] + cw2 * xin[(t + 2) * 128 + c] + cw3 * xin[(t + 3) * 128 + c] + cb;
        __syncthreads();
        { float ra[16], ia[16];
#pragma unroll
          for (int j = 0; j < 16; ++j) { ra[j] = 0.f; ia[j] = 0.f; }
          for (int i4 = 0; i4 < 128; i4 += 4) { float w_r4[4], w_i4[4];
#pragma unroll
              for (int q = 0; q < 4; ++q) { w_r4[q] = wr[(size_t)(i4 + q) * 128 + c]; w_i4[q] = wi[(size_t)(i4 + q) * 128 + c]; }
#pragma unroll
              for (int j = 0; j < 16; ++j) { const f32x4 xv = *(const LAS f32x4*)(xc + (tq * 16 + j) * 128 + i4);
#pragma unroll
                  for (int q = 0; q < 4; ++q) { ra[j] += xv[q] * w_r4[q]; ia[j] += xv[q] * w_i4[q]; } } }
#pragma unroll
          for (int j = 0; j < 16; ++j) { const int t = tq * 16 + j; const float r = sigmoidf_(ra[j] + br), ig = sigmoidf_(ia[j] + bi);
              const float log_a = -8.0f * r * sp; const float a = __expf(log_a); const float u = sqrtf(-expm1f(2.0f * log_a)) * (ig * xc[t * 128 + c]);
              ab[t * 128 + c] = a; ub[t * 128 + c] = u; } }
        __syncthreads();
        if (tid < 128) { float hh = hcar; for (int t = 0; t < len; ++t) { hh = ab[t * 128 + c] * hh + ub[t * 128 + c]; ub[t * 128 + c] = hh; } hcar = hh; }
        __syncthreads();
        for (int idx = tid; idx < len * 128; idx += NTHREADS) { const int t = idx >> 7, cc = idx & 127, s = c0 + t; if (s < NMETA) continue;
            const float y = ldproj(P, b, s, C_LY + n * 128 + cc);
            oab[((size_t)b * SEQ + (s - NMETA)) * KUP + 512 + n * 128 + cc] = f2bf(ub[idx] * gelu_tanh(y)); }
    }
}

__device__ void p5_router(const Params& P, LAS unsigned char* lds, int bid, int nb) {
    const int tid = threadIdx.x, wid = tid >> 6, lane = tid & 63;
    unsigned char* ws = P.ws;
    const bf16_t* h2 = (const bf16_t*)(ws + WS_H2); const bf16_t* wrt = (const bf16_t*)(ws + WS_WR); const float* ssq = (const float*)(ws + WS_SSQ);
    int* counts = (int*)(ws + WS_CTL + CTL_CNT); int* ltk = (int*)(ws + WS_LTK); float* lw = (float*)(ws + WS_LW);
    LAS int* lcnt = (LAS int*)lds;
    LAS int* lbase = lcnt + 32;
    LAS int* ae = lbase + 32;
    LAS int* al = ae + 512;
    LAS float* aw = (LAS float*)(al + 512);
    for (int t0 = bid * 256; t0 < NTOK; t0 += nb * 256) {
        __syncthreads();
        if (tid < 32) lcnt[tid] = 0;
        __syncthreads();
        for (int tl = wid; tl < 256; tl += 8) {
            const int tok = t0 + tl;
            float hv[16]; { const u32x4 a = *(const u32x4*)(h2 + (size_t)tok * D + lane * 16), c = *(const u32x4*)(h2 + (size_t)tok * D + lane * 16 + 8);
                float f0[8], f1[8]; unpack8(a, f0); unpack8(c, f1);
#pragma unroll
                for (int j = 0; j < 8; ++j) { hv[j] = f0[j]; hv[8 + j] = f1[j]; } }
            const float rstd = rsqrtf(ssq[tok] * (1.0f / D) + EPS);
            float mylg = 0.f;
#pragma unroll 2
            for (int j = 0; j < 36; ++j) { const u32x4 a = *(const u32x4*)(wrt + (size_t)j * D + lane * 16), c = *(const u32x4*)(wrt + (size_t)j * D + lane * 16 + 8);
                float f0[8], f1[8]; unpack8(a, f0); unpack8(c, f1); float s = 0.f;
#pragma unroll
                for (int q = 0; q < 8; ++q) s += hv[q] * f0[q] + hv[8 + q] * f1[q];
                s = wave_sum(s); mylg = (lane == j) ? s : mylg; }
            {
                float gl[4]; int gs = 0; float gm;
#pragma unroll
                for (int j = 0; j < 4; ++j) gl[j] = __shfl(mylg, j) * rstd + P.b_group[j];
                gm = gl[0];
#pragma unroll
                for (int j = 1; j < 4; ++j) if (gl[j] > gm) { gm = gl[j]; gs = j; }
                float den = 0.f;
#pragma unroll
                for (int j = 0; j < 4; ++j) den += __expf(gl[j] - gm);
                const float psel = 1.0f / den;
                float el[8];
#pragma unroll
                for (int e = 0; e < 8; ++e) el[e] = __shfl(mylg, 4 + gs * 8 + e) * rstd + P.b_router[gs * 8 + e];
                int i0 = 0; float v0 = el[0];
#pragma unroll
                for (int e = 1; e < 8; ++e) if (el[e] > v0) { v0 = el[e]; i0 = e; }
                int i1 = -1; float v1 = -3.0e38f;
#pragma unroll
                for (int e = 0; e < 8; ++e) if (e != i0 && el[e] > v1) { v1 = el[e]; i1 = e; }
                const float e1 = __expf(v1 - v0); const float w0 = psel / (1.0f + e1), w1 = psel * e1 / (1.0f + e1);
                const int ex0 = gs * 8 + i0, ex1 = gs * 8 + i1;
                if (lane == 0) {
                ae[tl * 2] = ex0; al[tl * 2] = __hip_atomic_fetch_add(lcnt + ex0, 1, __ATOMIC_RELAXED, __HIP_MEMORY_SCOPE_WORKGROUP); aw[tl * 2] = w0;
                ae[tl * 2 + 1] = ex1; al[tl * 2 + 1] = __hip_atomic_fetch_add(lcnt + ex1, 1, __ATOMIC_RELAXED, __HIP_MEMORY_SCOPE_WORKGROUP); aw[tl * 2 + 1] = w1; }
            }
        }
        __syncthreads();
        if (tid < 32) lbase[tid] = atomicAdd(counts + tid, lcnt[tid]);
        __syncthreads();
        { const int a = tid; const int e = ae[a]; const int pos = lbase[e] + al[a];
          ltk[(size_t)e * LCAP + pos] = (t0 + (a >> 1)) * 2 + (a & 1); lw[(size_t)e * LCAP + pos] = aw[a]; }
    }
}

__device__ void p8_final(const Params& P, int bid, int nb) {
    const int tid = threadIdx.x, wid = tid >> 6, lane = tid & 63;
    const bf16_t* h2 = (const bf16_t*)(P.ws + WS_H2); const bf16_t* yb = (const bf16_t*)(P.ws + WS_Y);
    for (int r = bid * 8 + wid; r < NTOK; r += nb * 8) {
        float v[16]; float ss = 0.f;
#pragma unroll
        for (int hlf = 0; hlf < 2; ++hlf) { float a[8], y0[8], y1[8];
            unpack8(*(const u32x4*)(h2 + (size_t)r * D + lane * 16 + hlf * 8), a);
            unpack8(*(const u32x4*)(yb + ((size_t)r * 2) * D + lane * 16 + hlf * 8), y0);
            unpack8(*(const u32x4*)(yb + ((size_t)r * 2 + 1) * D + lane * 16 + hlf * 8), y1);
#pragma unroll
            for (int j = 0; j < 8; ++j) { const float t = a[j] + (y0[j] + y1[j]); v[hlf * 8 + j] = t; ss += t * t; } }
        ss = wave_sum(ss); const float rstd = rsqrtf(ss * (1.0f / D) + EPS);
#pragma unroll
        for (int q = 0; q < 4; ++q) { const f32x4 g = *(const f32x4*)(P.final_g + lane * 16 + 4 * q); f32x4 o;
#pragma unroll
            for (int j = 0; j < 4; ++j) o[j] = v[4 * q + j] * rstd * g[j];
            *(f32x4*)(P.out + (size_t)r * D + lane * 16 + 4 * q) = o; }
    }
}

__device__ __forceinline__ void moe_table(const Params& P, volatile LAS int* tpre) {
    if (threadIdx.x == 0) { const int* counts = (const int*)(P.ws + WS_CTL + CTL_CNT); int acc = 0;
        for (int e = 0; e < NE; ++e) { const int cnt = counts[e]; tpre[e] = acc; tpre[40 + e] = cnt; acc += (cnt + 255) >> 8; }
        tpre[NE] = acc; }
    __syncthreads();
}
}

__global__ void __launch_bounds__(NTHREADS, 2) fwd_kernel(Params P) {
    extern __shared__ __attribute__((aligned(16))) unsigned char lds_raw[];
    LAS unsigned char* lds = (LAS unsigned char*)lds_raw;
    const int bid = blockIdx.x, nb = gridDim.x;
    unsigned char* ws = P.ws;
    const int lo = P.ph_lo, hi = P.ph_hi;
#ifdef ONLY_PHASE
#define IN(k) ((k) == ONLY_PHASE && lo <= (k) && (k) < hi)
#else
#define IN(k) (lo <= (k) && (k) < hi)
#endif
    if (IN(0)) p0_prologue(P, lds, bid, nb);
    if (IN(1)) { DenseOrder S; S.init(ws + WS_HN, D * 2, ws + WS_WIN, D * 2, NTOK, DIN, nb, bid);
        EpiStoreBf16 E{(bf16_t*)(ws + WS_PROJ), DIN};
        gemm_simple<EpiStoreBf16, DenseOrder, false, 0>(D * 2, D * 2, D, S, E); }
    if (IN(2)) { for (int u = bid; u < 128 + 256; u += nb) { if (u < 128) hgrn_simple(P, lds, u); else lru_simple(P, lds, u - 128); } }
    if (IN(3)) { DenseOrder S; S.init(P.out, KUP * 2, ws + WS_WUP, KUP * 2, NTOK, D, nb, bid);
        EpiMerge E{(bf16_t*)(ws + WS_HN), (const bf16_t*)(ws + WS_PROJ)};
        gemm_simple<EpiMerge, DenseOrder, false, 512>(KUP * 2, KUP * 2, KUP, S, E); }
    if (IN(4)) { DenseOrder S; S.init(ws + WS_HN, D * 2, ws + WS_WOUT, D * 2, NTOK, D, nb, bid);
        EpiResid E{(bf16_t*)(ws + WS_H2), P.x, (float*)(ws + WS_SSQ)};
        gemm_simple<EpiResid, DenseOrder, false, 0>(D * 2, D * 2, D, S, E); }
    if (IN(5)) p5_router(P, lds, bid, nb);
    if (IN(6)) { volatile LAS int* tpre = (volatile LAS int*)(lds + 140 * 1024); __syncthreads(); moe_table(P, tpre);
        MoeOrder S; S.A = (const char*)(ws + WS_H2); S.B = (const char*)(ws + WS_WGU); S.ltk = (const int*)(ws + WS_LTK); S.tpre = tpre; S.nN = 4; S.nunits = tpre[NE] * 4; S.G = nb; S.c = bid;
        S.b_exp = (size_t)1024 * D * 2; S.b_tile = (size_t)256 * D * 2; S.a_row = D * 2; S.gather = true;
        EpiAct E{(bf16_t*)(ws + WS_ACT), (const int*)(ws + WS_LTK), (const float*)(ws + WS_SSQ), tpre};
        gemm_simple<EpiAct, MoeOrder, true, 0>(D * 2, D * 2, D, S, E); }
    if (IN(7)) { volatile LAS int* tpre = (volatile LAS int*)(lds + 140 * 1024); __syncthreads(); moe_table(P, tpre);
        MoeOrder S; S.A = (const char*)(ws + WS_ACT); S.B = (const char*)(ws + WS_WD); S.ltk = (const int*)(ws + WS_LTK); S.tpre = tpre; S.nN = 4; S.nunits = tpre[NE] * 4; S.G = nb; S.c = bid;
        S.b_exp = (size_t)D * DE * 2; S.b_tile = (size_t)256 * DE * 2; S.a_row = DE * 2; S.gather = false;
        EpiDown E{(bf16_t*)(ws + WS_Y), (const int*)(ws + WS_LTK), (const float*)(ws + WS_LW)};
        gemm_simple<EpiDown, MoeOrder, false, 0>(DE * 2, DE * 2, DE, S, E); }
    if (IN(8)) p8_final(P, bid, nb);
#undef IN
}

extern "C" void kernel_launch(void* const* d_in, const int* in_sizes, int n_in, void* d_out, int out_size, void* d_ws, size_t ws_size, hipStream_t stream) {
    static int grid = 0;
    if (grid == 0) {
        if (n_in != 25 || in_sizes[0] != NTOK * D || out_size != NTOK * D || ws_size < WS_END) {
            fprintf(stderr, "kernel_launch: unexpected shapes (n_in %d, in0 %d, out %d, ws %zu < %zu); nothing launched\n", n_in, n_in > 0 ? in_sizes[0] : -1, out_size, ws_size, (size_t)WS_END); grid = -1; return; }
        int dev = 0, cus = 0;
        if (hipGetDevice(&dev) != hipSuccess || hipDeviceGetAttribute(&cus, hipDeviceAttributeMultiprocessorCount, dev) != hipSuccess) { grid = -1; return; }
        if (hipFuncSetAttribute((const void*)fwd_kernel, hipFuncAttributeMaxDynamicSharedMemorySize, LDS_BYTES) != hipSuccess) { fprintf(stderr, "kernel_launch: hipFuncSetAttribute failed\n"); grid = -1; return; }
        grid = cus;
    }
    if (grid < 0) return;
    (void)hipMemsetAsync((char*)d_ws + WS_CTL, 0, CTL_ZERO_BYTES, stream);
    Params p{};
    const float** f = (const float**)&p;
    for (int i = 0; i < 25; ++i) f[i] = (const float*)d_in[i];
    p.out = (float*)d_out; p.ws = (unsigned char*)d_ws;
    for (int ph = 0; ph < 9; ++ph) { p.ph_lo = ph; p.ph_hi = ph + 1;
        hipLaunchKernelGGL(fwd_kernel, dim3(grid), dim3(NTHREADS), LDS_BYTES, stream, p); }
}
```

```cpp
#include <hip/hip_runtime.h>
#include <cstdio>
#include <cstdint>

#ifndef NLAUNCH
#define NLAUNCH 1
#endif

#define LAS __attribute__((address_space(3)))
typedef unsigned short bf16_t;
typedef short bf16x8 __attribute__((ext_vector_type(8)));
typedef float f32x4 __attribute__((ext_vector_type(4)));
typedef float f32x2 __attribute__((ext_vector_type(2)));
typedef unsigned u32x4 __attribute__((ext_vector_type(4)));
typedef unsigned u32x2 __attribute__((ext_vector_type(2)));

#define XB_TMO      128
#define XB_XCNT(j)  (256  + 64 * (j))
#define XB_XSUB(j)  (1280 + 64 * (j))
#define XB_XGEN(j)  (2304 + 64 * (j))
#define XB_TOP      3328
#define XB_TOPGEN   3392
#define XCD_BAR_WORDS 3456
#define XB_SPIN_CAP (1u << 18)

__device__ __forceinline__ unsigned xb_ld(unsigned* p)              { return __hip_atomic_load(p, __ATOMIC_RELAXED, __HIP_MEMORY_SCOPE_AGENT); }
__device__ __forceinline__ unsigned xb_add(unsigned* p, unsigned v) { return __hip_atomic_fetch_add(p, v, __ATOMIC_RELAXED, __HIP_MEMORY_SCOPE_AGENT); }
__device__ __forceinline__ unsigned xb_xcc_id() { return (unsigned)__builtin_amdgcn_s_getreg((3 << 11) | 20) & 0xFu; }
#define XB_SPIN(cond, bar) do { unsigned _sp = 0; while (cond) { __builtin_amdgcn_s_sleep(1); \
    if ((++_sp & 255u) == 0u) { if (xb_ld(&(bar)[XB_TMO])) break; if (_sp > XB_SPIN_CAP) { atomicAdd(&(bar)[XB_TMO], 1u); break; } } } } while (0)

struct XcdBarrier {
    unsigned* bar; unsigned x;
    volatile LAS unsigned* st;
};

__device__ __forceinline__ XcdBarrier xcd_barrier_post(unsigned* bar, volatile LAS unsigned* st) {
    XcdBarrier b; b.bar = bar; b.x = xb_xcc_id(); b.st = st;
    if (threadIdx.x == 0) (void)xb_add(&bar[XB_XCNT(b.x)], 1u);
    return b;
}
__device__ __forceinline__ void xcd_barrier_complete(unsigned* bar, unsigned x, unsigned& nloc, unsigned& nx) {
    const unsigned G = gridDim.x * gridDim.y * gridDim.z;
    unsigned sum, cnt, mine, sp = 0u;
    for (;;) {
        sum = 0u; cnt = 0u; mine = 0u;
#pragma unroll
        for (unsigned j = 0; j < 16; ++j) { const unsigned c = xb_ld(&bar[XB_XCNT(j)]); sum += c; cnt += (c > 0u) ? 1u : 0u; mine = (j == x) ? c : mine; }
        if (sum == G) break;
        __builtin_amdgcn_s_sleep(1);
        if ((++sp & 255u) == 0u) { if (xb_ld(&bar[XB_TMO])) break; if (sp > XB_SPIN_CAP) { atomicAdd(&bar[XB_TMO], 1u); break; } }
    }
    nloc = mine > 0u ? mine : 1u; nx = cnt > 0u ? cnt : 1u;
}

__device__ __forceinline__ void xcd_barrier(const XcdBarrier& b) {
    asm volatile("s_waitcnt vmcnt(0)" ::: "memory");
    __syncthreads();
    if (threadIdx.x == 0) {
        unsigned* bar = b.bar;
        __builtin_amdgcn_s_waitcnt(0);
        unsigned nloc = b.st[0], nx = b.st[1];
        if (nloc == 0u) { xcd_barrier_complete(bar, b.x, nloc, nx); b.st[0] = nloc; b.st[1] = nx; }
        const unsigned old = xb_add(&bar[XB_XSUB(b.x)], 1u);
        const unsigned gen = old / nloc;
        if (old + 1u == (gen + 1u) * nloc) {
            __builtin_amdgcn_fence(__ATOMIC_RELEASE, "agent");
            asm volatile("s_waitcnt vmcnt(0)" ::: "memory");
            const unsigned og = xb_add(&bar[XB_TOP], 1u);
            const unsigned tg = og / nx;
            if (og + 1u == (tg + 1u) * nx) xb_add(&bar[XB_TOPGEN], 1u);
            else XB_SPIN(xb_ld(&bar[XB_TOPGEN]) == tg, bar);
            __builtin_amdgcn_fence(__ATOMIC_ACQUIRE, "agent");
            xb_add(&bar[XB_XGEN(b.x)], 1u);
            asm volatile("s_waitcnt vmcnt(0)" ::: "memory");
        } else {
            XB_SPIN(xb_ld(&bar[XB_XGEN(b.x)]) == gen, bar);
            __builtin_amdgcn_fence(__ATOMIC_ACQUIRE, "agent");
            asm volatile("s_waitcnt vmcnt(0)" ::: "memory");
        }
    }
    __syncthreads();
}


namespace {
constexpr int NB = 32, SEQ = 2048, NMETA = 16, D = 1024, NTOK = NB * SEQ;
constexpr int TSEQ = SEQ + NMETA;
constexpr int DIN = 6144, DHG = 512, NE = 32, DE = 512;
constexpr int C_Q = 0, C_F = 512, C_I = 1024, C_OG = 1536, C_LX = 2048, C_LY = 3072, C_GA = 4096, C_GB = 5120;
constexpr int KUP = 1536;
constexpr float EPS = 1e-6f;
constexpr int NTHREADS = 512;
constexpr int LDS_BYTES = 144 * 1024;
constexpr int ACT_ROWS = 139264;
constexpr int LCAP = 65536;

constexpr size_t MiB = 1024ull * 1024ull;
constexpr size_t WS_PROJ = 0;
constexpr size_t WS_H2   = 0;
constexpr size_t WS_Y    = 128 * MiB;
constexpr size_t WS_ACT  = 384 * MiB;
constexpr size_t WS_LTK  = 520 * MiB;
constexpr size_t WS_LW   = 528 * MiB;
constexpr size_t WS_HN   = 768 * MiB;
constexpr size_t WS_W    = 896 * MiB;
constexpr size_t WS_WIN  = WS_W;
constexpr size_t WS_WUP  = WS_WIN + (size_t)DIN * D * 2;
constexpr size_t WS_WOUT = WS_WUP + (size_t)D * KUP * 2;
constexpr size_t WS_WGU  = WS_WOUT + (size_t)D * D * 2;
constexpr size_t WS_WD   = WS_WGU + (size_t)NE * 1024 * D * 2;
constexpr size_t WS_WR   = WS_WD + (size_t)NE * D * DE * 2;
constexpr size_t WS_CTL  = WS_WR + 128 * 1024;
constexpr size_t CTL_BAR = 0, CTL_CNT = 16384;
constexpr size_t CTL_ZERO_BYTES = 16384 + 256;
constexpr size_t WS_SSQ  = WS_CTL + 32768;
constexpr size_t WS_PROJM = WS_SSQ + (size_t)NTOK * 4;
constexpr size_t WS_LB   = WS_PROJM + (size_t)NMETA * DIN * 4;
constexpr size_t WS_END  = WS_LB + 4096;

struct Params {
    const float *x, *meta, *norm1_g, *w_in, *hg_lb, *hg_norm_g, *conv_w, *conv_b, *w_r, *b_r, *w_i, *b_i, *lam, *w_up_a, *w_up_b, *w_out,
                *norm2_g, *w_group, *b_group, *w_router, *b_router, *w_gate, *w_up, *w_down, *final_g;
    float* out; unsigned char* ws;
    int ph_lo, ph_hi;
};

__device__ __forceinline__ float bf2f(bf16_t b) { return __uint_as_float(((unsigned)b) << 16); }
__device__ __forceinline__ unsigned cvt_pk_bf16(float lo, float hi) { unsigned r; asm volatile("v_cvt_pk_bf16_f32 %0, %1, %2" : "=v"(r) : "v"(lo), "v"(hi)); return r; }
__device__ __forceinline__ bf16_t f2bf(float f) { return (bf16_t)(cvt_pk_bf16(f, 0.f) & 0xffffu); }
__device__ __forceinline__ float sigmoidf_(float x) { return 1.0f / (1.0f + __expf(-x)); }
__device__ __forceinline__ float gelu_tanh(float y) { const float z = 0.7978845608028654f * (y + 0.044715f * y * y * y); const float t = 1.0f - 2.0f / (1.0f + __expf(2.0f * z)); return 0.5f * y * (1.0f + t); }
__device__ __forceinline__ float wave_sum(float v) {
#pragma unroll
    for (int o = 32; o > 0; o >>= 1) v += __shfl_xor(v, o);
    return v;
}
__device__ __forceinline__ int perm32(int rho) { const int n = rho >> 4, i = rho & 15; return 8 * (i >> 2) + 4 * n + (i & 3); }

struct Unit { const char* A; const char* B; int pm, pn, e, cnt; };

struct DenseOrder {
    const char* A; const char* B; int nN, nunits, G, c; size_t a_tile, b_tile;
    __device__ void init(const void* A_, size_t lda_b, const void* B_, size_t ldb_b, int M, int N, int G_, int c_) {
        A = (const char*)A_; B = (const char*)B_; nN = N / 256; nunits = (M / 256) * nN; G = G_; c = c_; a_tile = 256 * lda_b; b_tile = 256 * ldb_b; }
    __device__ __forceinline__ bool next(int i, Unit& u) const {
        const int L = i * G + c; if (L >= nunits) return false;
        u.pm = L / nN; u.pn = L % nN; u.e = 0; u.cnt = 256; u.A = A + (size_t)u.pm * a_tile; u.B = B + (size_t)u.pn * b_tile; return true; }
    __device__ __forceinline__ unsigned row_off(const Unit&, int) const { return 0u; }
};

struct MoeOrder {
    const char* A; const char* B; const int* ltk; const volatile LAS int* tpre; int nN, nunits, G, c; size_t b_exp, b_tile, a_row; bool gather;
    __device__ __forceinline__ bool next(int i, Unit& u) const {
        const int L = i * G + c; if (L >= nunits) return false;
        const int tile = L / nN; u.pn = L % nN;
        int e = 0;
#pragma unroll 1
        while (e < NE - 1 && tile >= tpre[e + 1]) ++e;
        u.e = e; u.pm = tile - tpre[e]; u.cnt = tpre[40 + e] - u.pm * 256;
        u.B = B + (size_t)e * b_exp + (size_t)u.pn * b_tile;
        u.A = gather ? A : A + (size_t)tile * 256 * a_row; return true; }
    __device__ __forceinline__ unsigned row_off(const Unit& u, int r) const {
        const int idx = u.pm * 256 + r; const int tk = (r < u.cnt) ? ltk[(size_t)u.e * LCAP + idx] : 0; return (unsigned)(tk >> 1) * (unsigned)a_row; }
};

template <class Epi, class Sched, bool GATHER, int KMID>
__device__ __forceinline__ void gemm_simple(unsigned lda_b, unsigned ldb_b, int K, const Sched& S, const Epi& E) {
    const int tid = threadIdx.x, wid = tid >> 6, lane = tid & 63, wr = wid >> 2, wc = wid & 3, fr = lane & 15, fq = lane >> 4;
    for (int i = 0;; ++i) {
        Unit u; if (!S.next(i, u)) break;
        f32x4 acc[2][2][4][2];
#pragma unroll
        for (int a = 0; a < 2; ++a)
#pragma unroll
            for (int b = 0; b < 2; ++b)
#pragma unroll
                for (int m = 0; m < 4; ++m)
#pragma unroll
                    for (int n = 0; n < 2; ++n) acc[a][b][m][n] = (f32x4){0.f, 0.f, 0.f, 0.f};
        unsigned aoff[2][4], boff[2][2];
#pragma unroll
        for (int a = 0; a < 2; ++a)
#pragma unroll
            for (int m = 0; m < 4; ++m) { const int r = 128 * a + 64 * wr + 16 * m + fr; aoff[a][m] = (GATHER ? S.row_off(u, r) : (unsigned)r * lda_b) + fq * 16; }
#pragma unroll
        for (int b = 0; b < 2; ++b)
#pragma unroll
            for (int n = 0; n < 2; ++n) { const int wrow = 128 * b + 32 * wc + perm32(16 * n + fr); boff[b][n] = (unsigned)wrow * ldb_b + fq * 16; }
#define GS_KLOOP(k0, k1) _Pragma("unroll 1") for (int k = (k0); k < (k1); k += 32) { \
            bf16x8 av[2][4], bv[2][2]; \
            _Pragma("unroll") for (int a = 0; a < 2; ++a) _Pragma("unroll") for (int m = 0; m < 4; ++m) av[a][m] = *(const bf16x8*)(u.A + aoff[a][m] + k * 2); \
            _Pragma("unroll") for (int b = 0; b < 2; ++b) _Pragma("unroll") for (int n = 0; n < 2; ++n) bv[b][n] = *(const bf16x8*)(u.B + boff[b][n] + k * 2); \
            _Pragma("unroll") for (int a = 0; a < 2; ++a) _Pragma("unroll") for (int b = 0; b < 2; ++b) _Pragma("unroll") for (int m = 0; m < 4; ++m) _Pragma("unroll") for (int n = 0; n < 2; ++n) \
                acc[a][b][m][n] = __builtin_amdgcn_mfma_f32_16x16x32_bf16(bv[b][n], av[a][m], acc[a][b][m][n], 0, 0, 0); }
        if (KMID > 0) { GS_KLOOP(0, KMID) E.mid(acc, u, wr, wc, fr, fq); GS_KLOOP(KMID, K) } else { GS_KLOOP(0, K) }
#undef GS_KLOOP
        E(acc, u, wr, wc, fr, fq);
    }
}

struct EpiStoreBf16 {
    bf16_t* O; int ldc;
    __device__ __forceinline__ void mid(f32x4 (&)[2][2][4][2], const Unit&, int, int, int, int) const {}
    __device__ __forceinline__ void operator()(const f32x4 (&acc)[2][2][4][2], const Unit& u, int wr, int wc, int fr, int fq) const {
        const int row0 = u.pm * 256 + wr * 64 + fr, col0 = u.pn * 256 + wc * 32 + 8 * fq;
#pragma unroll
        for (int ai = 0; ai < 2; ++ai)
#pragma unroll
            for (int m = 0; m < 4; ++m) { bf16_t* rowp = O + (size_t)(row0 + ai * 128 + m * 16) * ldc + col0;
#pragma unroll
                for (int bj = 0; bj < 2; ++bj) { const f32x4 v0 = acc[ai][bj][m][0], v1 = acc[ai][bj][m][1];
                    u32x4 w; w.x = cvt_pk_bf16(v0[0], v0[1]); w.y = cvt_pk_bf16(v0[2], v0[3]); w.z = cvt_pk_bf16(v1[0], v1[1]); w.w = cvt_pk_bf16(v1[2], v1[3]);
                    *(u32x4*)(rowp + bj * 128) = w; } }
    }
};

__device__ __forceinline__ void unpack8(const u32x4 w, float (&f)[8]) {
    f[0] = __uint_as_float(w.x << 16); f[1] = __uint_as_float(w.x & 0xffff0000u); f[2] = __uint_as_float(w.y << 16); f[3] = __uint_as_float(w.y & 0xffff0000u);
    f[4] = __uint_as_float(w.z << 16); f[5] = __uint_as_float(w.z & 0xffff0000u); f[6] = __uint_as_float(w.w << 16); f[7] = __uint_as_float(w.w & 0xffff0000u);
}

struct EpiMerge {
    bf16_t* O; const bf16_t* proj;
    __device__ __forceinline__ void mid(f32x4 (&acc)[2][2][4][2], const Unit& u, int wr, int wc, int fr, int fq) const {
        const int row0 = u.pm * 256 + wr * 64 + fr, col0 = u.pn * 256 + wc * 32 + 8 * fq;
#pragma unroll
        for (int ai = 0; ai < 2; ++ai)
#pragma unroll
            for (int m = 0; m < 4; ++m) { int rr = row0 + ai * 128 + m * 16; asm volatile("" : "+v"(rr)); const bf16_t* rowp = proj + (size_t)rr * DIN + col0;
#pragma unroll
                for (int bj = 0; bj < 2; ++bj) { float ga[8], gb[8]; unpack8(*(const u32x4*)(rowp + C_GA + bj * 128), ga); unpack8(*(const u32x4*)(rowp + C_GB + bj * 128), gb);
#pragma unroll
                    for (int j = 0; j < 8; ++j) { const float ratio = (1.0f + __expf(-gb[j])) / (1.0f + __expf(-ga[j])); acc[ai][bj][m][j >> 2][j & 3] *= ratio; } }
                asm volatile("" ::: "memory"); }
    }
    __device__ __forceinline__ void operator()(const f32x4 (&acc)[2][2][4][2], const Unit& u, int wr, int wc, int fr, int fq) const {
        const int row0 = u.pm * 256 + wr * 64 + fr, col0 = u.pn * 256 + wc * 32 + 8 * fq;
#pragma unroll
        for (int ai = 0; ai < 2; ++ai)
#pragma unroll
            for (int m = 0; m < 4; ++m) { int rr = row0 + ai * 128 + m * 16; asm volatile("" : "+v"(rr)); const size_t r = (size_t)rr;
#pragma unroll
                for (int bj = 0; bj < 2; ++bj) { float gb[8], v[8]; unpack8(*(const u32x4*)(proj + r * DIN + col0 + C_GB + bj * 128), gb);
#pragma unroll
                    for (int j = 0; j < 8; ++j) v[j] = acc[ai][bj][m][j >> 2][j & 3] * sigmoidf_(gb[j]);
                    u32x4 w; w.x = cvt_pk_bf16(v[0], v[1]); w.y = cvt_pk_bf16(v[2], v[3]); w.z = cvt_pk_bf16(v[4], v[5]); w.w = cvt_pk_bf16(v[6], v[7]);
                    *(u32x4*)(O + r * D + col0 + bj * 128) = w; }
                asm volatile("" ::: "memory"); }
    }
};

struct EpiResid {
    bf16_t* O; const float* x; float* ssq;
    __device__ __forceinline__ void mid(f32x4 (&)[2][2][4][2], const Unit&, int, int, int, int) const {}
    __device__ __forceinline__ void operator()(const f32x4 (&acc)[2][2][4][2], const Unit& u, int wr, int wc, int fr, int fq) const {
        const int row0 = u.pm * 256 + wr * 64 + fr, col0 = u.pn * 256 + wc * 32 + 8 * fq;
#pragma unroll
        for (int ai = 0; ai < 2; ++ai)
#pragma unroll
            for (int m = 0; m < 4; ++m) { const size_t r = (size_t)(row0 + ai * 128 + m * 16); float ss = 0.f;
#pragma unroll
                for (int bj = 0; bj < 2; ++bj) { const f32x4 x0 = *(const f32x4*)(x + r * D + col0 + bj * 128), x1 = *(const f32x4*)(x + r * D + col0 + bj * 128 + 4);
                    const f32x4 v0 = acc[ai][bj][m][0] + x0, v1 = acc[ai][bj][m][1] + x1;
                    ss += (v0[0] * v0[0] + v0[1] * v0[1]) + (v0[2] * v0[2] + v0[3] * v0[3]) + (v1[0] * v1[0] + v1[1] * v1[1]) + (v1[2] * v1[2] + v1[3] * v1[3]);
                    u32x4 w; w.x = cvt_pk_bf16(v0[0], v0[1]); w.y = cvt_pk_bf16(v0[2], v0[3]); w.z = cvt_pk_bf16(v1[0], v1[1]); w.w = cvt_pk_bf16(v1[2], v1[3]);
                    *(u32x4*)(O + r * D + col0 + bj * 128) = w; }
                ss += __shfl_xor(ss, 16); ss += __shfl_xor(ss, 32);
                if (fq == 0) atomicAdd(ssq + r, ss); }
    }
};

struct EpiAct {
    bf16_t* act; const int* ltk; const float* ssq; const volatile LAS int* tpre;
    __device__ __forceinline__ void mid(f32x4 (&)[2][2][4][2], const Unit&, int, int, int, int) const {}
    __device__ __forceinline__ void operator()(const f32x4 (&acc)[2][2][4][2], const Unit& u, int wr, int wc, int fr, int fq) const {
        const int tile = tpre[u.e] + u.pm; const int col0 = u.pn * 128 + wc * 32 + 8 * fq;
#pragma unroll
        for (int ai = 0; ai < 2; ++ai)
#pragma unroll
            for (int m = 0; m < 4; ++m) { const int rr = ai * 128 + wr * 64 + m * 16 + fr;
                const int tk = (rr < u.cnt) ? ltk[(size_t)u.e * LCAP + u.pm * 256 + rr] : 0;
                const float rstd = rsqrtf(ssq[tk >> 1] * (1.0f / D) + EPS);
                float v[8];
#pragma unroll
                for (int j = 0; j < 8; ++j) { const float g = acc[ai][0][m][j >> 2][j & 3] * rstd, up = acc[ai][1][m][j >> 2][j & 3] * rstd; v[j] = g * sigmoidf_(g) * up; }
                u32x4 w; w.x = cvt_pk_bf16(v[0], v[1]); w.y = cvt_pk_bf16(v[2], v[3]); w.z = cvt_pk_bf16(v[4], v[5]); w.w = cvt_pk_bf16(v[6], v[7]);
                *(u32x4*)(act + ((size_t)tile * 256 + rr) * DE + col0) = w; }
    }
};

struct EpiDown {
    bf16_t* y; const int* ltk; const float* lw;
    __device__ __forceinline__ void mid(f32x4 (&)[2][2][4][2], const Unit&, int, int, int, int) const {}
    __device__ __forceinline__ void operator()(const f32x4 (&acc)[2][2][4][2], const Unit& u, int wr, int wc, int fr, int fq) const {
        const int col0 = u.pn * 256 + wc * 32 + 8 * fq;
#pragma unroll
        for (int ai = 0; ai < 2; ++ai)
#pragma unroll
            for (int m = 0; m < 4; ++m) { const int rr = ai * 128 + wr * 64 + m * 16 + fr;
                if (rr < u.cnt) { const size_t li = (size_t)u.e * LCAP + u.pm * 256 + rr; const int tk = ltk[li]; const float wt = lw[li];
#pragma unroll
                    for (int bj = 0; bj < 2; ++bj) { const f32x4 v0 = acc[ai][bj][m][0] * wt, v1 = acc[ai][bj][m][1] * wt;
                        u32x4 w; w.x = cvt_pk_bf16(v0[0], v0[1]); w.y = cvt_pk_bf16(v0[2], v0[3]); w.z = cvt_pk_bf16(v1[0], v1[1]); w.w = cvt_pk_bf16(v1[2], v1[3]);
                        *(u32x4*)(y + (size_t)tk * D + col0 + bj * 128) = w; } } }
    }
};

__device__ __forceinline__ void tr_tile(const float* src, int ld_src, bf16_t* dst, int ld_dst, int k0, int n0, int drow0, const float* scale, LAS float* tile) {
    const int tid = threadIdx.x;
    { const int kk = tid >> 4, n4 = (tid & 15) * 4;
#pragma unroll
      for (int p = 0; p < 2; ++p) { const int k = kk + 32 * p; const f32x4 v = *(const f32x4*)(src + (size_t)(k0 + k) * ld_src + n0 + n4); const float s = scale ? scale[k0 + k] : 1.0f;
          tile[k * 65 + n4 + 0] = v[0] * s; tile[k * 65 + n4 + 1] = v[1] * s; tile[k * 65 + n4 + 2] = v[2] * s; tile[k * 65 + n4 + 3] = v[3] * s; } }
    __syncthreads();
    { const int nn = tid >> 3, k8 = (tid & 7) * 8; float f[8];
#pragma unroll
      for (int j = 0; j < 8; ++j) f[j] = tile[(k8 + j) * 65 + nn];
      u32x4 w; w.x = cvt_pk_bf16(f[0], f[1]); w.y = cvt_pk_bf16(f[2], f[3]); w.z = cvt_pk_bf16(f[4], f[5]); w.w = cvt_pk_bf16(f[6], f[7]);
      *(u32x4*)(dst + (size_t)(drow0 + nn) * ld_dst + k0 + k8) = w; }
    __syncthreads();
}

__device__ void p0_prologue(const Params& P, LAS unsigned char* lds, int bid, int nb) {
    const int tid = threadIdx.x, wid = tid >> 6, lane = tid & 63;
    unsigned char* ws = P.ws;
    LAS float* tile = (LAS float*)lds;
    constexpr int T_IN = 16 * 96, T_UPA = 8 * 16, T_UPB = 16 * 16, T_OUT = 16 * 16, T_G = NE * 16 * 8, T_U = NE * 16 * 8, T_D = NE * 8 * 16;
    constexpr int T_TOTAL = T_IN + T_UPA + T_UPB + T_OUT + T_G + T_U + T_D;
    for (int t = bid; t < T_TOTAL; t += nb) {
        int j = t;
        if (j < T_IN) { const int kt = j / 96, ntl = j % 96; tr_tile(P.w_in, DIN, (bf16_t*)(ws + WS_WIN), D, kt * 64, ntl * 64, ntl * 64, nullptr, tile); continue; }
        j -= T_IN;
        if (j < T_UPA) { const int kt = j / 16, ntl = j % 16; tr_tile(P.w_up_a, D, (bf16_t*)(ws + WS_WUP), KUP, kt * 64, ntl * 64, ntl * 64, nullptr, tile); continue; }
        j -= T_UPA;
        if (j < T_UPB) { const int kt = j / 16, ntl = j % 16; tr_tile(P.w_up_b, D, (bf16_t*)(ws + WS_WUP) + 512, KUP, kt * 64, ntl * 64, ntl * 64, nullptr, tile); continue; }
        j -= T_UPB;
        if (j < T_OUT) { const int kt = j / 16, ntl = j % 16; tr_tile(P.w_out, D, (bf16_t*)(ws + WS_WOUT), D, kt * 64, ntl * 64, ntl * 64, nullptr, tile); continue; }
        j -= T_OUT;
        if (j < T_G + T_U) { const bool up = j >= T_G; if (up) j -= T_G; const int e = j / 128, r = j % 128, kt = r / 8, ntl = r % 8; const int c0 = ntl * 64;
            const int drow = (c0 >> 7) * 256 + (c0 & 127) + (up ? 128 : 0);
            tr_tile((up ? P.w_up : P.w_gate) + (size_t)e * D * DE, DE, (bf16_t*)(ws + WS_WGU) + (size_t)e * 1024 * D, D, kt * 64, c0, drow, P.norm2_g, tile); continue; }
        j -= T_G + T_U;
        { const int e = j / 128, r = j % 128, kt = r / 16, ntl = r % 16;
          tr_tile(P.w_down + (size_t)e * DE * D, D, (bf16_t*)(ws + WS_WD) + (size_t)e * D * DE, DE, kt * 64, ntl * 64, ntl * 64, nullptr, tile); }
    }
    { bf16_t* hn = (bf16_t*)(ws + WS_HN);
      for (int r = bid * 8 + wid; r < NTOK; r += nb * 8) {
          const float* xr = P.x + (size_t)r * D + lane * 16; f32x4 v[4]; float ss = 0.f;
#pragma unroll
          for (int q = 0; q < 4; ++q) { v[q] = *(const f32x4*)(xr + 4 * q); ss += v[q][0] * v[q][0] + v[q][1] * v[q][1] + v[q][2] * v[q][2] + v[q][3] * v[q][3]; }
          ss = wave_sum(ss); const float rstd = rsqrtf(ss * (1.0f / D) + EPS);
          float f[16];
#pragma unroll
          for (int q = 0; q < 4; ++q) { const f32x4 g = *(const f32x4*)(P.norm1_g + lane * 16 + 4 * q);
#pragma unroll
              for (int j = 0; j < 4; ++j) f[4 * q + j] = v[q][j] * rstd * g[j]; }
          u32x4 w0, w1; w0.x = cvt_pk_bf16(f[0], f[1]); w0.y = cvt_pk_bf16(f[2], f[3]); w0.z = cvt_pk_bf16(f[4], f[5]); w0.w = cvt_pk_bf16(f[6], f[7]);
          w1.x = cvt_pk_bf16(f[8], f[9]); w1.y = cvt_pk_bf16(f[10], f[11]); w1.z = cvt_pk_bf16(f[12], f[13]); w1.w = cvt_pk_bf16(f[14], f[15]);
          *(u32x4*)(hn + (size_t)r * D + lane * 16) = w0; *(u32x4*)(hn + (size_t)r * D + lane * 16 + 8) = w1; } }
    { LAS float* hm = (LAS float*)lds;
      LAS float* red = (LAS float*)(lds + 65536);
      float* projm = (float*)(ws + WS_PROJM);
      bool have = false;
      for (int cg = nb - 1 - bid; cg < DIN / 64; cg += nb) {
          if (!have) { __syncthreads();
              for (int r = wid; r < NMETA; r += 8) { const float* mr = P.meta + (size_t)r * D; float ss = 0.f;
                  for (int k = lane; k < D; k += 64) { const float v = mr[k]; ss += v * v; }
                  ss = wave_sum(ss); const float rstd = rsqrtf(ss * (1.0f / D) + EPS);
                  for (int k = lane; k < D; k += 64) hm[r * D + k] = mr[k] * rstd * P.norm1_g[k]; }
              have = true; __syncthreads(); }
          const int c = tid & 63, ks = tid >> 6; float a[16];
#pragma unroll
          for (int r = 0; r < 16; ++r) a[r] = 0.f;
          for (int k = ks * 128; k < ks * 128 + 128; ++k) { const float w = P.w_in[(size_t)k * DIN + cg * 64 + c];
#pragma unroll
              for (int r = 0; r < 16; ++r) a[r] += hm[r * D + k] * w; }
#pragma unroll
          for (int r = 0; r < 16; ++r) red[(ks * 16 + r) * 64 + c] = a[r];
          __syncthreads();
          for (int o = tid; o < 16 * 64; o += NTHREADS) { const int r = o >> 6, cc = o & 63; float s = 0.f;
#pragma unroll
              for (int q = 0; q < 8; ++q) s += red[(q * 16 + r) * 64 + cc];
              projm[(size_t)r * DIN + cg * 64 + cc] = s; }
          __syncthreads(); } }
    { float* lb = (float*)(ws + WS_LB);
      for (int d = bid * NTHREADS + tid; d < DHG; d += nb * NTHREADS) lb[d] = sigmoidf_(P.hg_lb[d] - P.hg_lb[DHG + d]);
      bf16_t* wrt = (bf16_t*)(ws + WS_WR);
      for (int o = bid * NTHREADS + tid; o < 48 * D; o += nb * NTHREADS) { const int j = o / D, k = o % D; float v = 0.f;
          if (j < 4) v = P.w_group[(size_t)k * 4 + j] * P.norm2_g[k];
          else if (j < 36) { const int g = (j - 4) >> 3, e = (j - 4) & 7; v = P.w_router[((size_t)g * D + k) * 8 + e] * P.norm2_g[k]; }
          wrt[o] = f2bf(v); }
      float* ssq = (float*)(ws + WS_SSQ);
      for (int o = bid * NTHREADS + tid; o < NTOK; o += nb * NTHREADS) ssq[o] = 0.f; }
}

__device__ __forceinline__ float ldproj(const Params& P, int b, int s, int col) {
    if (s < NMETA) return ((const float*)(P.ws + WS_PROJM))[(size_t)s * DIN + col];
    return bf2f(((const bf16_t*)(P.ws + WS_PROJ))[((size_t)b * SEQ + (s - NMETA)) * DIN + col]);
}

__device__ void hgrn_simple(const Params& P, LAS unsigned char* lds, int unit) {
    constexpr int TC = 32;
    const int tid = threadIdx.x, wid = tid >> 6, lane = tid & 63, b = unit >> 2, h = unit & 3, v = tid & 127, dg = tid >> 7;
    LAS float* fb = (LAS float*)lds; LAS float* kb = fb + TC * 128; LAS float* qb = kb + TC * 128; LAS float* vb = qb + TC * 128; LAS float* op = vb + TC * 128;
    const float* lbp = (const float*)(P.ws + WS_LB);
    bf16_t* oab = (bf16_t*)P.out;
    float S[32];
#pragma unroll
    for (int j = 0; j < 32; ++j) S[j] = 0.f;
    for (int c0 = 0; c0 < TSEQ; c0 += TC) {
        const int len = (TSEQ - c0) < TC ? (TSEQ - c0) : TC;
        __syncthreads();
        for (int idx = tid; idx < len * 128; idx += NTHREADS) { const int t = idx >> 7, d = idx & 127, s = c0 + t;
            const float q = ldproj(P, b, s, C_Q + h * 128 + d), fp = ldproj(P, b, s, C_F + h * 128 + d), iv = ldproj(P, b, s, C_I + h * 128 + d);
            const float lb = lbp[h * 128 + d];
            fb[idx] = lb + (1.0f - lb) * sigmoidf_(fp); kb[idx] = (1.0f - lb) * sigmoidf_(-fp); qb[idx] = q; vb[idx] = iv; }
        __syncthreads();
        for (int t = 0; t < len; ++t) { const float vv = vb[t * 128 + v]; float o = 0.f;
#pragma unroll
            for (int j4 = 0; j4 < 8; ++j4) { const f32x4 f4 = *(const LAS f32x4*)(fb + t * 128 + dg * 32 + j4 * 4), k4 = *(const LAS f32x4*)(kb + t * 128 + dg * 32 + j4 * 4), q4 = *(const LAS f32x4*)(qb + t * 128 + dg * 32 + j4 * 4);
#pragma unroll
                for (int j = 0; j < 4; ++j) { S[j4 * 4 + j] = f4[j] * S[j4 * 4 + j] + k4[j] * vv; o += S[j4 * 4 + j] * q4[j]; } }
            op[(t * 4 + dg) * 128 + v] = o; }
        __syncthreads();
        for (int t = wid; t < len; t += 8) { const int s = c0 + t; if (s < NMETA) continue;
            const float o0 = op[(t * 4 + 0) * 128 + lane] + op[(t * 4 + 1) * 128 + lane] + op[(t * 4 + 2) * 128 + lane] + op[(t * 4 + 3) * 128 + lane];
            const float o1 = op[(t * 4 + 0) * 128 + lane + 64] + op[(t * 4 + 1) * 128 + lane + 64] + op[(t * 4 + 2) * 128 + lane + 64] + op[(t * 4 + 3) * 128 + lane + 64];
            const float ss = wave_sum(o0 * o0 + o1 * o1); const float rstd = rsqrtf(ss * (1.0f / 128.0f) + EPS);
            const size_t row = (size_t)b * SEQ + (s - NMETA);
            const float g0 = P.hg_norm_g[h * 128 + lane], g1 = P.hg_norm_g[h * 128 + lane + 64];
            const float og0 = ldproj(P, b, s, C_OG + h * 128 + lane), og1 = ldproj(P, b, s, C_OG + h * 128 + lane + 64);
            oab[row * KUP + h * 128 + lane] = f2bf(o0 * rstd * g0 * sigmoidf_(og0));
            oab[row * KUP + h * 128 + lane + 64] = f2bf(o1 * rstd * g1 * sigmoidf_(og1)); }
    }
}

__device__ void lru_simple(const Params& P, LAS unsigned char* lds, int unit) {
    constexpr int TC = 64;
    const int tid = threadIdx.x, b = unit >> 3, n = unit & 7, c = tid & 127, tq = tid >> 7, ch = n * 128 + c;
    LAS float* xin = (LAS float*)lds;
    LAS float* xc = xin + (TC + 3) * 128;
    LAS float* ab = xc + TC * 128;
    LAS float* ub = ab + TC * 128;
    bf16_t* oab = (bf16_t*)P.out;
    const float cw0 = P.conv_w[0 * D + ch], cw1 = P.conv_w[1 * D + ch], cw2 = P.conv_w[2 * D + ch], cw3 = P.conv_w[3 * D + ch], cb = P.conv_b[ch];
    const float br = P.b_r[ch], bi = P.b_i[ch];
    const float lamv = P.lam[ch]; const float sp = (lamv > 15.f) ? __expf(-lamv) : log1pf(__expf(-lamv));
    const float* wr = P.w_r + (size_t)n * 128 * 128; const float* wi = P.w_i + (size_t)n * 128 * 128;
    float hcar = 0.f;
    for (int c0 = 0; c0 < TSEQ; c0 += TC) {
        const int len = (TSEQ - c0) < TC ? (TSEQ - c0) : TC;
        __syncthreads();
        for (int idx = tid; idx < (len + 3) * 128; idx += NTHREADS) { const int t = idx >> 7, cc = idx & 127, s = c0 + t - 3;
            xin[idx] = (s >= 0) ? ldproj(P, b, s, C_LX + n * 128 + cc) : 0.f; }
        __syncthreads();
        for (int t = tq; t < len; t += 4) xc[t * 128 + c] = cw0 * xin[t * 128 + c] + cw1 * xin[(t + 1) * 128 + c] + cw2 * xin[(t + 2) * 128 + c] + cw3 * xin[(t + 3) * 128 + c] + cb;
        __syncthreads();
        { float ra[16], ia[16];
#pragma unroll
          for (int j = 0; j < 16; ++j) { ra[j] = 0.f; ia[j] = 0.f; }
          for (int i4 = 0; i4 < 128; i4 += 4) { float w_r4[4], w_i4[4];
#pragma unroll
              for (int q = 0; q < 4; ++q) { w_r4[q] = wr[(size_t)(i4 + q) * 128 + c]; w_i4[q] = wi[(size_t)(i4 + q) * 128 + c]; }
#pragma unroll
              for (int j = 0; j < 16; ++j) { const f32x4 xv = *(const LAS f32x4*)(xc + (tq * 16 + j) * 128 + i4);
#pragma unroll
                  for (int q = 0; q < 4; ++q) { ra[j] += xv[q] * w_r4[q]; ia[j] += xv[q] * w_i4[q]; } } }
#pragma unroll
          for (int j = 0; j < 16; ++j) { const int t = tq * 16 + j; const float r = sigmoidf_(ra[j] + br), ig = sigmoidf_(ia[j] + bi);
              const float log_a = -8.0f * r * sp; const float a = __expf(log_a); const float u = sqrtf(-expm1f(2.0f * log_a)) * (ig * xc[t * 128 + c]);
              ab[t * 128 + c] = a; ub[t * 128 + c] = u; } }
        __syncthreads();
        if (tid < 128) { float hh = hcar; for (int t = 0; t < len; ++t) { hh = ab[t * 128 + c] * hh + ub[t * 128 + c]; ub[t * 128 + c] = hh; } hcar = hh; }
        __syncthreads();
        for (int idx = tid; idx < len * 128; idx += NTHREADS) { const int t = idx >> 7, cc = idx & 127, s = c0 + t; if (s < NMETA) continue;
            const float y = ldproj(P, b, s, C_LY + n * 128 + cc);
            oab[((size_t)b * SEQ + (s - NMETA)) * KUP + 512 + n * 128 + cc] = f2bf(ub[idx] * gelu_tanh(y)); }
    }
}

__device__ void p5_router(const Params& P, LAS unsigned char* lds, int bid, int nb) {
    const int tid = threadIdx.x, wid = tid >> 6, lane = tid & 63;
    unsigned char* ws = P.ws;
    const bf16_t* h2 = (const bf16_t*)(ws + WS_H2); const bf16_t* wrt = (const bf16_t*)(ws + WS_WR); const float* ssq = (const float*)(ws + WS_SSQ);
    int* counts = (int*)(ws + WS_CTL + CTL_CNT); int* ltk = (int*)(ws + WS_LTK); float* lw = (float*)(ws + WS_LW);
    LAS int* lcnt = (LAS int*)lds;
    LAS int* lbase = lcnt + 32;
    LAS int* ae = lbase + 32;
    LAS int* al = ae + 512;
    LAS float* aw = (LAS float*)(al + 512);
    for (int t0 = bid * 256; t0 < NTOK; t0 += nb * 256) {
        __syncthreads();
        if (tid < 32) lcnt[tid] = 0;
        __syncthreads();
        for (int tl = wid; tl < 256; tl += 8) {
            const int tok = t0 + tl;
            float hv[16]; { const u32x4 a = *(const u32x4*)(h2 + (size_t)tok * D + lane * 16), c = *(const u32x4*)(h2 + (size_t)tok * D + lane * 16 + 8);
                float f0[8], f1[8]; unpack8(a, f0); unpack8(c, f1);
#pragma unroll
                for (int j = 0; j < 8; ++j) { hv[j] = f0[j]; hv[8 + j] = f1[j]; } }
            const float rstd = rsqrtf(ssq[tok] * (1.0f / D) + EPS);
            float mylg = 0.f;
#pragma unroll 2
            for (int j = 0; j < 36; ++j) { const u32x4 a = *(const u32x4*)(wrt + (size_t)j * D + lane * 16), c = *(const u32x4*)(wrt + (size_t)j * D + lane * 16 + 8);
                float f0[8], f1[8]; unpack8(a, f0); unpack8(c, f1); float s = 0.f;
#pragma unroll
                for (int q = 0; q < 8; ++q) s += hv[q] * f0[q] + hv[8 + q] * f1[q];
                s = wave_sum(s); mylg = (lane == j) ? s : mylg; }
            {
                float gl[4]; int gs = 0; float gm;
#pragma unroll
                for (int j = 0; j < 4; ++j) gl[j] = __shfl(mylg, j) * rstd + P.b_group[j];
                gm = gl[0];
#pragma unroll
                for (int j = 1; j < 4; ++j) if (gl[j] > gm) { gm = gl[j]; gs = j; }
                float den = 0.f;
#pragma unroll
                for (int j = 0; j < 4; ++j) den += __expf(gl[j] - gm);
                const float psel = 1.0f / den;
                float el[8];
#pragma unroll
                for (int e = 0; e < 8; ++e) el[e] = __shfl(mylg, 4 + gs * 8 + e) * rstd + P.b_router[gs * 8 + e];
                int i0 = 0; float v0 = el[0];
#pragma unroll
                for (int e = 1; e < 8; ++e) if (el[e] > v0) { v0 = el[e]; i0 = e; }
                int i1 = -1; float v1 = -3.0e38f;
#pragma unroll
                for (int e = 0; e < 8; ++e) if (e != i0 && el[e] > v1) { v1 = el[e]; i1 = e; }
                const float e1 = __expf(v1 - v0); const float w0 = psel / (1.0f + e1), w1 = psel * e1 / (1.0f + e1);
                const int ex0 = gs * 8 + i0, ex1 = gs * 8 + i1;
                if (lane == 0) {
                ae[tl * 2] = ex0; al[tl * 2] = __hip_atomic_fetch_add(lcnt + ex0, 1, __ATOMIC_RELAXED, __HIP_MEMORY_SCOPE_WORKGROUP); aw[tl * 2] = w0;
                ae[tl * 2 + 1] = ex1; al[tl * 2 + 1] = __hip_atomic_fetch_add(lcnt + ex1, 1, __ATOMIC_RELAXED, __HIP_MEMORY_SCOPE_WORKGROUP); aw[tl * 2 + 1] = w1; }
            }
        }
        __syncthreads();
        if (tid < 32) lbase[tid] = atomicAdd(counts + tid, lcnt[tid]);
        __syncthreads();
        { const int a = tid; const int e = ae[a]; const int pos = lbase[e] + al[a];
          ltk[(size_t)e * LCAP + pos] = (t0 + (a >> 1)) * 2 + (a & 1); lw[(size_t)e * LCAP + pos] = aw[a]; }
    }
}

__device__ void p8_final(const Params& P, int bid, int nb) {
    const int tid = threadIdx.x, wid = tid >> 6, lane = tid & 63;
    const bf16_t* h2 = (const bf16_t*)(P.ws + WS_H2); const bf16_t* yb = (const bf16_t*)(P.ws + WS_Y);
    for (int r = bid * 8 + wid; r < NTOK; r += nb * 8) {
        float v[16]; float ss = 0.f;
#pragma unroll
        for (int hlf = 0; hlf < 2; ++hlf) { float a[8], y0[8], y1[8];
            unpack8(*(const u32x4*)(h2 + (size_t)r * D + lane * 16 + hlf * 8), a);
            unpack8(*(const u32x4*)(yb + ((size_t)r * 2) * D + lane * 16 + hlf * 8), y0);
            unpack8(*(const u32x4*)(yb + ((size_t)r * 2 + 1) * D + lane * 16 + hlf * 8), y1);
#pragma unroll
            for (int j = 0; j < 8; ++j) { const float t = a[j] + (y0[j] + y1[j]); v[hlf * 8 + j] = t; ss += t * t; } }
        ss = wave_sum(ss); const float rstd = rsqrtf(ss * (1.0f / D) + EPS);
#pragma unroll
        for (int q = 0; q < 4; ++q) { const f32x4 g = *(const f32x4*)(P.final_g + lane * 16 + 4 * q); f32x4 o;
#pragma unroll
            for (int j = 0; j < 4; ++j) o[j] = v[4 * q + j] * rstd * g[j];
            *(f32x4*)(P.out + (size_t)r * D + lane * 16 + 4 * q) = o; }
    }
}

__device__ __forceinline__ void moe_table(const Params& P, volatile LAS int* tpre) {
    if (threadIdx.x == 0) { const int* counts = (const int*)(P.ws + WS_CTL + CTL_CNT); int acc = 0;
        for (int e = 0; e < NE; ++e) { const int cnt = counts[e]; tpre[e] = acc; tpre[40 + e] = cnt; acc += (cnt + 255) >> 8; }
        tpre[NE] = acc; }
    __syncthreads();
}
}

__global__ void __launch_bounds__(NTHREADS, 2) fwd_kernel(Params P) {
    extern __shared__ __attribute__((aligned(16))) unsigned char lds_raw[];
    LAS unsigned char* lds = (LAS unsigned char*)lds_raw;
    const int bid = blockIdx.x, nb = gridDim.x;
    unsigned char* ws = P.ws;
    const int lo = P.ph_lo, hi = P.ph_hi;
    volatile LAS unsigned* xbw = (volatile LAS unsigned*)(lds + LDS_BYTES - 16);
    if (threadIdx.x == 0) { xbw[0] = 0u; xbw[1] = 0u; xbw[2] = 0u; xbw[3] = 0u; }
    __syncthreads();
    XcdBarrier bar; bar.bar = (unsigned*)(ws + WS_CTL + CTL_BAR); bar.x = 0; bar.st = xbw;
    if (hi - lo > 1) bar = xcd_barrier_post((unsigned*)(ws + WS_CTL + CTL_BAR), xbw);
#define SEAM(k) do { if (IN(k) && IN((k) + 1)) xcd_barrier(bar); } while (0)
#ifdef ONLY_PHASE
#define IN(k) ((k) == ONLY_PHASE && lo <= (k) && (k) < hi)
#else
#define IN(k) (lo <= (k) && (k) < hi)
#endif
    if (IN(0)) p0_prologue(P, lds, bid, nb);
    SEAM(0);
    if (IN(1)) { DenseOrder S; S.init(ws + WS_HN, D * 2, ws + WS_WIN, D * 2, NTOK, DIN, nb, bid);
        EpiStoreBf16 E{(bf16_t*)(ws + WS_PROJ), DIN};
        gemm_simple<EpiStoreBf16, DenseOrder, false, 0>(D * 2, D * 2, D, S, E); }
    SEAM(1);
    if (IN(2)) { for (int u = bid; u < 128 + 256; u += nb) { if (u < 128) hgrn_simple(P, lds, u); else lru_simple(P, lds, u - 128); } }
    SEAM(2);
    if (IN(3)) { DenseOrder S; S.init(P.out, KUP * 2, ws + WS_WUP, KUP * 2, NTOK, D, nb, bid);
        EpiMerge E{(bf16_t*)(ws + WS_HN), (const bf16_t*)(ws + WS_PROJ)};
        gemm_simple<EpiMerge, DenseOrder, false, 512>(KUP * 2, KUP * 2, KUP, S, E); }
    SEAM(3);
    if (IN(4)) { DenseOrder S; S.init(ws + WS_HN, D * 2, ws + WS_WOUT, D * 2, NTOK, D, nb, bid);
        EpiResid E{(bf16_t*)(ws + WS_H2), P.x, (float*)(ws + WS_SSQ)};
        gemm_simple<EpiResid, DenseOrder, false, 0>(D * 2, D * 2, D, S, E); }
    SEAM(4);
    if (IN(5)) p5_router(P, lds, bid, nb);
    SEAM(5);
    if (IN(6)) { volatile LAS int* tpre = (volatile LAS int*)(lds + 140 * 1024); __syncthreads(); moe_table(P, tpre);
        MoeOrder S; S.A = (const char*)(ws + WS_H2); S.B = (const char*)(ws + WS_WGU); S.ltk = (const int*)(ws + WS_LTK); S.tpre = tpre; S.nN = 4; S.nunits = tpre[NE] * 4; S.G = nb; S.c = bid;
        S.b_exp = (size_t)1024 * D * 2; S.b_tile = (size_t)256 * D * 2; S.a_row = D * 2; S.gather = true;
        EpiAct E{(bf16_t*)(ws + WS_ACT), (const int*)(ws + WS_LTK), (const float*)(ws + WS_SSQ), tpre};
        gemm_simple<EpiAct, MoeOrder, true, 0>(D * 2, D * 2, D, S, E); }
    SEAM(6);
    if (IN(7)) { volatile LAS int* tpre = (volatile LAS int*)(lds + 140 * 1024); __syncthreads(); moe_table(P, tpre);
        MoeOrder S; S.A = (const char*)(ws + WS_ACT); S.B = (const char*)(ws + WS_WD); S.ltk = (const int*)(ws + WS_LTK); S.tpre = tpre; S.nN = 4; S.nunits = tpre[NE] * 4; S.G = nb; S.c = bid;
        S.b_exp = (size_t)D * DE * 2; S.b_tile = (size_t)256 * DE * 2; S.a_row = DE * 2; S.gather = false;
        EpiDown E{(bf16_t*)(ws + WS_Y), (const int*)(ws + WS_LTK), (const float*)(ws + WS_LW)};
        gemm_simple<EpiDown, MoeOrder, false, 0>(DE * 2, DE * 2, DE, S, E); }
    SEAM(7);
    if (IN(8)) p8_final(P, bid, nb);
#undef IN
#undef SEAM
}

extern "C" void kernel_launch(void* const* d_in, const int* in_sizes, int n_in, void* d_out, int out_size, void* d_ws, size_t ws_size, hipStream_t stream) {
    static int grid = 0;
    if (grid == 0) {
        if (n_in != 25 || in_sizes[0] != NTOK * D || out_size != NTOK * D || ws_size < WS_END) {
            fprintf(stderr, "kernel_launch: unexpected shapes (n_in %d, in0 %d, out %d, ws %zu < %zu); nothing launched\n", n_in, n_in > 0 ? in_sizes[0] : -1, out_size, ws_size, (size_t)WS_END); grid = -1; return; }
        int dev = 0, cus = 0;
        if (hipGetDevice(&dev) != hipSuccess || hipDeviceGetAttribute(&cus, hipDeviceAttributeMultiprocessorCount, dev) != hipSuccess) { grid = -1; return; }
        if (hipFuncSetAttribute((const void*)fwd_kernel, hipFuncAttributeMaxDynamicSharedMemorySize, LDS_BYTES) != hipSuccess) { fprintf(stderr, "kernel_launch: hipFuncSetAttribute failed\n"); grid = -1; return; }
        grid = cus;
    }
    if (grid < 0) return;
    (void)hipMemsetAsync((char*)d_ws + WS_CTL, 0, CTL_ZERO_BYTES, stream);
    Params p{};
    const float** f = (const float**)&p;
    for (int i = 0; i < 25; ++i) f[i] = (const float*)d_in[i];
    p.out = (float*)d_out; p.ws = (unsigned char*)d_ws;
#if NLAUNCH == 1
    p.ph_lo = 0; p.ph_hi = 9;
    hipLaunchKernelGGL(fwd_kernel, dim3(grid), dim3(NTHREADS), LDS_BYTES, stream, p);
#else
    for (int ph = 0; ph < 9; ++ph) { p.ph_lo = ph; p.ph_hi = ph + 1;
        hipLaunchKernelGGL(fwd_kernel, dim3(grid), dim3(NTHREADS), LDS_BYTES, stream, p); }
#endif
}
```

```cpp
#include <hip/hip_runtime.h>
#include <cstdio>
#include <cstdint>

#ifndef FAST_MASK
#define FAST_MASK 0x7ff
#endif
#ifndef NLAUNCH
#define NLAUNCH 1
#endif

#define LAS __attribute__((address_space(3)))
typedef unsigned short bf16_t;
typedef short bf16x8 __attribute__((ext_vector_type(8)));
typedef float f32x4 __attribute__((ext_vector_type(4)));
typedef float f32x2 __attribute__((ext_vector_type(2)));
typedef unsigned u32x4 __attribute__((ext_vector_type(4)));
typedef unsigned u32x2 __attribute__((ext_vector_type(2)));

#define XB_TMO      128
#define XB_XCNT(j)  (256  + 64 * (j))
#define XB_XSUB(j)  (1280 + 64 * (j))
#define XB_XGEN(j)  (2304 + 64 * (j))
#define XB_TOP      3328
#define XB_TOPGEN   3392
#define XCD_BAR_WORDS 3456
#define XB_SPIN_CAP (1u << 18)

__device__ __forceinline__ unsigned xb_ld(unsigned* p)              { return __hip_atomic_load(p, __ATOMIC_RELAXED, __HIP_MEMORY_SCOPE_AGENT); }
__device__ __forceinline__ unsigned xb_add(unsigned* p, unsigned v) { return __hip_atomic_fetch_add(p, v, __ATOMIC_RELAXED, __HIP_MEMORY_SCOPE_AGENT); }
__device__ __forceinline__ unsigned xb_xcc_id() { return (unsigned)__builtin_amdgcn_s_getreg((3 << 11) | 20) & 0xFu; }
#define XB_SPIN(cond, bar) do { unsigned _sp = 0; while (cond) { __builtin_amdgcn_s_sleep(1); \
    if ((++_sp & 255u) == 0u) { if (xb_ld(&(bar)[XB_TMO])) break; if (_sp > XB_SPIN_CAP) { atomicAdd(&(bar)[XB_TMO], 1u); break; } } } } while (0)

struct XcdBarrier {
    unsigned* bar; unsigned x;
    volatile LAS unsigned* st;
};

__device__ __forceinline__ XcdBarrier xcd_barrier_post(unsigned* bar, volatile LAS unsigned* st) {
    XcdBarrier b; b.bar = bar; b.x = xb_xcc_id(); b.st = st;
    if (threadIdx.x == 0) (void)xb_add(&bar[XB_XCNT(b.x)], 1u);
    return b;
}
__device__ __forceinline__ void xcd_barrier_complete(unsigned* bar, unsigned x, unsigned& nloc, unsigned& nx) {
    const unsigned G = gridDim.x * gridDim.y * gridDim.z;
    unsigned sum, cnt, mine, sp = 0u;
    for (;;) {
        sum = 0u; cnt = 0u; mine = 0u;
#pragma unroll
        for (unsigned j = 0; j < 16; ++j) { const unsigned c = xb_ld(&bar[XB_XCNT(j)]); sum += c; cnt += (c > 0u) ? 1u : 0u; mine = (j == x) ? c : mine; }
        if (sum == G) break;
        __builtin_amdgcn_s_sleep(1);
        if ((++sp & 255u) == 0u) { if (xb_ld(&bar[XB_TMO])) break; if (sp > XB_SPIN_CAP) { atomicAdd(&bar[XB_TMO], 1u); break; } }
    }
    nloc = mine > 0u ? mine : 1u; nx = cnt > 0u ? cnt : 1u;
}

__device__ __forceinline__ void xcd_barrier(const XcdBarrier& b) {
    asm volatile("s_waitcnt vmcnt(0)" ::: "memory");
    __syncthreads();
    if (threadIdx.x == 0) {
        unsigned* bar = b.bar;
        __builtin_amdgcn_s_waitcnt(0);
        unsigned nloc = b.st[0], nx = b.st[1];
        if (nloc == 0u) { xcd_barrier_complete(bar, b.x, nloc, nx); b.st[0] = nloc; b.st[1] = nx; }
        const unsigned old = xb_add(&bar[XB_XSUB(b.x)], 1u);
        const unsigned gen = old / nloc;
        if (old + 1u == (gen + 1u) * nloc) {
            __builtin_amdgcn_fence(__ATOMIC_RELEASE, "agent");
            asm volatile("s_waitcnt vmcnt(0)" ::: "memory");
            const unsigned og = xb_add(&bar[XB_TOP], 1u);
            const unsigned tg = og / nx;
            if (og + 1u == (tg + 1u) * nx) xb_add(&bar[XB_TOPGEN], 1u);
            else XB_SPIN(xb_ld(&bar[XB_TOPGEN]) == tg, bar);
            __builtin_amdgcn_fence(__ATOMIC_ACQUIRE, "agent");
            xb_add(&bar[XB_XGEN(b.x)], 1u);
            asm volatile("s_waitcnt vmcnt(0)" ::: "memory");
        } else {
            XB_SPIN(xb_ld(&bar[XB_XGEN(b.x)]) == gen, bar);
            __builtin_amdgcn_fence(__ATOMIC_ACQUIRE, "agent");
            asm volatile("s_waitcnt vmcnt(0)" ::: "memory");
        }
    }
    __syncthreads();
}


namespace {
constexpr int NB = 32, SEQ = 2048, NMETA = 16, D = 1024, NTOK = NB * SEQ;
constexpr int TSEQ = SEQ + NMETA;
constexpr int DIN = 6144, DHG = 512, NE = 32, DE = 512;
constexpr int C_Q = 0, C_F = 512, C_I = 1024, C_OG = 1536, C_LX = 2048, C_LY = 3072, C_GA = 4096, C_GB = 5120;
constexpr int KUP = 1536;
constexpr float EPS = 1e-6f;
constexpr int NTHREADS = 512;
constexpr int LDS_BYTES = 144 * 1024;
constexpr int ACT_ROWS = 139264;
constexpr int LCAP = 65536;

constexpr size_t MiB = 1024ull * 1024ull;
constexpr size_t WS_PROJ = 0;
constexpr size_t WS_H2   = 0;
constexpr size_t WS_Y    = 128 * MiB;
constexpr size_t WS_ACT  = 384 * MiB;
constexpr size_t WS_LTK  = 520 * MiB;
constexpr size_t WS_LW   = 528 * MiB;
constexpr size_t WS_HN   = 768 * MiB;
constexpr size_t WS_W    = 896 * MiB;
constexpr size_t WS_WIN  = WS_W;
constexpr size_t WS_WUP  = WS_WIN + (size_t)DIN * D * 2;
constexpr size_t WS_WOUT = WS_WUP + (size_t)D * KUP * 2;
constexpr size_t WS_WGU  = WS_WOUT + (size_t)D * D * 2;
constexpr size_t WS_WD   = WS_WGU + (size_t)NE * 1024 * D * 2;
constexpr size_t WS_WR   = WS_WD + (size_t)NE * D * DE * 2;
constexpr size_t WS_CTL  = WS_WR + 128 * 1024;
constexpr size_t CTL_BAR = 0, CTL_CNT = 16384;
constexpr size_t CTL_ZERO_BYTES = 16384 + 256;
constexpr size_t WS_SSQ  = WS_CTL + 32768;
constexpr size_t WS_PROJM = WS_SSQ + (size_t)NTOK * 4;
constexpr size_t WS_LB   = WS_PROJM + (size_t)NMETA * DIN * 4;
constexpr size_t WS_METAT = WS_LB + 4096;
constexpr size_t WS_END  = WS_METAT + (size_t)64 * DIN * 2;

struct Params {
    const float *x, *meta, *norm1_g, *w_in, *hg_lb, *hg_norm_g, *conv_w, *conv_b, *w_r, *b_r, *w_i, *b_i, *lam, *w_up_a, *w_up_b, *w_out,
                *norm2_g, *w_group, *b_group, *w_router, *b_router, *w_gate, *w_up, *w_down, *final_g;
    float* out; unsigned char* ws;
    int ph_lo, ph_hi;
};

__device__ __forceinline__ float bf2f(bf16_t b) { return __uint_as_float(((unsigned)b) << 16); }
__device__ __forceinline__ unsigned cvt_pk_bf16(float lo, float hi) { unsigned r; asm volatile("v_cvt_pk_bf16_f32 %0, %1, %2" : "=v"(r) : "v"(lo), "v"(hi)); return r; }
__device__ __forceinline__ bf16_t f2bf(float f) { return (bf16_t)(cvt_pk_bf16(f, 0.f) & 0xffffu); }
__device__ __forceinline__ float sigmoidf_(float x) { return 1.0f / (1.0f + __expf(-x)); }
__device__ __forceinline__ float gelu_tanh(float y) { const float z = 0.7978845608028654f * (y + 0.044715f * y * y * y); const float t = 1.0f - 2.0f / (1.0f + __expf(2.0f * z)); return 0.5f * y * (1.0f + t); }
__device__ __forceinline__ float wave_sum(float v) {
#pragma unroll
    for (int o = 32; o > 0; o >>= 1) v += __shfl_xor(v, o);
    return v;
}
__device__ __forceinline__ int perm32(int rho) { const int n = rho >> 4, i = rho & 15; return 8 * (i >> 2) + 4 * n + (i & 3); }

struct Unit { const char* A; const char* B; int pm, pn, e, cnt; };

struct DenseOrder {
    const char* A; const char* B; int nN, nunits, G, c; size_t a_tile, b_tile;
    __device__ void init(const void* A_, size_t lda_b, const void* B_, size_t ldb_b, int M, int N, int G_, int c_) {
        A = (const char*)A_; B = (const char*)B_; nN = N / 256; nunits = (M / 256) * nN; G = G_; c = c_; a_tile = 256 * lda_b; b_tile = 256 * ldb_b; }
    __device__ __forceinline__ bool next(int i, Unit& u) const {
        const int L = i * G + c; if (L >= nunits) return false;
        u.pm = L / nN; u.pn = L % nN; u.e = 0; u.cnt = 256; u.A = A + (size_t)u.pm * a_tile; u.B = B + (size_t)u.pn * b_tile; return true; }
    __device__ __forceinline__ unsigned row_off(const Unit&, int) const { return 0u; }
};

struct MoeOrder {
    const char* A; const char* B; const int* ltk; const volatile LAS int* tpre; int nN, nunits, G, c; size_t b_exp, b_tile, a_row; bool gather;
    __device__ __forceinline__ bool next(int i, Unit& u) const {
        const int L = i * G + c; if (L >= nunits) return false;
        const int tile = L / nN; u.pn = L % nN;
        int e = 0;
#pragma unroll 1
        while (e < NE - 1 && tile >= tpre[e + 1]) ++e;
        u.e = e; u.pm = tile - tpre[e]; u.cnt = tpre[40 + e] - u.pm * 256;
        u.B = B + (size_t)e * b_exp + (size_t)u.pn * b_tile;
        u.A = gather ? A : A + (size_t)tile * 256 * a_row; return true; }
    __device__ __forceinline__ unsigned row_off(const Unit& u, int r) const {
        const int idx = u.pm * 256 + r; const int tk = (r < u.cnt) ? ltk[(size_t)u.e * LCAP + idx] : 0; return (unsigned)(tk >> 1) * (unsigned)a_row; }
};

template <class Epi, class Sched, bool GATHER, int KMID>
__device__ __forceinline__ void gemm_simple(unsigned lda_b, unsigned ldb_b, int K, const Sched& S, const Epi& E) {
    const int tid = threadIdx.x, wid = tid >> 6, lane = tid & 63, wr = wid >> 2, wc = wid & 3, fr = lane & 15, fq = lane >> 4;
    for (int i = 0;; ++i) {
        Unit u; if (!S.next(i, u)) break;
        f32x4 acc[2][2][4][2];
#pragma unroll
        for (int a = 0; a < 2; ++a)
#pragma unroll
            for (int b = 0; b < 2; ++b)
#pragma unroll
                for (int m = 0; m < 4; ++m)
#pragma unroll
                    for (int n = 0; n < 2; ++n) acc[a][b][m][n] = (f32x4){0.f, 0.f, 0.f, 0.f};
        unsigned aoff[2][4], boff[2][2];
#pragma unroll
        for (int a = 0; a < 2; ++a)
#pragma unroll
            for (int m = 0; m < 4; ++m) { const int r = 128 * a + 64 * wr + 16 * m + fr; aoff[a][m] = (GATHER ? S.row_off(u, r) : (unsigned)r * lda_b) + fq * 16; }
#pragma unroll
        for (int b = 0; b < 2; ++b)
#pragma unroll
            for (int n = 0; n < 2; ++n) { const int wrow = 128 * b + 32 * wc + perm32(16 * n + fr); boff[b][n] = (unsigned)wrow * ldb_b + fq * 16; }
#define GS_KLOOP(k0, k1) _Pragma("unroll 1") for (int k = (k0); k < (k1); k += 32) { \
            bf16x8 av[2][4], bv[2][2]; \
            _Pragma("unroll") for (int a = 0; a < 2; ++a) _Pragma("unroll") for (int m = 0; m < 4; ++m) av[a][m] = *(const bf16x8*)(u.A + aoff[a][m] + k * 2); \
            _Pragma("unroll") for (int b = 0; b < 2; ++b) _Pragma("unroll") for (int n = 0; n < 2; ++n) bv[b][n] = *(const bf16x8*)(u.B + boff[b][n] + k * 2); \
            _Pragma("unroll") for (int a = 0; a < 2; ++a) _Pragma("unroll") for (int b = 0; b < 2; ++b) _Pragma("unroll") for (int m = 0; m < 4; ++m) _Pragma("unroll") for (int n = 0; n < 2; ++n) \
                acc[a][b][m][n] = __builtin_amdgcn_mfma_f32_16x16x32_bf16(bv[b][n], av[a][m], acc[a][b][m][n], 0, 0, 0); }
        if (KMID > 0) { GS_KLOOP(0, KMID) E.mid(acc, u, wr, wc, fr, fq); GS_KLOOP(KMID, K) } else { GS_KLOOP(0, K) }
#undef GS_KLOOP
        E(acc, u, wr, wc, fr, fq);
    }
}


constexpr int HTB = 128 * 64 * 2;
__device__ __forceinline__ int lds_byte(int r, int c) { const int st = (r >> 4) * 2 + (c >> 5), rr = r & 15, cc = c & 31, ob = rr * 64 + cc * 2; return st * 1024 + (ob ^ (((ob >> 9) & 1) << 5)); }
__device__ __forceinline__ void stage_rc(int b, int& R, int& C) { const int st = b / 1024, sb = b % 1024, swz = sb ^ (((sb >> 9) & 1) << 5); R = (st >> 1) * 16 + swz / 64; C = (st & 1) * 32 + (swz % 64) / 2; }

template <class Epi, class Sched, bool GATHER, int KMID>
__device__ __forceinline__ void gemm_phase(LAS unsigned char* lds, unsigned lda_b, unsigned ldb_b, int K, const Sched& S, const Epi& E) {
    const int tid = threadIdx.x, wid = __builtin_amdgcn_readfirstlane(tid >> 6), lane = tid & 63, wr = wid >> 2, wc = wid & 3, fr = lane & 15, fq = lane >> 4;
    const int nt = K / 64;
    unsigned voffB[2], vA[2][2];
#pragma unroll
    for (int i = 0; i < 2; ++i) { int R, C; stage_rc(tid * 16 + i * 8192, R, C); const int Rb = (R & ~31) + perm32(R & 31);
        voffB[i] = (unsigned)Rb * ldb_b + (unsigned)C * 2u; vA[0][i] = (unsigned)R * lda_b + (unsigned)C * 2u; vA[1][i] = vA[0][i]; }
    const size_t kstep = 128;
    const size_t hstepA = GATHER ? 0 : (size_t)128 * lda_b, hstepB = (size_t)128 * ldb_b;
    const unsigned ldsw = (unsigned)wid * 1024u;
    const int aoff = lds_byte(wr * 64 + fr, fq * 8), boff = lds_byte(wc * 32 + fr, fq * 8);
#define PG8_SA(b, h) (((b) * 2 + (h)) * HTB)
#define PG8_SB(b, h) ((4 + (b) * 2 + (h)) * HTB)
#define PG8_STAGE(bufoff, gbase, voff) do { _Pragma("unroll") for (int _i = 0; _i < 2; ++_i) \
        __builtin_amdgcn_global_load_lds((const unsigned*)((const char*)(gbase) + (voff)[_i]), (LAS unsigned*)(lds + (bufoff) + ldsw + _i * 8192), 16, 0, 0); } while (0)
#define PG8_STAGE_A(bufoff, gbase, h) PG8_STAGE(bufoff, (gbase) + (h) * hstepA, vA[GATHER ? (h) : 0])
#define PG8_LDA(dst, b, h) do { _Pragma("unroll") for (int m = 0; m < 4; ++m) _Pragma("unroll") for (int k = 0; k < 2; ++k) dst[m][k] = *(const LAS bf16x8*)(lds + PG8_SA(b, h) + aoff + m * 2048 + k * 1024); } while (0)
#define PG8_LDB(dst, b, h) do { _Pragma("unroll") for (int n = 0; n < 2; ++n) _Pragma("unroll") for (int k = 0; k < 2; ++k) dst[n][k] = *(const LAS bf16x8*)(lds + PG8_SB(b, h) + boff + n * 2048 + k * 1024); } while (0)
#define PG8_MMA(ai, bj, At, Bt) do { __builtin_amdgcn_s_setprio(1); _Pragma("unroll") for (int m = 0; m < 4; ++m) _Pragma("unroll") for (int n = 0; n < 2; ++n) _Pragma("unroll") for (int k = 0; k < 2; ++k) \
        acc[ai][bj][m][n] = __builtin_amdgcn_mfma_f32_16x16x32_bf16(Bt[n][k], At[m][k], acc[ai][bj][m][n], 0, 0, 0); __builtin_amdgcn_s_setprio(0); } while (0)
#define PG8_WAIT_V(n) asm volatile("s_waitcnt vmcnt(" #n ")" ::: "memory")
#define PG8_WAIT_L(n) asm volatile("s_waitcnt lgkmcnt(" #n ")" ::: "memory")
#define PG8_BAR __builtin_amdgcn_s_barrier()
#define PG8_SCHED __builtin_amdgcn_sched_barrier(0)
    Unit cur, nxt; int ui = 0;
    if (!S.next(0, cur)) return;
    f32x4 acc[2][2][4][2];
#pragma unroll
    for (int a = 0; a < 2; ++a)
#pragma unroll
        for (int b = 0; b < 2; ++b)
#pragma unroll
            for (int m = 0; m < 4; ++m)
#pragma unroll
                for (int n = 0; n < 2; ++n) acc[a][b][m][n] = (f32x4){0.f, 0.f, 0.f, 0.f};
    bf16x8 At[4][2], B0[2][2], B1[2][2];
    const char* cA = cur.A; const char* cB = cur.B;
    if constexpr (GATHER) {
#pragma unroll
        for (int h = 0; h < 2; ++h)
#pragma unroll
            for (int i = 0; i < 2; ++i) { int R, C; stage_rc(tid * 16 + i * 8192, R, C); vA[h][i] = S.row_off(cur, h * 128 + R) + (unsigned)C * 2u; }
    }
    PG8_STAGE(PG8_SB(0, 0), cB, voffB); PG8_STAGE(PG8_SB(0, 1), cB + hstepB, voffB); PG8_STAGE_A(PG8_SA(0, 0), cA, 0); PG8_STAGE_A(PG8_SA(0, 1), cA, 1);
    if (wr == 1) PG8_BAR;
    PG8_WAIT_V(2); PG8_BAR;
    PG8_STAGE(PG8_SB(1, 0), cB + kstep, voffB); PG8_STAGE_A(PG8_SA(1, 0), cA + kstep, 0); PG8_STAGE(PG8_SB(1, 1), cB + hstepB + kstep, voffB);
    PG8_WAIT_V(6); PG8_BAR;
    for (;;) {
        const bool has_next = S.next(ui + 1, nxt);
        const char* nA = has_next ? nxt.A : cA; const char* nB = has_next ? nxt.B : cB;
        if constexpr (GATHER) {
            int tz = tid; asm volatile("" : "+v"(tz));
            volatile LAS unsigned* gsave = (volatile LAS unsigned*)(lds + 8 * HTB);
#pragma unroll
            for (int h = 0; h < 2; ++h)
#pragma unroll
                for (int i = 0; i < 2; ++i) { int R, C; stage_rc(tz * 16 + i * 8192, R, C);
                    gsave[(h * 2 + i) * NTHREADS + tz] = has_next ? (S.row_off(nxt, h * 128 + R) + (unsigned)C * 2u) : vA[h][i]; }
        }
        for (int t = 0; t < nt; t += 2) {
            const bool last = (t == nt - 2);
            const char* a1 = cA + (size_t)(t + 1) * kstep;
            const char* a2 = last ? nA : cA + (size_t)(t + 2) * kstep; const char* b2 = last ? nB : cB + (size_t)(t + 2) * kstep;
            const char* a3 = a2 + kstep; const char* b3 = b2 + kstep;
            if (KMID > 0 && t == KMID / 64) E.mid(acc, cur, wr, wc, fr, fq);
            PG8_LDB(B0, 0, 0); PG8_LDB(B1, 0, 1); PG8_SCHED; PG8_LDA(At, 0, 0); PG8_STAGE_A(PG8_SA(1, 1), a1, 1);
            if constexpr (GATHER) { if (last) { volatile LAS unsigned* gsave = (volatile LAS unsigned*)(lds + 8 * HTB);
#pragma unroll
                for (int h = 0; h < 2; ++h)
#pragma unroll
                    for (int i = 0; i < 2; ++i) vA[h][i] = gsave[(h * 2 + i) * NTHREADS + tid]; } }
            PG8_WAIT_V(8); PG8_WAIT_L(0); PG8_BAR; PG8_MMA(0, 0, At, B0); PG8_MMA(0, 1, At, B1); PG8_BAR; PG8_SCHED;
            PG8_LDA(At, 0, 1); PG8_STAGE(PG8_SB(0, 0), b2, voffB); PG8_STAGE(PG8_SB(0, 1), b2 + hstepB, voffB); PG8_STAGE_A(PG8_SA(0, 0), a2, 0);
            PG8_WAIT_V(8); PG8_WAIT_L(0); PG8_BAR; PG8_MMA(1, 0, At, B0); PG8_MMA(1, 1, At, B1); PG8_BAR; PG8_SCHED;
            PG8_LDB(B0, 1, 0); PG8_LDB(B1, 1, 1); PG8_SCHED; PG8_LDA(At, 1, 0); PG8_STAGE_A(PG8_SA(0, 1), a2, 1);
            PG8_WAIT_V(8); PG8_WAIT_L(0); PG8_BAR; PG8_MMA(0, 0, At, B0); PG8_MMA(0, 1, At, B1); PG8_BAR; PG8_SCHED;
            PG8_LDA(At, 1, 1); PG8_STAGE(PG8_SB(1, 0), b3, voffB); PG8_STAGE(PG8_SB(1, 1), b3 + hstepB, voffB); PG8_STAGE_A(PG8_SA(1, 0), a3, 0);
            PG8_WAIT_V(8); PG8_WAIT_L(0); PG8_BAR; PG8_MMA(1, 0, At, B0); PG8_MMA(1, 1, At, B1); PG8_BAR; PG8_SCHED;
        }
        if (wr == 0) PG8_BAR;
        E(acc, cur, wr, wc, fr, fq);
        if (!has_next) break;
#pragma unroll
        for (int a = 0; a < 2; ++a)
#pragma unroll
            for (int b = 0; b < 2; ++b)
#pragma unroll
                for (int m = 0; m < 4; ++m)
#pragma unroll
                    for (int n = 0; n < 2; ++n) acc[a][b][m][n] = (f32x4){0.f, 0.f, 0.f, 0.f};
        cur = nxt; cA = nA; cB = nB; ++ui;
        if (wr == 1) PG8_BAR;
    }
    PG8_WAIT_V(0);
    PG8_BAR;
#undef PG8_SA
#undef PG8_SB
#undef PG8_STAGE
#undef PG8_STAGE_A
#undef PG8_LDA
#undef PG8_LDB
#undef PG8_MMA
#undef PG8_WAIT_V
#undef PG8_WAIT_L
#undef PG8_BAR
#undef PG8_SCHED
}

struct EpiStoreBf16 {
    bf16_t* O; int ldc;
    __device__ __forceinline__ void mid(f32x4 (&)[2][2][4][2], const Unit&, int, int, int, int) const {}
    __device__ __forceinline__ void operator()(const f32x4 (&acc)[2][2][4][2], const Unit& u, int wr, int wc, int fr, int fq) const {
        const int row0 = u.pm * 256 + wr * 64 + fr, col0 = u.pn * 256 + wc * 32 + 8 * fq;
#pragma unroll
        for (int ai = 0; ai < 2; ++ai)
#pragma unroll
            for (int m = 0; m < 4; ++m) { bf16_t* rowp = O + (size_t)(row0 + ai * 128 + m * 16) * ldc + col0;
#pragma unroll
                for (int bj = 0; bj < 2; ++bj) { const f32x4 v0 = acc[ai][bj][m][0], v1 = acc[ai][bj][m][1];
                    u32x4 w; w.x = cvt_pk_bf16(v0[0], v0[1]); w.y = cvt_pk_bf16(v0[2], v0[3]); w.z = cvt_pk_bf16(v1[0], v1[1]); w.w = cvt_pk_bf16(v1[2], v1[3]);
                    *(u32x4*)(rowp + bj * 128) = w; } }
    }
};

__device__ __forceinline__ void unpack8(const u32x4 w, float (&f)[8]) {
    f[0] = __uint_as_float(w.x << 16); f[1] = __uint_as_float(w.x & 0xffff0000u); f[2] = __uint_as_float(w.y << 16); f[3] = __uint_as_float(w.y & 0xffff0000u);
    f[4] = __uint_as_float(w.z << 16); f[5] = __uint_as_float(w.z & 0xffff0000u); f[6] = __uint_as_float(w.w << 16); f[7] = __uint_as_float(w.w & 0xffff0000u);
}

struct EpiMerge {
    bf16_t* O; const bf16_t* proj;
    __device__ __forceinline__ void mid(f32x4 (&acc)[2][2][4][2], const Unit& u, int wr, int wc, int fr, int fq) const {
        const int row0 = u.pm * 256 + wr * 64 + fr, col0 = u.pn * 256 + wc * 32 + 8 * fq;
#pragma unroll
        for (int ai = 0; ai < 2; ++ai)
#pragma unroll
            for (int m = 0; m < 4; ++m) { int rr = row0 + ai * 128 + m * 16; asm volatile("" : "+v"(rr)); const bf16_t* rowp = proj + (size_t)rr * DIN + col0;
#pragma unroll
                for (int bj = 0; bj < 2; ++bj) { float ga[8], gb[8]; unpack8(*(const u32x4*)(rowp + C_GA + bj * 128), ga); unpack8(*(const u32x4*)(rowp + C_GB + bj * 128), gb);
#pragma unroll
                    for (int j = 0; j < 8; ++j) { const float ratio = (1.0f + __expf(-gb[j])) / (1.0f + __expf(-ga[j])); acc[ai][bj][m][j >> 2][j & 3] *= ratio; } }
                asm volatile("" ::: "memory"); }
    }
    __device__ __forceinline__ void operator()(const f32x4 (&acc)[2][2][4][2], const Unit& u, int wr, int wc, int fr, int fq) const {
        const int row0 = u.pm * 256 + wr * 64 + fr, col0 = u.pn * 256 + wc * 32 + 8 * fq;
#pragma unroll
        for (int ai = 0; ai < 2; ++ai)
#pragma unroll
            for (int m = 0; m < 4; ++m) { int rr = row0 + ai * 128 + m * 16; asm volatile("" : "+v"(rr)); const size_t r = (size_t)rr;
#pragma unroll
                for (int bj = 0; bj < 2; ++bj) { float gb[8], v[8]; unpack8(*(const u32x4*)(proj + r * DIN + col0 + C_GB + bj * 128), gb);
#pragma unroll
                    for (int j = 0; j < 8; ++j) v[j] = acc[ai][bj][m][j >> 2][j & 3] * sigmoidf_(gb[j]);
                    u32x4 w; w.x = cvt_pk_bf16(v[0], v[1]); w.y = cvt_pk_bf16(v[2], v[3]); w.z = cvt_pk_bf16(v[4], v[5]); w.w = cvt_pk_bf16(v[6], v[7]);
                    *(u32x4*)(O + r * D + col0 + bj * 128) = w; }
                asm volatile("" ::: "memory"); }
    }
};

struct EpiResid {
    bf16_t* O; const float* x; float* ssq;
    __device__ __forceinline__ void mid(f32x4 (&)[2][2][4][2], const Unit&, int, int, int, int) const {}
    __device__ __forceinline__ void operator()(const f32x4 (&acc)[2][2][4][2], const Unit& u, int wr, int wc, int fr, int fq) const {
        const int row0 = u.pm * 256 + wr * 64 + fr, col0 = u.pn * 256 + wc * 32 + 8 * fq;
#pragma unroll
        for (int ai = 0; ai < 2; ++ai)
#pragma unroll
            for (int m = 0; m < 4; ++m) { const size_t r = (size_t)(row0 + ai * 128 + m * 16); float ss = 0.f;
#pragma unroll
                for (int bj = 0; bj < 2; ++bj) { const f32x4 x0 = *(const f32x4*)(x + r * D + col0 + bj * 128), x1 = *(const f32x4*)(x + r * D + col0 + bj * 128 + 4);
                    const f32x4 v0 = acc[ai][bj][m][0] + x0, v1 = acc[ai][bj][m][1] + x1;
                    ss += (v0[0] * v0[0] + v0[1] * v0[1]) + (v0[2] * v0[2] + v0[3] * v0[3]) + (v1[0] * v1[0] + v1[1] * v1[1]) + (v1[2] * v1[2] + v1[3] * v1[3]);
                    u32x4 w; w.x = cvt_pk_bf16(v0[0], v0[1]); w.y = cvt_pk_bf16(v0[2], v0[3]); w.z = cvt_pk_bf16(v1[0], v1[1]); w.w = cvt_pk_bf16(v1[2], v1[3]);
                    *(u32x4*)(O + r * D + col0 + bj * 128) = w; }
                ss += __shfl_xor(ss, 16); ss += __shfl_xor(ss, 32);
                if (fq == 0) atomicAdd(ssq + r, ss); }
    }
};

struct EpiAct {
    bf16_t* act; const int* ltk; const float* ssq; const volatile LAS int* tpre;
    __device__ __forceinline__ void mid(f32x4 (&)[2][2][4][2], const Unit&, int, int, int, int) const {}
    __device__ __forceinline__ void operator()(const f32x4 (&acc)[2][2][4][2], const Unit& u, int wr, int wc, int fr, int fq) const {
        const int tile = tpre[u.e] + u.pm; const int col0 = u.pn * 128 + wc * 32 + 8 * fq;
#pragma unroll
        for (int ai = 0; ai < 2; ++ai)
#pragma unroll
            for (int m = 0; m < 4; ++m) { const int rr = ai * 128 + wr * 64 + m * 16 + fr;
                const int tk = (rr < u.cnt) ? ltk[(size_t)u.e * LCAP + u.pm * 256 + rr] : 0;
                const float rstd = rsqrtf(ssq[tk >> 1] * (1.0f / D) + EPS);
                float v[8];
#pragma unroll
                for (int j = 0; j < 8; ++j) { const float g = acc[ai][0][m][j >> 2][j & 3] * rstd, up = acc[ai][1][m][j >> 2][j & 3] * rstd; v[j] = g * sigmoidf_(g) * up; }
                u32x4 w; w.x = cvt_pk_bf16(v[0], v[1]); w.y = cvt_pk_bf16(v[2], v[3]); w.z = cvt_pk_bf16(v[4], v[5]); w.w = cvt_pk_bf16(v[6], v[7]);
                *(u32x4*)(act + ((size_t)tile * 256 + rr) * DE + col0) = w; }
    }
};

struct EpiDown {
    bf16_t* y; const int* ltk; const float* lw;
    __device__ __forceinline__ void mid(f32x4 (&)[2][2][4][2], const Unit&, int, int, int, int) const {}
    __device__ __forceinline__ void operator()(const f32x4 (&acc)[2][2][4][2], const Unit& u, int wr, int wc, int fr, int fq) const {
        const int col0 = u.pn * 256 + wc * 32 + 8 * fq;
#pragma unroll
        for (int ai = 0; ai < 2; ++ai)
#pragma unroll
            for (int m = 0; m < 4; ++m) { const int rr = ai * 128 + wr * 64 + m * 16 + fr;
                if (rr < u.cnt) { const size_t li = (size_t)u.e * LCAP + u.pm * 256 + rr; const int tk = ltk[li]; const float wt = lw[li];
#pragma unroll
                    for (int bj = 0; bj < 2; ++bj) { const f32x4 v0 = acc[ai][bj][m][0] * wt, v1 = acc[ai][bj][m][1] * wt;
                        u32x4 w; w.x = cvt_pk_bf16(v0[0], v0[1]); w.y = cvt_pk_bf16(v0[2], v0[3]); w.z = cvt_pk_bf16(v1[0], v1[1]); w.w = cvt_pk_bf16(v1[2], v1[3]);
                        *(u32x4*)(y + (size_t)tk * D + col0 + bj * 128) = w; } } }
    }
};

__device__ __forceinline__ void tr_tile(const float* src, int ld_src, bf16_t* dst, int ld_dst, int k0, int n0, int drow0, const float* scale, LAS float* tile) {
    const int tid = threadIdx.x;
    { const int kk = tid >> 4, n4 = (tid & 15) * 4;
#pragma unroll
      for (int p = 0; p < 2; ++p) { const int k = kk + 32 * p; const f32x4 v = *(const f32x4*)(src + (size_t)(k0 + k) * ld_src + n0 + n4); const float s = scale ? scale[k0 + k] : 1.0f;
          tile[k * 65 + n4 + 0] = v[0] * s; tile[k * 65 + n4 + 1] = v[1] * s; tile[k * 65 + n4 + 2] = v[2] * s; tile[k * 65 + n4 + 3] = v[3] * s; } }
    __syncthreads();
    { const int nn = tid >> 3, k8 = (tid & 7) * 8; float f[8];
#pragma unroll
      for (int j = 0; j < 8; ++j) f[j] = tile[(k8 + j) * 65 + nn];
      u32x4 w; w.x = cvt_pk_bf16(f[0], f[1]); w.y = cvt_pk_bf16(f[2], f[3]); w.z = cvt_pk_bf16(f[4], f[5]); w.w = cvt_pk_bf16(f[6], f[7]);
      *(u32x4*)(dst + (size_t)(drow0 + nn) * ld_dst + k0 + k8) = w; }
    __syncthreads();
}

__device__ void p0_prologue(const Params& P, LAS unsigned char* lds, int bid, int nb) {
    const int tid = threadIdx.x, wid = tid >> 6, lane = tid & 63;
    unsigned char* ws = P.ws;
    LAS float* tile = (LAS float*)lds;
    constexpr int T_IN = 16 * 96, T_UPA = 8 * 16, T_UPB = 16 * 16, T_OUT = 16 * 16, T_G = NE * 16 * 8, T_U = NE * 16 * 8, T_D = NE * 8 * 16;
    constexpr int T_TOTAL = T_IN + T_UPA + T_UPB + T_OUT + T_G + T_U + T_D;
    for (int t = bid; t < T_TOTAL; t += nb) {
        int j = t;
        if (j < T_IN) { const int kt = j / 96, ntl = j % 96; tr_tile(P.w_in, DIN, (bf16_t*)(ws + WS_WIN), D, kt * 64, ntl * 64, ntl * 64, nullptr, tile); continue; }
        j -= T_IN;
        if (j < T_UPA) { const int kt = j / 16, ntl = j % 16; tr_tile(P.w_up_a, D, (bf16_t*)(ws + WS_WUP), KUP, kt * 64, ntl * 64, ntl * 64, nullptr, tile); continue; }
        j -= T_UPA;
        if (j < T_UPB) { const int kt = j / 16, ntl = j % 16; tr_tile(P.w_up_b, D, (bf16_t*)(ws + WS_WUP) + 512, KUP, kt * 64, ntl * 64, ntl * 64, nullptr, tile); continue; }
        j -= T_UPB;
        if (j < T_OUT) { const int kt = j / 16, ntl = j % 16; tr_tile(P.w_out, D, (bf16_t*)(ws + WS_WOUT), D, kt * 64, ntl * 64, ntl * 64, nullptr, tile); continue; }
        j -= T_OUT;
        if (j < T_G + T_U) { const bool up = j >= T_G; if (up) j -= T_G; const int e = j / 128, r = j % 128, kt = r / 8, ntl = r % 8; const int c0 = ntl * 64;
            const int drow = (c0 >> 7) * 256 + (c0 & 127) + (up ? 128 : 0);
            tr_tile((up ? P.w_up : P.w_gate) + (size_t)e * D * DE, DE, (bf16_t*)(ws + WS_WGU) + (size_t)e * 1024 * D, D, kt * 64, c0, drow, P.norm2_g, tile); continue; }
        j -= T_G + T_U;
        { const int e = j / 128, r = j % 128, kt = r / 16, ntl = r % 16;
          tr_tile(P.w_down + (size_t)e * DE * D, D, (bf16_t*)(ws + WS_WD) + (size_t)e * D * DE, DE, kt * 64, ntl * 64, ntl * 64, nullptr, tile); }
    }
    { bf16_t* hn = (bf16_t*)(ws + WS_HN);
      for (int r = bid * 8 + wid; r < NTOK; r += nb * 8) {
          const float* xr = P.x + (size_t)r * D + lane * 16; f32x4 v[4]; float ss = 0.f;
#pragma unroll
          for (int q = 0; q < 4; ++q) { v[q] = *(const f32x4*)(xr + 4 * q); ss += v[q][0] * v[q][0] + v[q][1] * v[q][1] + v[q][2] * v[q][2] + v[q][3] * v[q][3]; }
          ss = wave_sum(ss); const float rstd = rsqrtf(ss * (1.0f / D) + EPS);
          float f[16];
#pragma unroll
          for (int q = 0; q < 4; ++q) { const f32x4 g = *(const f32x4*)(P.norm1_g + lane * 16 + 4 * q);
#pragma unroll
              for (int j = 0; j < 4; ++j) f[4 * q + j] = v[q][j] * rstd * g[j]; }
          u32x4 w0, w1; w0.x = cvt_pk_bf16(f[0], f[1]); w0.y = cvt_pk_bf16(f[2], f[3]); w0.z = cvt_pk_bf16(f[4], f[5]); w0.w = cvt_pk_bf16(f[6], f[7]);
          w1.x = cvt_pk_bf16(f[8], f[9]); w1.y = cvt_pk_bf16(f[10], f[11]); w1.z = cvt_pk_bf16(f[12], f[13]); w1.w = cvt_pk_bf16(f[14], f[15]);
          *(u32x4*)(hn + (size_t)r * D + lane * 16) = w0; *(u32x4*)(hn + (size_t)r * D + lane * 16 + 8) = w1; } }
    { LAS float* hm = (LAS float*)lds;
      LAS float* red = (LAS float*)(lds + 65536);
      float* projm = (float*)(ws + WS_PROJM); bf16_t* metat = (bf16_t*)(ws + WS_METAT);
      bool have = false;
      for (int cg = nb - 1 - bid; cg < DIN / 64; cg += nb) {
          if (!have) { __syncthreads();
              for (int r = wid; r < NMETA; r += 8) { const float* mr = P.meta + (size_t)r * D; float ss = 0.f;
                  for (int k = lane; k < D; k += 64) { const float v = mr[k]; ss += v * v; }
                  ss = wave_sum(ss); const float rstd = rsqrtf(ss * (1.0f / D) + EPS);
                  for (int k = lane; k < D; k += 64) hm[r * D + k] = mr[k] * rstd * P.norm1_g[k]; }
              have = true; __syncthreads(); }
          const int c = tid & 63, ks = tid >> 6; float a[16];
#pragma unroll
          for (int r = 0; r < 16; ++r) a[r] = 0.f;
          for (int k = ks * 128; k < ks * 128 + 128; ++k) { const float w = P.w_in[(size_t)k * DIN + cg * 64 + c];
#pragma unroll
              for (int r = 0; r < 16; ++r) a[r] += hm[r * D + k] * w; }
#pragma unroll
          for (int r = 0; r < 16; ++r) red[(ks * 16 + r) * 64 + c] = a[r];
          __syncthreads();
          for (int o = tid; o < 16 * 64; o += NTHREADS) { const int r = o >> 6, cc = o & 63; float s = 0.f;
#pragma unroll
              for (int q = 0; q < 8; ++q) s += red[(q * 16 + r) * 64 + cc];
              projm[(size_t)r * DIN + cg * 64 + cc] = s; metat[(size_t)(48 + r) * DIN + cg * 64 + cc] = f2bf(s); }
          for (int o = tid; o < 48 * 64; o += NTHREADS) { const int r = o >> 6, col = cg * 64 + (o & 63); metat[(size_t)r * DIN + col] = (col >= C_F && col < C_F + DHG) ? (bf16_t)0x42A0 : (bf16_t)0; }
          __syncthreads(); } }
    { float* lb = (float*)(ws + WS_LB);
      for (int d = bid * NTHREADS + tid; d < DHG; d += nb * NTHREADS) lb[d] = sigmoidf_(P.hg_lb[d] - P.hg_lb[DHG + d]);
      bf16_t* wrt = (bf16_t*)(ws + WS_WR);
      for (int o = bid * NTHREADS + tid; o < 48 * D; o += nb * NTHREADS) { const int j = o / D, k = o % D; float v = 0.f;
          if (j < 4) v = P.w_group[(size_t)k * 4 + j] * P.norm2_g[k];
          else if (j < 36) { const int g = (j - 4) >> 3, e = (j - 4) & 7; v = P.w_router[((size_t)g * D + k) * 8 + e] * P.norm2_g[k]; }
          wrt[o] = f2bf(v); }
      float* ssq = (float*)(ws + WS_SSQ);
      for (int o = bid * NTHREADS + tid; o < NTOK; o += nb * NTHREADS) ssq[o] = 0.f; }
}

__device__ __forceinline__ float ldproj(const Params& P, int b, int s, int col) {
    if (s < NMETA) return ((const float*)(P.ws + WS_PROJM))[(size_t)s * DIN + col];
    return bf2f(((const bf16_t*)(P.ws + WS_PROJ))[((size_t)b * SEQ + (s - NMETA)) * DIN + col]);
}

__device__ void hgrn_simple(const Params& P, LAS unsigned char* lds, int unit) {
    constexpr int TC = 32;
    const int tid = threadIdx.x, wid = tid >> 6, lane = tid & 63, b = unit >> 2, h = unit & 3, v = tid & 127, dg = tid >> 7;
    LAS float* fb = (LAS float*)lds; LAS float* kb = fb + TC * 128; LAS float* qb = kb + TC * 128; LAS float* vb = qb + TC * 128; LAS float* op = vb + TC * 128;
    const float* lbp = (const float*)(P.ws + WS_LB);
    bf16_t* oab = (bf16_t*)P.out;
    float S[32];
#pragma unroll
    for (int j = 0; j < 32; ++j) S[j] = 0.f;
    for (int c0 = 0; c0 < TSEQ; c0 += TC) {
        const int len = (TSEQ - c0) < TC ? (TSEQ - c0) : TC;
        __syncthreads();
        for (int idx = tid; idx < len * 128; idx += NTHREADS) { const int t = idx >> 7, d = idx & 127, s = c0 + t;
            const float q = ldproj(P, b, s, C_Q + h * 128 + d), fp = ldproj(P, b, s, C_F + h * 128 + d), iv = ldproj(P, b, s, C_I + h * 128 + d);
            const float lb = lbp[h * 128 + d];
            fb[idx] = lb + (1.0f - lb) * sigmoidf_(fp); kb[idx] = (1.0f - lb) * sigmoidf_(-fp); qb[idx] = q; vb[idx] = iv; }
        __syncthreads();
        for (int t = 0; t < len; ++t) { const float vv = vb[t * 128 + v]; float o = 0.f;
#pragma unroll
            for (int j4 = 0; j4 < 8; ++j4) { const f32x4 f4 = *(const LAS f32x4*)(fb + t * 128 + dg * 32 + j4 * 4), k4 = *(const LAS f32x4*)(kb + t * 128 + dg * 32 + j4 * 4), q4 = *(const LAS f32x4*)(qb + t * 128 + dg * 32 + j4 * 4);
#pragma unroll
                for (int j = 0; j < 4; ++j) { S[j4 * 4 + j] = f4[j] * S[j4 * 4 + j] + k4[j] * vv; o += S[j4 * 4 + j] * q4[j]; } }
            op[(t * 4 + dg) * 128 + v] = o; }
        __syncthreads();
        for (int t = wid; t < len; t += 8) { const int s = c0 + t; if (s < NMETA) continue;
            const float o0 = op[(t * 4 + 0) * 128 + lane] + op[(t * 4 + 1) * 128 + lane] + op[(t * 4 + 2) * 128 + lane] + op[(t * 4 + 3) * 128 + lane];
            const float o1 = op[(t * 4 + 0) * 128 + lane + 64] + op[(t * 4 + 1) * 128 + lane + 64] + op[(t * 4 + 2) * 128 + lane + 64] + op[(t * 4 + 3) * 128 + lane + 64];
            const float ss = wave_sum(o0 * o0 + o1 * o1); const float rstd = rsqrtf(ss * (1.0f / 128.0f) + EPS);
            const size_t row = (size_t)b * SEQ + (s - NMETA);
            const float g0 = P.hg_norm_g[h * 128 + lane], g1 = P.hg_norm_g[h * 128 + lane + 64];
            const float og0 = ldproj(P, b, s, C_OG + h * 128 + lane), og1 = ldproj(P, b, s, C_OG + h * 128 + lane + 64);
            oab[row * KUP + h * 128 + lane] = f2bf(o0 * rstd * g0 * sigmoidf_(og0));
            oab[row * KUP + h * 128 + lane + 64] = f2bf(o1 * rstd * g1 * sigmoidf_(og1)); }
    }
}

__device__ void lru_simple(const Params& P, LAS unsigned char* lds, int unit) {
    constexpr int TC = 64;
    const int tid = threadIdx.x, b = unit >> 3, n = unit & 7, c = tid & 127, tq = tid >> 7, ch = n * 128 + c;
    LAS float* xin = (LAS float*)lds;
    LAS float* xc = xin + (TC + 3) * 128;
    LAS float* ab = xc + TC * 128;
    LAS float* ub = ab + TC * 128;
    bf16_t* oab = (bf16_t*)P.out;
    const float cw0 = P.conv_w[0 * D + ch], cw1 = P.conv_w[1 * D + ch], cw2 = P.conv_w[2 * D + ch], cw3 = P.conv_w[3 * D + ch], cb = P.conv_b[ch];
    const float br = P.b_r[ch], bi = P.b_i[ch];
    const float lamv = P.lam[ch]; const float sp = (lamv > 15.f) ? __expf(-lamv) : log1pf(__expf(-lamv));
    const float* wr = P.w_r + (size_t)n * 128 * 128; const float* wi = P.w_i + (size_t)n * 128 * 128;
    float hcar = 0.f;
    for (int c0 = 0; c0 < TSEQ; c0 += TC) {
        const int len = (TSEQ - c0) < TC ? (TSEQ - c0) : TC;
        __syncthreads();
        for (int idx = tid; idx < (len + 3) * 128; idx += NTHREADS) { const int t = idx >> 7, cc = idx & 127, s = c0 + t - 3;
            xin[idx] = (s >= 0) ? ldproj(P, b, s, C_LX + n * 128 + cc) : 0.f; }
        __syncthreads();
        for (int t = tq; t < len; t += 4) xc[t * 128 + c] = cw0 * xin[t * 128 + c] + cw1 * xin[(t + 1) * 128 + c] + cw2 * xin[(t + 2) * 128 + c] + cw3 * xin[(t + 3) * 128 + c] + cb;
        __syncthreads();
        { float ra[16], ia[16];
#pragma unroll
          for (int j = 0; j < 16; ++j) { ra[j] = 0.f; ia[j] = 0.f; }
          for (int i4 = 0; i4 < 128; i4 += 4) { float w_r4[4], w_i4[4];
#pragma unroll
              for (int q = 0; q < 4; ++q) { w_r4[q] = wr[(size_t)(i4 + q) * 128 + c]; w_i4[q] = wi[(size_t)(i4 + q) * 128 + c]; }
#pragma unroll
              for (int j = 0; j < 16; ++j) { const f32x4 xv = *(const LAS f32x4*)(xc + (tq * 16 + j) * 128 + i4);
#pragma unroll
                  for (int q = 0; q < 4; ++q) { ra[j] += xv[q] * w_r4[q]; ia[j] += xv[q] * w_i4[q]; } } }
#pragma unroll
          for (int j = 0; j < 16; ++j) { const int t = tq * 16 + j; const float r = sigmoidf_(ra[j] + br), ig = sigmoidf_(ia[j] + bi);
              const float log_a = -8.0f * r * sp; const float a = __expf(log_a); const float u = sqrtf(-expm1f(2.0f * log_a)) * (ig * xc[t * 128 + c]);
              ab[t * 128 + c] = a; ub[t * 128 + c] = u; } }
        __syncthreads();
        if (tid < 128) { float hh = hcar; for (int t = 0; t < len; ++t) { hh = ab[t * 128 + c] * hh + ub[t * 128 + c]; ub[t * 128 + c] = hh; } hcar = hh; }
        __syncthreads();
        for (int idx = tid; idx < len * 128; idx += NTHREADS) { const int t = idx >> 7, cc = idx & 127, s = c0 + t; if (s < NMETA) continue;
            const float y = ldproj(P, b, s, C_LY + n * 128 + cc);
            oab[((size_t)b * SEQ + (s - NMETA)) * KUP + 512 + n * 128 + cc] = f2bf(ub[idx] * gelu_tanh(y)); }
    }
}


constexpr int LT = 272;
__device__ __forceinline__ const bf16_t* seq_row(const Params& P, int b, int c, int t) {
    return c == 0 ? (const bf16_t*)(P.ws + WS_METAT) + (size_t)t * DIN : (const bf16_t*)(P.ws + WS_PROJ) + ((size_t)b * SEQ + (size_t)(c - 1) * 64 + t) * DIN;
}
__device__ __forceinline__ float bflo(unsigned w) { return __uint_as_float(w << 16); }
__device__ __forceinline__ float bfhi(unsigned w) { return __uint_as_float(w & 0xffff0000u); }

__device__ void lru_fast(const Params& P, LAS unsigned char* lds, int unit) {
    const int tid = threadIdx.x, wid = __builtin_amdgcn_readfirstlane(tid >> 6), lane = tid & 63, b = unit >> 3, n = unit & 7, fr = lane & 15, g = lane >> 4;
    LAS unsigned char* XA = lds;
    LAS unsigned char* YT = lds + 64 * LT;
    LAS unsigned char* OT = lds + 128 * LT;
    bf16_t* oab = (bf16_t*)P.out;
    bf16x8 Br[4], Bi[4];
    { const float* wr = P.w_r + (size_t)n * 128 * 128 + wid * 16 + fr; const float* wi = P.w_i + (size_t)n * 128 * 128 + wid * 16 + fr;
#pragma unroll
      for (int ks = 0; ks < 4; ++ks) { unsigned pr[4], pi[4];
#pragma unroll
          for (int j = 0; j < 4; ++j) { const int i0 = 32 * ks + 8 * g + 2 * j;
              pr[j] = cvt_pk_bf16(wr[(size_t)i0 * 128], wr[(size_t)(i0 + 1) * 128]); pi[j] = cvt_pk_bf16(wi[(size_t)i0 * 128], wi[(size_t)(i0 + 1) * 128]); }
          u32x4 tr = {pr[0], pr[1], pr[2], pr[3]}, ti = {pi[0], pi[1], pi[2], pi[3]};
          Br[ks] = __builtin_bit_cast(bf16x8, tr); Bi[ks] = __builtin_bit_cast(bf16x8, ti); } }
    const int chg = n * 128 + wid * 16 + fr;
    const float LOG2E = 1.4426950408889634f;
    const float nbr = -P.b_r[chg] * LOG2E, nbi = -P.b_i[chg] * LOG2E;
    const float lamv = P.lam[chg]; const float c2 = -8.0f * LOG2E * ((lamv > 15.f) ? __expf(-lamv) : log1pf(__expf(-lamv)));
    const int chc = n * 128 + 2 * lane;
    const f32x2 cw0 = *(const f32x2*)(P.conv_w + 0 * D + chc), cw1 = *(const f32x2*)(P.conv_w + 1 * D + chc), cw2 = *(const f32x2*)(P.conv_w + 2 * D + chc), cw3 = *(const f32x2*)(P.conv_w + 3 * D + chc),
                cbv = *(const f32x2*)(P.conv_b + chc);
    float carry = 0.f;
    unsigned xl[11]; u32x4 yv[2];
#define LRU_PREFETCH(c) do { _Pragma("unroll") for (int q = 0; q < 11; ++q) { const int t = wid * 8 + q - 3; \
            const bf16_t* rp = (t >= 0) ? seq_row(P, b, (c), t) : (((c) > 0) ? seq_row(P, b, (c) - 1, t + 64) : nullptr); \
            xl[q] = rp ? *(const unsigned*)(rp + C_LX + n * 128 + 2 * lane) : 0u; } \
        _Pragma("unroll") for (int i = 0; i < 2; ++i) { const int p = tid + NTHREADS * i; yv[i] = *(const u32x4*)(seq_row(P, b, (c), p >> 4) + C_LY + n * 128 + (p & 15) * 8); } } while (0)
    __syncthreads();
    LRU_PREFETCH(0);
    for (int c = 0; c < 33; ++c) {
        { float x0[11], x1[11];
#pragma unroll
          for (int q = 0; q < 11; ++q) { x0[q] = bflo(xl[q]); x1[q] = bfhi(xl[q]); }
#pragma unroll
          for (int q = 0; q < 8; ++q) { const float v0 = cw0[0] * x0[q] + cw1[0] * x0[q + 1] + cw2[0] * x0[q + 2] + cw3[0] * x0[q + 3] + cbv[0];
              const float v1 = cw0[1] * x1[q] + cw1[1] * x1[q + 1] + cw2[1] * x1[q + 2] + cw3[1] * x1[q + 3] + cbv[1];
              *(LAS unsigned*)(XA + (wid * 8 + q) * LT + lane * 4) = cvt_pk_bf16(v0, v1); }
#pragma unroll
          for (int i = 0; i < 2; ++i) { const int p = tid + NTHREADS * i; *(LAS u32x4*)(YT + (p >> 4) * LT + (p & 15) * 16) = yv[i]; } }
        __syncthreads();
        if (c + 1 < 33) LRU_PREFETCH(c + 1);
#pragma unroll
        for (int m = 0; m < 4; ++m) {
            f32x4 ar = {0.f, 0.f, 0.f, 0.f}, ai = {0.f, 0.f, 0.f, 0.f};
#pragma unroll
            for (int ks = 0; ks < 4; ++ks) { const bf16x8 af = *(const LAS bf16x8*)(XA + (16 * m + fr) * LT + ks * 64 + g * 16);
                ar = __builtin_amdgcn_mfma_f32_16x16x32_bf16(af, Br[ks], ar, 0, 0, 0); ai = __builtin_amdgcn_mfma_f32_16x16x32_bf16(af, Bi[ks], ai, 0, 0, 0); }
            float a[4], u[4], yg[4];
#pragma unroll
            for (int j = 0; j < 4; ++j) { const int t = 16 * m + 4 * g + j;
                const float xc = bf2f(*(const LAS bf16_t*)(XA + t * LT + (wid * 16 + fr) * 2)), y = bf2f(*(const LAS bf16_t*)(YT + t * LT + (wid * 16 + fr) * 2));
                const float er = __builtin_amdgcn_exp2f(fminf(fmaf(ar[j], -LOG2E, nbr), 40.f)), ei = __builtin_amdgcn_exp2f(fminf(fmaf(ai[j], -LOG2E, nbi), 40.f));
                const float z2 = (-2.0f * 0.7978845608028654f * LOG2E) * (y + 0.044715f * y * y * y);
                const float eg = __builtin_amdgcn_exp2f(fminf(z2, 40.f));
                const float dr = 1.0f + er, di = 1.0f + ei, dg = 1.0f + eg;
                const float inv = __builtin_amdgcn_rcpf(dr * di * dg);
                const float r = inv * di * dg, ig = inv * dr * dg, sg = inv * dr * di;
                float av = __builtin_amdgcn_exp2f(c2 * r); float uv = __builtin_amdgcn_sqrtf(fmaxf(1.0f - av * av, 0.f)) * (ig * xc);
                if (c == 0 && t < 48) { av = 1.0f; uv = 0.f; }
                a[j] = av; u[j] = uv; yg[j] = y * sg; }
            const float A4 = a[0] * a[1] * a[2] * a[3], U4 = ((u[0] * a[1] + u[1]) * a[2] + u[2]) * a[3] + u[3];
            float H = carry, Hm = carry;
#pragma unroll
            for (int gg = 0; gg < 4; ++gg) { const float Ag = __shfl(A4, fr + 16 * gg), Ug = __shfl(U4, fr + 16 * gg); if (gg == g) Hm = H; H = Ag * H + Ug; }
            carry = H;
            float h = Hm;
#pragma unroll
            for (int j = 0; j < 4; ++j) { h = a[j] * h + u[j]; *(LAS bf16_t*)(OT + (16 * m + 4 * g + j) * LT + (wid * 16 + fr) * 2) = f2bf(h * yg[j]); }
        }
        __syncthreads();
        if (c > 0) {
#pragma unroll
            for (int i = 0; i < 2; ++i) { const int p = tid + NTHREADS * i; const u32x4 v = *(const LAS u32x4*)(OT + (p >> 4) * LT + (p & 15) * 16);
                *(u32x4*)(oab + ((size_t)b * SEQ + (size_t)(c - 1) * 64 + (p >> 4)) * KUP + 512 + n * 128 + (p & 15) * 8) = v; } }
    }
#undef LRU_PREFETCH
}


constexpr int KEP = 144;
__device__ void hgrn_fast(const Params& P, LAS unsigned char* lds, int unit) {
    const int tid = threadIdx.x, wid = __builtin_amdgcn_readfirstlane(tid >> 6), lane = tid & 63, b = unit >> 2, h = unit & 3, fr = lane & 15, g = lane >> 4;
    LAS unsigned char* QG = lds;
    LAS unsigned char* KG = QG + 64 * LT;
    LAS unsigned char* VT = KG + 64 * LT;
    LAS unsigned char* KE = VT + 64 * LT;
    LAS unsigned char* PT = KE + 128 * KEP;
    LAS float* DEC = (LAS float*)(PT + 64 * KEP);
    LAS float* SEG = DEC + 128;
    LAS float* PART = SEG + 8 * 128;
    bf16_t* oab = (bf16_t*)P.out;
    const float LOG2E = 1.4426950408889634f;
    const float* lbp = (const float*)(P.ws + WS_LB) + h * 128 + 2 * lane;
    const float lb0 = lbp[0], lb1 = lbp[1], om0 = 1.0f - lb0, om1 = 1.0f - lb1;
    int pos; { const int d = 2 * lane, kd = d >> 5, r = d & 31; pos = 32 * kd + 8 * ((r >> 2) & 3) + 4 * (r >> 4) + (r & 3); }
    const f32x4 ng = *(const f32x4*)(P.hg_norm_g + h * 128 + wid * 16 + 4 * g);
    f32x4 S[8];
#pragma unroll
    for (int db = 0; db < 8; ++db) S[db] = (f32x4){0.f, 0.f, 0.f, 0.f};
    unsigned qv[8], fv[8]; u32x4 vv[2];
#define HG_PREFETCH(c) do { _Pragma("unroll") for (int q = 0; q < 8; ++q) { const bf16_t* rp = seq_row(P, b, (c), wid * 8 + q) + h * 128 + 2 * lane; \
            qv[q] = *(const unsigned*)(rp + C_Q); fv[q] = *(const unsigned*)(rp + C_F); } \
        _Pragma("unroll") for (int i = 0; i < 2; ++i) { const int p = tid + NTHREADS * i; vv[i] = *(const u32x4*)(seq_row(P, b, (c), p >> 4) + C_I + h * 128 + (p & 15) * 8); } } while (0)
    __syncthreads();
    HG_PREFETCH(0);
    for (int c = 0; c < 33; ++c) {
        float k0[8], k1[8], c0[8], c1[8];
        { float p0 = 1.0f, p1 = 1.0f;
#pragma unroll
          for (int q = 0; q < 8; ++q) { const float x0 = bflo(fv[q]), x1 = bfhi(fv[q]);
              const float e0 = __builtin_amdgcn_exp2f(fminf(-LOG2E * x0, 80.f)), e1 = __builtin_amdgcn_exp2f(fminf(-LOG2E * x1, 80.f));
              const float r0 = __builtin_amdgcn_rcpf(1.0f + e0), r1 = __builtin_amdgcn_rcpf(1.0f + e1);
              const float f0 = lb0 + om0 * r0, f1 = lb1 + om1 * r1;
              k0[q] = om0 * e0 * r0; k1[q] = om1 * e1 * r1;
              p0 *= f0; p1 *= f1; c0[q] = p0; c1[q] = p1; }
          *(LAS f32x2*)(SEG + wid * 128 + 2 * lane) = (f32x2){p0, p1}; }
        __syncthreads();
        { float pre0 = 1.0f, pre1 = 1.0f, tot0 = 1.0f, tot1 = 1.0f;
#pragma unroll
          for (int w2 = 0; w2 < 8; ++w2) { const f32x2 sv = *(const LAS f32x2*)(SEG + w2 * 128 + 2 * lane); if (w2 < wid) { pre0 *= sv[0]; pre1 *= sv[1]; } tot0 *= sv[0]; tot1 *= sv[1]; }
          unsigned ke0[4], ke1[4]; float keb0 = 0.f, keb1 = 0.f;
#pragma unroll
          for (int q = 0; q < 8; ++q) { const float G0 = pre0 * c0[q], G1 = pre1 * c1[q];
              const float rg0 = __builtin_amdgcn_rcpf(G0), rg1 = __builtin_amdgcn_rcpf(G1);
              const float kg0 = k0[q] * rg0, kg1 = k1[q] * rg1;
              const int t = wid * 8 + q;
              *(LAS unsigned*)(QG + t * LT + pos * 2) = cvt_pk_bf16(bflo(qv[q]) * G0, bfhi(qv[q]) * G1);
              *(LAS unsigned*)(KG + t * LT + pos * 2) = cvt_pk_bf16(kg0, kg1);
              const float e0 = kg0 * tot0, e1 = kg1 * tot1;
              if (q & 1) { ke0[q >> 1] = cvt_pk_bf16(keb0, e0); ke1[q >> 1] = cvt_pk_bf16(keb1, e1); } else { keb0 = e0; keb1 = e1; } }
          *(LAS u32x4*)(KE + (2 * lane) * KEP + wid * 16) = (u32x4){ke0[0], ke0[1], ke0[2], ke0[3]};
          *(LAS u32x4*)(KE + (2 * lane + 1) * KEP + wid * 16) = (u32x4){ke1[0], ke1[1], ke1[2], ke1[3]};
          if (wid == 0) *(LAS f32x2*)(DEC + 2 * lane) = (f32x2){tot0, tot1};
#pragma unroll
          for (int i = 0; i < 2; ++i) { const int p = tid + NTHREADS * i; *(LAS u32x4*)(VT + (p >> 4) * LT + (p & 15) * 16) = vv[i]; } }
        __syncthreads();
        if (c + 1 < 33) HG_PREFETCH(c + 1);
        u32x2 ogv[4];
        if (c > 0) {
#pragma unroll
            for (int m = 0; m < 4; ++m) ogv[m] = *(const u32x2*)(seq_row(P, b, c, 16 * m + fr) + C_OG + h * 128 + wid * 16 + 4 * g); }
        if (c > 0) {
            const int tb = wid >> 1;
#pragma unroll
            for (int s2 = 0; s2 < 2; ++s2) { const int sb = 2 * (wid & 1) + s2; f32x4 pt = {0.f, 0.f, 0.f, 0.f};
#pragma unroll
                for (int kd = 0; kd < 4; ++kd) { const bf16x8 kf = *(const LAS bf16x8*)(KG + (16 * sb + fr) * LT + kd * 64 + g * 16), qf = *(const LAS bf16x8*)(QG + (16 * tb + fr) * LT + kd * 64 + g * 16);
                    pt = __builtin_amdgcn_mfma_f32_16x16x32_bf16(kf, qf, pt, 0, 0, 0); }
                const int tg = 16 * tb + fr, sg0 = 16 * sb + 4 * g;
                const float m0 = (sg0 + 0 <= tg) ? pt[0] : 0.f, m1 = (sg0 + 1 <= tg) ? pt[1] : 0.f, m2 = (sg0 + 2 <= tg) ? pt[2] : 0.f, m3 = (sg0 + 3 <= tg) ? pt[3] : 0.f;
                *(LAS u32x2*)(PT + tg * KEP + sg0 * 2) = (u32x2){cvt_pk_bf16(m0, m1), cvt_pk_bf16(m2, m3)}; } }
        __syncthreads();
        bf16x8 Vf[2];
#pragma unroll
        for (int ks = 0; ks < 2; ++ks) { unsigned w4[4];
#pragma unroll
            for (int j = 0; j < 4; ++j) { const int s0 = 32 * ks + 8 * g + 2 * j;
                const unsigned lo = *(const LAS bf16_t*)(VT + s0 * LT + (wid * 16 + fr) * 2), hi = *(const LAS bf16_t*)(VT + (s0 + 1) * LT + (wid * 16 + fr) * 2);
                w4[j] = lo | (hi << 16); }
            u32x4 tv = {w4[0], w4[1], w4[2], w4[3]}; Vf[ks] = __builtin_bit_cast(bf16x8, tv); }
        f32x4 ov[4];
        if (c > 0) {
            bf16x8 Sf[4];
#pragma unroll
            for (int kd = 0; kd < 4; ++kd) { u32x4 tv = {cvt_pk_bf16(S[2 * kd][0], S[2 * kd][1]), cvt_pk_bf16(S[2 * kd][2], S[2 * kd][3]), cvt_pk_bf16(S[2 * kd + 1][0], S[2 * kd + 1][1]), cvt_pk_bf16(S[2 * kd + 1][2], S[2 * kd + 1][3])};
                Sf[kd] = __builtin_bit_cast(bf16x8, tv); }
#pragma unroll
            for (int m = 0; m < 4; ++m) { f32x4 o = {0.f, 0.f, 0.f, 0.f};
#pragma unroll
                for (int ks = 0; ks < 2; ++ks) { const bf16x8 pf = *(const LAS bf16x8*)(PT + (16 * m + fr) * KEP + ks * 64 + g * 16); o = __builtin_amdgcn_mfma_f32_16x16x32_bf16(Vf[ks], pf, o, 0, 0, 0); }
#pragma unroll
                for (int kd = 0; kd < 4; ++kd) { const bf16x8 qf = *(const LAS bf16x8*)(QG + (16 * m + fr) * LT + kd * 64 + g * 16); o = __builtin_amdgcn_mfma_f32_16x16x32_bf16(Sf[kd], qf, o, 0, 0, 0); }
                ov[m] = o; } }
#pragma unroll
        for (int db = 0; db < 8; ++db) { const f32x4 dc = *(const LAS f32x4*)(DEC + 16 * db + 4 * g); f32x4 sa = S[db] * dc;
#pragma unroll
            for (int ks = 0; ks < 2; ++ks) { const bf16x8 kf = *(const LAS bf16x8*)(KE + (16 * db + fr) * KEP + ks * 64 + g * 16); sa = __builtin_amdgcn_mfma_f32_16x16x32_bf16(kf, Vf[ks], sa, 0, 0, 0); }
            S[db] = sa; }
        if (c > 0) {
#pragma unroll
            for (int m = 0; m < 4; ++m) { float pq = ov[m][0] * ov[m][0] + ov[m][1] * ov[m][1] + ov[m][2] * ov[m][2] + ov[m][3] * ov[m][3];
                pq += __shfl_xor(pq, 16); pq += __shfl_xor(pq, 32);
                if (g == 0) PART[(16 * m + fr) * 8 + wid] = pq; } }
        __syncthreads();
        if (c > 0) {
#pragma unroll
            for (int m = 0; m < 4; ++m) { const f32x4 pa = *(const LAS f32x4*)(PART + (16 * m + fr) * 8), pb = *(const LAS f32x4*)(PART + (16 * m + fr) * 8 + 4);
                const float ss = ((pa[0] + pa[1]) + (pa[2] + pa[3])) + ((pb[0] + pb[1]) + (pb[2] + pb[3]));
                const float rstd = rsqrtf(ss * (1.0f / 128.0f) + EPS);
                const float g0 = bflo(ogv[m].x), g1 = bfhi(ogv[m].x), g2 = bflo(ogv[m].y), g3 = bfhi(ogv[m].y);
                const float o0 = ov[m][0] * rstd * ng[0] * __builtin_amdgcn_rcpf(1.0f + __builtin_amdgcn_exp2f(-LOG2E * g0));
                const float o1 = ov[m][1] * rstd * ng[1] * __builtin_amdgcn_rcpf(1.0f + __builtin_amdgcn_exp2f(-LOG2E * g1));
                const float o2 = ov[m][2] * rstd * ng[2] * __builtin_amdgcn_rcpf(1.0f + __builtin_amdgcn_exp2f(-LOG2E * g2));
                const float o3 = ov[m][3] * rstd * ng[3] * __builtin_amdgcn_rcpf(1.0f + __builtin_amdgcn_exp2f(-LOG2E * g3));
                *(u32x2*)(oab + ((size_t)b * SEQ + (size_t)(c - 1) * 64 + 16 * m + fr) * KUP + h * 128 + wid * 16 + 4 * g) = (u32x2){cvt_pk_bf16(o0, o1), cvt_pk_bf16(o2, o3)}; } }
    }
#undef HG_PREFETCH
}

__device__ void p5_router(const Params& P, LAS unsigned char* lds, int bid, int nb) {
    const int tid = threadIdx.x, wid = tid >> 6, lane = tid & 63;
    unsigned char* ws = P.ws;
    const bf16_t* h2 = (const bf16_t*)(ws + WS_H2); const bf16_t* wrt = (const bf16_t*)(ws + WS_WR); const float* ssq = (const float*)(ws + WS_SSQ);
    int* counts = (int*)(ws + WS_CTL + CTL_CNT); int* ltk = (int*)(ws + WS_LTK); float* lw = (float*)(ws + WS_LW);
    LAS int* lcnt = (LAS int*)lds;
    LAS int* lbase = lcnt + 32;
    LAS int* ae = lbase + 32;
    LAS int* al = ae + 512;
    LAS float* aw = (LAS float*)(al + 512);
    for (int t0 = bid * 256; t0 < NTOK; t0 += nb * 256) {
        __syncthreads();
        if (tid < 32) lcnt[tid] = 0;
        __syncthreads();
        for (int tl = wid; tl < 256; tl += 8) {
            const int tok = t0 + tl;
            float hv[16]; { const u32x4 a = *(const u32x4*)(h2 + (size_t)tok * D + lane * 16), c = *(const u32x4*)(h2 + (size_t)tok * D + lane * 16 + 8);
                float f0[8], f1[8]; unpack8(a, f0); unpack8(c, f1);
#pragma unroll
                for (int j = 0; j < 8; ++j) { hv[j] = f0[j]; hv[8 + j] = f1[j]; } }
            const float rstd = rsqrtf(ssq[tok] * (1.0f / D) + EPS);
            float mylg = 0.f;
#pragma unroll 2
            for (int j = 0; j < 36; ++j) { const u32x4 a = *(const u32x4*)(wrt + (size_t)j * D + lane * 16), c = *(const u32x4*)(wrt + (size_t)j * D + lane * 16 + 8);
                float f0[8], f1[8]; unpack8(a, f0); unpack8(c, f1); float s = 0.f;
#pragma unroll
                for (int q = 0; q < 8; ++q) s += hv[q] * f0[q] + hv[8 + q] * f1[q];
                s = wave_sum(s); mylg = (lane == j) ? s : mylg; }
            {
                float gl[4]; int gs = 0; float gm;
#pragma unroll
                for (int j = 0; j < 4; ++j) gl[j] = __shfl(mylg, j) * rstd + P.b_group[j];
                gm = gl[0];
#pragma unroll
                for (int j = 1; j < 4; ++j) if (gl[j] > gm) { gm = gl[j]; gs = j; }
                float den = 0.f;
#pragma unroll
                for (int j = 0; j < 4; ++j) den += __expf(gl[j] - gm);
                const float psel = 1.0f / den;
                float el[8];
#pragma unroll
                for (int e = 0; e < 8; ++e) el[e] = __shfl(mylg, 4 + gs * 8 + e) * rstd + P.b_router[gs * 8 + e];
                int i0 = 0; float v0 = el[0];
#pragma unroll
                for (int e = 1; e < 8; ++e) if (el[e] > v0) { v0 = el[e]; i0 = e; }
                int i1 = -1; float v1 = -3.0e38f;
#pragma unroll
                for (int e = 0; e < 8; ++e) if (e != i0 && el[e] > v1) { v1 = el[e]; i1 = e; }
                const float e1 = __expf(v1 - v0); const float w0 = psel / (1.0f + e1), w1 = psel * e1 / (1.0f + e1);
                const int ex0 = gs * 8 + i0, ex1 = gs * 8 + i1;
                if (lane == 0) {
                ae[tl * 2] = ex0; al[tl * 2] = __hip_atomic_fetch_add(lcnt + ex0, 1, __ATOMIC_RELAXED, __HIP_MEMORY_SCOPE_WORKGROUP); aw[tl * 2] = w0;
                ae[tl * 2 + 1] = ex1; al[tl * 2 + 1] = __hip_atomic_fetch_add(lcnt + ex1, 1, __ATOMIC_RELAXED, __HIP_MEMORY_SCOPE_WORKGROUP); aw[tl * 2 + 1] = w1; }
            }
        }
        __syncthreads();
        if (tid < 32) lbase[tid] = atomicAdd(counts + tid, lcnt[tid]);
        __syncthreads();
        { const int a = tid; const int e = ae[a]; const int pos = lbase[e] + al[a];
          ltk[(size_t)e * LCAP + pos] = (t0 + (a >> 1)) * 2 + (a & 1); lw[(size_t)e * LCAP + pos] = aw[a]; }
    }
}

__device__ void p8_final(const Params& P, int bid, int nb) {
    const int tid = threadIdx.x, wid = tid >> 6, lane = tid & 63;
    const bf16_t* h2 = (const bf16_t*)(P.ws + WS_H2); const bf16_t* yb = (const bf16_t*)(P.ws + WS_Y);
    for (int r = bid * 8 + wid; r < NTOK; r += nb * 8) {
        float v[16]; float ss = 0.f;
#pragma unroll
        for (int hlf = 0; hlf < 2; ++hlf) { float a[8], y0[8], y1[8];
            unpack8(*(const u32x4*)(h2 + (size_t)r * D + lane * 16 + hlf * 8), a);
            unpack8(*(const u32x4*)(yb + ((size_t)r * 2) * D + lane * 16 + hlf * 8), y0);
            unpack8(*(const u32x4*)(yb + ((size_t)r * 2 + 1) * D + lane * 16 + hlf * 8), y1);
#pragma unroll
            for (int j = 0; j < 8; ++j) { const float t = a[j] + (y0[j] + y1[j]); v[hlf * 8 + j] = t; ss += t * t; } }
        ss = wave_sum(ss); const float rstd = rsqrtf(ss * (1.0f / D) + EPS);
#pragma unroll
        for (int q = 0; q < 4; ++q) { const f32x4 g = *(const f32x4*)(P.final_g + lane * 16 + 4 * q); f32x4 o;
#pragma unroll
            for (int j = 0; j < 4; ++j) o[j] = v[4 * q + j] * rstd * g[j];
            *(f32x4*)(P.out + (size_t)r * D + lane * 16 + 4 * q) = o; }
    }
}

__device__ __forceinline__ void moe_table(const Params& P, volatile LAS int* tpre) {
    if (threadIdx.x == 0) { const int* counts = (const int*)(P.ws + WS_CTL + CTL_CNT); int acc = 0;
        for (int e = 0; e < NE; ++e) { const int cnt = counts[e]; tpre[e] = acc; tpre[40 + e] = cnt; acc += (cnt + 255) >> 8; }
        tpre[NE] = acc; }
    __syncthreads();
}
}

__global__ void __launch_bounds__(NTHREADS, 2) fwd_kernel(Params P) {
    extern __shared__ __attribute__((aligned(16))) unsigned char lds_raw[];
    LAS unsigned char* lds = (LAS unsigned char*)lds_raw;
    const int bid = blockIdx.x, nb = gridDim.x;
    unsigned char* ws = P.ws;
    const int lo = P.ph_lo, hi = P.ph_hi;
    volatile LAS unsigned* xbw = (volatile LAS unsigned*)(lds + LDS_BYTES - 16);
    if (threadIdx.x == 0) { xbw[0] = 0u; xbw[1] = 0u; xbw[2] = 0u; xbw[3] = 0u; }
    __syncthreads();
    XcdBarrier bar; bar.bar = (unsigned*)(ws + WS_CTL + CTL_BAR); bar.x = 0; bar.st = xbw;
    if (hi - lo > 1) bar = xcd_barrier_post((unsigned*)(ws + WS_CTL + CTL_BAR), xbw);
#define SEAM(k) do { if (IN(k) && IN((k) + 1)) xcd_barrier(bar); } while (0)
#ifdef ONLY_PHASE
#define IN(k) ((k) == ONLY_PHASE && lo <= (k) && (k) < hi)
#else
#define IN(k) (lo <= (k) && (k) < hi)
#endif
    if (IN(0)) p0_prologue(P, lds, bid, nb);
    SEAM(0);
    if (IN(1)) { DenseOrder S; S.init(ws + WS_HN, D * 2, ws + WS_WIN, D * 2, NTOK, DIN, nb, bid);
        EpiStoreBf16 E{(bf16_t*)(ws + WS_PROJ), DIN};
        if constexpr ((FAST_MASK >> 1) & 1) gemm_phase<EpiStoreBf16, DenseOrder, false, 0>(lds, D * 2, D * 2, D, S, E); else gemm_simple<EpiStoreBf16, DenseOrder, false, 0>(D * 2, D * 2, D, S, E); }
    SEAM(1);
    if (IN(2)) {
        if constexpr (((FAST_MASK >> 9) & 3) == 3) {
            if (nb == 256) { if (bid < 128) hgrn_fast(P, lds, bid); else { lru_fast(P, lds, 2 * (bid - 128)); lru_fast(P, lds, 2 * (bid - 128) + 1); } }
            else for (int u = bid; u < 128 + 256; u += nb) { if (u < 128) hgrn_fast(P, lds, u); else lru_fast(P, lds, u - 128); }
        } else {
            for (int u = bid; u < 128 + 256; u += nb) {
                if (u < 128) { if constexpr ((FAST_MASK >> 10) & 1) hgrn_fast(P, lds, u); else hgrn_simple(P, lds, u); }
                else { if constexpr ((FAST_MASK >> 9) & 1) lru_fast(P, lds, u - 128); else lru_simple(P, lds, u - 128); } } } }
    SEAM(2);
    if (IN(3)) { DenseOrder S; S.init(P.out, KUP * 2, ws + WS_WUP, KUP * 2, NTOK, D, nb, bid);
        EpiMerge E{(bf16_t*)(ws + WS_HN), (const bf16_t*)(ws + WS_PROJ)};
        if constexpr ((FAST_MASK >> 3) & 1) gemm_phase<EpiMerge, DenseOrder, false, 512>(lds, KUP * 2, KUP * 2, KUP, S, E); else gemm_simple<EpiMerge, DenseOrder, false, 512>(KUP * 2, KUP * 2, KUP, S, E); }
    SEAM(3);
    if (IN(4)) { DenseOrder S; S.init(ws + WS_HN, D * 2, ws + WS_WOUT, D * 2, NTOK, D, nb, bid);
        EpiResid E{(bf16_t*)(ws + WS_H2), P.x, (float*)(ws + WS_SSQ)};
        if constexpr ((FAST_MASK >> 4) & 1) gemm_phase<EpiResid, DenseOrder, false, 0>(lds, D * 2, D * 2, D, S, E); else gemm_simple<EpiResid, DenseOrder, false, 0>(D * 2, D * 2, D, S, E); }
    SEAM(4);
    if (IN(5)) p5_router(P, lds, bid, nb);
    SEAM(5);
    if (IN(6)) { volatile LAS int* tpre = (volatile LAS int*)(lds + 140 * 1024); __syncthreads(); moe_table(P, tpre);
        MoeOrder S; S.A = (const char*)(ws + WS_H2); S.B = (const char*)(ws + WS_WGU); S.ltk = (const int*)(ws + WS_LTK); S.tpre = tpre; S.nN = 4; S.nunits = tpre[NE] * 4; S.G = nb; S.c = bid;
        S.b_exp = (size_t)1024 * D * 2; S.b_tile = (size_t)256 * D * 2; S.a_row = D * 2; S.gather = true;
        EpiAct E{(bf16_t*)(ws + WS_ACT), (const int*)(ws + WS_LTK), (const float*)(ws + WS_SSQ), tpre};
        if constexpr ((FAST_MASK >> 6) & 1) gemm_phase<EpiAct, MoeOrder, true, 0>(lds, D * 2, D * 2, D, S, E); else gemm_simple<EpiAct, MoeOrder, true, 0>(D * 2, D * 2, D, S, E); }
    SEAM(6);
    if (IN(7)) { volatile LAS int* tpre = (volatile LAS int*)(lds + 140 * 1024); __syncthreads(); moe_table(P, tpre);
        MoeOrder S; S.A = (const char*)(ws + WS_ACT); S.B = (const char*)(ws + WS_WD); S.ltk = (const int*)(ws + WS_LTK); S.tpre = tpre; S.nN = 4; S.nunits = tpre[NE] * 4; S.G = nb; S.c = bid;
        S.b_exp = (size_t)D * DE * 2; S.b_tile = (size_t)256 * DE * 2; S.a_row = DE * 2; S.gather = false;
        EpiDown E{(bf16_t*)(ws + WS_Y), (const int*)(ws + WS_LTK), (const float*)(ws + WS_LW)};
        if constexpr ((FAST_MASK >> 7) & 1) gemm_phase<EpiDown, MoeOrder, false, 0>(lds, DE * 2, DE * 2, DE, S, E); else gemm_simple<EpiDown, MoeOrder, false, 0>(DE * 2, DE * 2, DE, S, E); }
    SEAM(7);
    if (IN(8)) p8_final(P, bid, nb);
#undef IN
#undef SEAM
}

extern "C" void kernel_launch(void* const* d_in, const int* in_sizes, int n_in, void* d_out, int out_size, void* d_ws, size_t ws_size, hipStream_t stream) {
    static int grid = 0;
    if (grid == 0) {
        if (n_in != 25 || in_sizes[0] != NTOK * D || out_size != NTOK * D || ws_size < WS_END) {
            fprintf(stderr, "kernel_launch: unexpected shapes (n_in %d, in0 %d, out %d, ws %zu < %zu); nothing launched\n", n_in, n_in > 0 ? in_sizes[0] : -1, out_size, ws_size, (size_t)WS_END); grid = -1; return; }
        int dev = 0, cus = 0;
        if (hipGetDevice(&dev) != hipSuccess || hipDeviceGetAttribute(&cus, hipDeviceAttributeMultiprocessorCount, dev) != hipSuccess) { grid = -1; return; }
        if (hipFuncSetAttribute((const void*)fwd_kernel, hipFuncAttributeMaxDynamicSharedMemorySize, LDS_BYTES) != hipSuccess) { fprintf(stderr, "kernel_launch: hipFuncSetAttribute failed\n"); grid = -1; return; }
        grid = cus;
    }
    if (grid < 0) return;
    (void)hipMemsetAsync((char*)d_ws + WS_CTL, 0, CTL_ZERO_BYTES, stream);
    Params p{};
    const float** f = (const float**)&p;
    for (int i = 0; i < 25; ++i) f[i] = (const float*)d_in[i];
    p.out = (float*)d_out; p.ws = (unsigned char*)d_ws;
#if NLAUNCH == 1
    p.ph_lo = 0; p.ph_hi = 9;
    hipLaunchKernelGGL(fwd_kernel, dim3(grid), dim3(NTHREADS), LDS_BYTES, stream, p);
#else
    for (int ph = 0; ph < 9; ++ph) { p.ph_lo = ph; p.ph_hi = ph + 1;
        hipLaunchKernelGGL(fwd_kernel, dim3(grid), dim3(NTHREADS), LDS_BYTES, stream, p); }
#endif
}
```

```cpp
#include <hip/hip_runtime.h>
#include <cstdio>
#include <cstdint>

#ifndef FAST_MASK
#define FAST_MASK 0x7ff
#endif
#ifndef NLAUNCH
#define NLAUNCH 1
#endif

#define LAS __attribute__((address_space(3)))
typedef unsigned short bf16_t;
typedef short bf16x8 __attribute__((ext_vector_type(8)));
typedef float f32x4 __attribute__((ext_vector_type(4)));
typedef float f32x2 __attribute__((ext_vector_type(2)));
typedef unsigned u32x4 __attribute__((ext_vector_type(4)));
typedef unsigned u32x2 __attribute__((ext_vector_type(2)));
typedef __bf16 bf2_t __attribute__((ext_vector_type(2)));

#define XB_TMO      128
#define XB_XCNT(j)  (256  + 64 * (j))
#define XB_XSUB(j)  (1280 + 64 * (j))
#define XB_XGEN(j)  (2304 + 64 * (j))
#define XB_TOP      3328
#define XB_TOPGEN   3392
#define XCD_BAR_WORDS 3456
#define XB_SPIN_CAP (1u << 18)

__device__ __forceinline__ unsigned xb_ld(unsigned* p)              { return __hip_atomic_load(p, __ATOMIC_RELAXED, __HIP_MEMORY_SCOPE_AGENT); }
__device__ __forceinline__ unsigned xb_add(unsigned* p, unsigned v) { return __hip_atomic_fetch_add(p, v, __ATOMIC_RELAXED, __HIP_MEMORY_SCOPE_AGENT); }
__device__ __forceinline__ unsigned xb_xcc_id() { return (unsigned)__builtin_amdgcn_s_getreg((3 << 11) | 20) & 0xFu; }
#define XB_SPIN(cond, bar) do { unsigned _sp = 0; while (cond) { __builtin_amdgcn_s_sleep(1); \
    if ((++_sp & 255u) == 0u) { if (xb_ld(&(bar)[XB_TMO])) break; if (_sp > XB_SPIN_CAP) { atomicAdd(&(bar)[XB_TMO], 1u); break; } } } } while (0)

struct XcdBarrier {
    unsigned* bar; unsigned x;
    volatile LAS unsigned* st;
};

__device__ __forceinline__ XcdBarrier xcd_barrier_post(unsigned* bar, volatile LAS unsigned* st) {
    XcdBarrier b; b.bar = bar; b.x = xb_xcc_id(); b.st = st;
    if (threadIdx.x == 0) (void)xb_add(&bar[XB_XCNT(b.x)], 1u);
    return b;
}
__device__ __forceinline__ void xcd_barrier_complete(unsigned* bar, unsigned x, unsigned& nloc, unsigned& nx) {
    const unsigned G = gridDim.x * gridDim.y * gridDim.z;
    unsigned sum, cnt, mine, sp = 0u;
    for (;;) {
        sum = 0u; cnt = 0u; mine = 0u;
#pragma unroll
        for (unsigned j = 0; j < 16; ++j) { const unsigned c = xb_ld(&bar[XB_XCNT(j)]); sum += c; cnt += (c > 0u) ? 1u : 0u; mine = (j == x) ? c : mine; }
        if (sum == G) break;
        __builtin_amdgcn_s_sleep(1);
        if ((++sp & 255u) == 0u) { if (xb_ld(&bar[XB_TMO])) break; if (sp > XB_SPIN_CAP) { atomicAdd(&bar[XB_TMO], 1u); break; } }
    }
    nloc = mine > 0u ? mine : 1u; nx = cnt > 0u ? cnt : 1u;
}

__device__ __forceinline__ void xcd_barrier(const XcdBarrier& b) {
    asm volatile("s_waitcnt vmcnt(0)" ::: "memory");
    __syncthreads();
    if (threadIdx.x == 0) {
        unsigned* bar = b.bar;
        __builtin_amdgcn_s_waitcnt(0);
        unsigned nloc = b.st[0], nx = b.st[1];
        if (nloc == 0u) { xcd_barrier_complete(bar, b.x, nloc, nx); b.st[0] = nloc; b.st[1] = nx; }
        const unsigned old = xb_add(&bar[XB_XSUB(b.x)], 1u);
        const unsigned gen = old / nloc;
        if (old + 1u == (gen + 1u) * nloc) {
            __builtin_amdgcn_fence(__ATOMIC_RELEASE, "agent");
            asm volatile("s_waitcnt vmcnt(0)" ::: "memory");
            const unsigned og = xb_add(&bar[XB_TOP], 1u);
            const unsigned tg = og / nx;
            if (og + 1u == (tg + 1u) * nx) xb_add(&bar[XB_TOPGEN], 1u);
            else XB_SPIN(xb_ld(&bar[XB_TOPGEN]) == tg, bar);
            __builtin_amdgcn_fence(__ATOMIC_ACQUIRE, "agent");
            xb_add(&bar[XB_XGEN(b.x)], 1u);
            asm volatile("s_waitcnt vmcnt(0)" ::: "memory");
        } else {
            XB_SPIN(xb_ld(&bar[XB_XGEN(b.x)]) == gen, bar);
            __builtin_amdgcn_fence(__ATOMIC_ACQUIRE, "agent");
            asm volatile("s_waitcnt vmcnt(0)" ::: "memory");
        }
    }
    __syncthreads();
}


namespace {
constexpr int NB = 32, SEQ = 2048, NMETA = 16, D = 1024, NTOK = NB * SEQ;
constexpr int TSEQ = SEQ + NMETA;
constexpr int DIN = 6144, DHG = 512, NE = 32, DE = 512;
constexpr int C_Q = 0, C_F = 512, C_I = 1024, C_OG = 1536, C_LX = 2048, C_LY = 3072, C_GA = 4096, C_GB = 5120;
constexpr int KUP = 1536;
constexpr float EPS = 1e-6f;
constexpr int NTHREADS = 512;
constexpr int LDS_BYTES = 144 * 1024;
constexpr int ACT_ROWS = 139264;
constexpr int LCAP = 65536;
constexpr float WD_SCALE = 32.0f, WGU_SCALE = 64.0f, ACT_SCALE = 8.0f, Y_SCALE = 16.0f;

constexpr size_t MiB = 1024ull * 1024ull;
constexpr size_t WS_PROJ = 0;
constexpr size_t WS_H2   = 0;
constexpr size_t WS_Y    = 128 * MiB;
constexpr size_t WS_ACT  = 384 * MiB;
constexpr size_t WS_LTK  = 520 * MiB;
constexpr size_t WS_LW   = 528 * MiB;
constexpr size_t WS_LRS  = 608 * MiB;
constexpr size_t WS_YDUMMY = 600 * MiB;
constexpr int Y_DUMMY_ROW = (int)((600 * MiB - 128 * MiB) / 1024);
constexpr size_t WS_H2Q  = 536 * MiB;
constexpr size_t WS_HN   = 768 * MiB;
constexpr size_t WS_W    = 896 * MiB;
constexpr size_t WS_WIN  = WS_W;
constexpr size_t WS_WUP  = WS_WIN + (size_t)DIN * D * 2;
constexpr size_t WS_WOUT = WS_WUP + (size_t)D * KUP * 2;
constexpr size_t WS_WGU  = WS_WOUT + (size_t)D * D * 2;
constexpr size_t WS_WD   = WS_WGU + (size_t)NE * 1024 * D * 2;
constexpr size_t WS_WR   = WS_WD + (size_t)NE * D * DE * 2;
constexpr size_t WS_CTL  = WS_WR + 128 * 1024;
constexpr size_t CTL_BAR = 0, CTL_CNT = 16384;
constexpr size_t CTL_ZERO_BYTES = 16384 + 256;
constexpr size_t WS_SSQ  = WS_CTL + 32768;
constexpr size_t WS_PROJM = WS_SSQ + (size_t)NTOK * 4;
constexpr size_t WS_LB   = WS_PROJM + (size_t)NMETA * DIN * 4;
constexpr size_t WS_METAT = WS_LB + 4096;
constexpr size_t WS_END  = WS_METAT + (size_t)64 * DIN * 2;

struct Params {
    const float *x, *meta, *norm1_g, *w_in, *hg_lb, *hg_norm_g, *conv_w, *conv_b, *w_r, *b_r, *w_i, *b_i, *lam, *w_up_a, *w_up_b, *w_out,
                *norm2_g, *w_group, *b_group, *w_router, *b_router, *w_gate, *w_up, *w_down, *final_g;
    float* out; unsigned char* ws;
    int ph_lo, ph_hi;
};

__device__ __forceinline__ float bf2f(bf16_t b) { return __uint_as_float(((unsigned)b) << 16); }
__device__ __forceinline__ unsigned cvt_pk_bf16(float lo, float hi) { unsigned r; asm volatile("v_cvt_pk_bf16_f32 %0, %1, %2" : "=v"(r) : "v"(lo), "v"(hi)); return r; }
__device__ __forceinline__ bf16_t f2bf(float f) { return (bf16_t)(cvt_pk_bf16(f, 0.f) & 0xffffu); }
__device__ __forceinline__ float sigmoidf_(float x) { return 1.0f / (1.0f + __expf(-x)); }
__device__ __forceinline__ float gelu_tanh(float y) { const float z = 0.7978845608028654f * (y + 0.044715f * y * y * y); const float t = 1.0f - 2.0f / (1.0f + __expf(2.0f * z)); return 0.5f * y * (1.0f + t); }
__device__ __forceinline__ float wave_sum(float v) {
#pragma unroll
    for (int o = 32; o > 0; o >>= 1) v += __shfl_xor(v, o);
    return v;
}
__device__ __forceinline__ unsigned pack4_fp8(float a, float b, float c, float d) {
    a = __builtin_amdgcn_fmed3f(a, -448.f, 448.f); b = __builtin_amdgcn_fmed3f(b, -448.f, 448.f); c = __builtin_amdgcn_fmed3f(c, -448.f, 448.f); d = __builtin_amdgcn_fmed3f(d, -448.f, 448.f);
    int v = __builtin_amdgcn_cvt_pk_fp8_f32(a, b, 0, false); v = __builtin_amdgcn_cvt_pk_fp8_f32(c, d, v, true); return (unsigned)v; }
__device__ __forceinline__ int perm32(int rho) { const int n = rho >> 4, i = rho & 15; return 8 * (i >> 2) + 4 * n + (i & 3); }

struct Unit { const char* A; const char* B; int pm, pn, e, cnt, tile, slot; };

__device__ __forceinline__ int xcd_remap(int L, int nwg) {
    const int q = nwg / 8, r = nwg % 8, xcd = L % 8, off = L / 8; return (xcd < r ? xcd * (q + 1) : r * (q + 1) + (xcd - r) * q) + off; }
template <int NN>
struct DenseOrder {
    const char* A; const char* B; int nunits, G, c; size_t a_tile, b_tile;
    __device__ void init(const void* A_, size_t lda_b, const void* B_, size_t ldb_b, int M, int N, int G_, int c_) {
        A = (const char*)A_; B = (const char*)B_; nunits = (M / 256) * NN; G = G_; c = c_; a_tile = 256 * lda_b; b_tile = 256 * ldb_b; }
    __device__ __forceinline__ bool next(int i, Unit& u) const {
        const int L = i * G + c; if (L >= nunits) return false;
        const int W = xcd_remap(L, nunits);
        constexpr int nig = 8 * NN; const int gid = W / nig, w = W - gid * nig;
        u.pm = gid * 8 + (w & 7); u.pn = w >> 3; u.e = 0; u.cnt = 256; u.tile = 0; u.A = A + (size_t)u.pm * a_tile; u.B = B + (size_t)u.pn * b_tile; return true; }
    __device__ __forceinline__ unsigned row_off(const Unit&, int) const { return 0u; }
};

constexpr int T2E = 128;
constexpr int LS_OFF = 136 * 1024;
struct MoeOrder {
    const char* A; const char* B; const int* ltk; const float* lf; const volatile LAS int* tpre; int nN, nunits, G, c; size_t b_exp, b_tile, a_row; bool gather;
    __device__ __forceinline__ void stage_lists(const Unit& u, LAS unsigned char* lds, int wid) const {
        const size_t base = (size_t)u.e * LCAP + (size_t)u.pm * 256; LAS unsigned char* slot = lds + LS_OFF + u.slot * 2048; const int lane = threadIdx.x & 63;
        if (wid == 4) __builtin_amdgcn_global_load_lds((const unsigned*)(ltk + base) + lane * 4, (LAS unsigned*)slot, 16, 0, 0);
        else if (wid == 5) __builtin_amdgcn_global_load_lds((const unsigned*)(lf + base) + lane * 4, (LAS unsigned*)(slot + 1024), 16, 0, 0); }
    __device__ __forceinline__ unsigned row_off_lds(const Unit& u, int r, LAS unsigned char* lds) const {
        if (!gather) return (unsigned)(u.tile * 256 + r) * (unsigned)a_row;
        const volatile LAS int* ls = (const volatile LAS int*)(lds + LS_OFF + u.slot * 2048); const int tk = (r < u.cnt) ? ls[r] : 0; return (unsigned)(tk >> 1) * (unsigned)a_row; }
    __device__ __forceinline__ bool next(int i, Unit& u) const {
        const int L0 = i * G + c; if (L0 >= nunits) return false;
        const int L = xcd_remap(L0, nunits);
        const int tile = L / nN; u.pn = L % nN;
        const int e = __builtin_amdgcn_readfirstlane(tpre[T2E + tile]);
        u.e = e; u.pm = tile - __builtin_amdgcn_readfirstlane(tpre[e]); u.cnt = __builtin_amdgcn_readfirstlane(tpre[40 + e]) - u.pm * 256;
        u.B = B + (size_t)e * b_exp + (size_t)u.pn * b_tile; u.tile = tile;
        u.A = A; return true; }
    __device__ __forceinline__ unsigned row_off(const Unit& u, int r) const {
        if (!gather) return (unsigned)(u.tile * 256 + r) * (unsigned)a_row;
        const int idx = u.pm * 256 + r; const int tk = (r < u.cnt) ? ltk[(size_t)u.e * LCAP + idx] : 0; return (unsigned)(tk >> 1) * (unsigned)a_row; }
};

template <class Epi, class Sched, bool GATHER, int KMID>
__device__ __forceinline__ void gemm_simple(unsigned lda_b, unsigned ldb_b, int K, const Sched& S, const Epi& E) {
    const int tid = threadIdx.x, wid = tid >> 6, lane = tid & 63, wr = wid >> 2, wc = wid & 3, fr = lane & 15, fq = lane >> 4;
    for (int i = 0;; ++i) {
        Unit u; if (!S.next(i, u)) break;
        f32x4 acc[2][2][4][2];
#pragma unroll
        for (int a = 0; a < 2; ++a)
#pragma unroll
            for (int b = 0; b < 2; ++b)
#pragma unroll
                for (int m = 0; m < 4; ++m)
#pragma unroll
                    for (int n = 0; n < 2; ++n) acc[a][b][m][n] = (f32x4){0.f, 0.f, 0.f, 0.f};
        unsigned aoff[2][4], boff[2][2];
#pragma unroll
        for (int a = 0; a < 2; ++a)
#pragma unroll
            for (int m = 0; m < 4; ++m) { const int r = 128 * a + 64 * wr + 16 * m + fr; aoff[a][m] = (GATHER ? S.row_off(u, r) : (unsigned)r * lda_b) + fq * 16; }
#pragma unroll
        for (int b = 0; b < 2; ++b)
#pragma unroll
            for (int n = 0; n < 2; ++n) { const int wrow = 128 * b + 32 * wc + perm32(16 * n + fr); boff[b][n] = (unsigned)wrow * ldb_b + fq * 16; }
#define GS_KLOOP(k0, k1) _Pragma("unroll 1") for (int k = (k0); k < (k1); k += 32) { \
            bf16x8 av[2][4], bv[2][2]; \
            _Pragma("unroll") for (int a = 0; a < 2; ++a) _Pragma("unroll") for (int m = 0; m < 4; ++m) av[a][m] = *(const bf16x8*)(u.A + aoff[a][m] + k * 2); \
            _Pragma("unroll") for (int b = 0; b < 2; ++b) _Pragma("unroll") for (int n = 0; n < 2; ++n) bv[b][n] = *(const bf16x8*)(u.B + boff[b][n] + k * 2); \
            _Pragma("unroll") for (int a = 0; a < 2; ++a) _Pragma("unroll") for (int b = 0; b < 2; ++b) _Pragma("unroll") for (int m = 0; m < 4; ++m) _Pragma("unroll") for (int n = 0; n < 2; ++n) \
                acc[a][b][m][n] = __builtin_amdgcn_mfma_f32_16x16x32_bf16(bv[b][n], av[a][m], acc[a][b][m][n], 0, 0, 0); }
        if (KMID > 0) { GS_KLOOP(0, KMID) E.mid(acc, u, wr, wc, fr, fq); GS_KLOOP(KMID, K) } else { GS_KLOOP(0, K) }
#undef GS_KLOOP
        E(acc, u, wr, wc, fr, fq);
    }
}


constexpr int HTB = 128 * 64 * 2;
__device__ __forceinline__ int lds_byte(int r, int c) { const int st = (r >> 4) * 2 + (c >> 5), rr = r & 15, cc = c & 31, ob = rr * 64 + cc * 2; return st * 1024 + (ob ^ (((ob >> 9) & 1) << 5)); }
__device__ __forceinline__ void stage_rc(int b, int& R, int& C) { const int st = b / 1024, sb = b % 1024, swz = sb ^ (((sb >> 9) & 1) << 5); R = (st >> 1) * 16 + swz / 64; C = (st & 1) * 32 + (swz % 64) / 2; }

typedef int v8i32 __attribute__((ext_vector_type(8)));
typedef int v4i32 __attribute__((ext_vector_type(4)));
template <class Epi, class Sched, bool GATHER, int KMID, bool F8 = false>
__device__ __forceinline__ void gemm_phase(LAS unsigned char* lds, unsigned lda_b, unsigned ldb_b, int K  , const Sched& S, const Epi& E) {
    const int tid = threadIdx.x, wid = __builtin_amdgcn_readfirstlane(tid >> 6), lane = tid & 63, wr = wid >> 2, wc = wid & 3, fr = lane & 15, fq = lane >> 4;
    const int nt = K / 64;
    unsigned voffB[2], vA[2][2];
#pragma unroll
    for (int i = 0; i < 2; ++i) { int R, C; stage_rc(tid * 16 + i * 8192, R, C); const int Rb = (R & ~31) + perm32(R & 31);
        voffB[i] = (unsigned)Rb * ldb_b + (unsigned)C * 2u; vA[0][i] = (unsigned)R * lda_b + (unsigned)C * 2u; vA[1][i] = vA[0][i]; }
    const size_t kstep = 128;
    const size_t hstepA = GATHER ? 0 : (size_t)128 * lda_b, hstepB = (size_t)128 * ldb_b;
    const unsigned ldsw = (unsigned)wid * 1024u;
    const int aoff = lds_byte(wr * 64 + fr, fq * 8), boff = lds_byte(wc * 32 + fr, fq * 8);
#define PG8_SA(b, h) (((b) * 2 + (h)) * HTB)
#define PG8_SB(b, h) ((4 + (b) * 2 + (h)) * HTB)
#define PG8_STAGE(bufoff, gbase, voff) do { _Pragma("unroll") for (int _i = 0; _i < 2; ++_i) \
        __builtin_amdgcn_global_load_lds((const unsigned*)((const char*)(gbase) + (voff)[_i]), (LAS unsigned*)(lds + (bufoff) + ldsw + _i * 8192), 16, 0, 0); } while (0)
#define PG8_STAGE_A(bufoff, gbase, h) PG8_STAGE(bufoff, (gbase) + (h) * hstepA, vA[GATHER ? (h) : 0])
#define PG8_LDA(dst, b, h) do { _Pragma("unroll") for (int m = 0; m < 4; ++m) { if constexpr (F8) { const v4i32 _l = *(const LAS v4i32*)(lds + PG8_SA(b, h) + aoff + m * 2048), _h = *(const LAS v4i32*)(lds + PG8_SA(b, h) + aoff + m * 2048 + 1024); \
            dst##8[m] = __builtin_shufflevector(_l, _h, 0, 1, 2, 3, 4, 5, 6, 7); } else { _Pragma("unroll") for (int k = 0; k < 2; ++k) dst[m][k] = *(const LAS bf16x8*)(lds + PG8_SA(b, h) + aoff + m * 2048 + k * 1024); } } } while (0)
#define PG8_LDB(dst, b, h) do { _Pragma("unroll") for (int n = 0; n < 2; ++n) { if constexpr (F8) { const v4i32 _l = *(const LAS v4i32*)(lds + PG8_SB(b, h) + boff + n * 2048), _h = *(const LAS v4i32*)(lds + PG8_SB(b, h) + boff + n * 2048 + 1024); \
            dst##8[n] = __builtin_shufflevector(_l, _h, 0, 1, 2, 3, 4, 5, 6, 7); } else { _Pragma("unroll") for (int k = 0; k < 2; ++k) dst[n][k] = *(const LAS bf16x8*)(lds + PG8_SB(b, h) + boff + n * 2048 + k * 1024); } } } while (0)
#define PG8_MMA(ai, bj, At, Bt) do { __builtin_amdgcn_s_setprio(1); _Pragma("unroll") for (int m = 0; m < 4; ++m) _Pragma("unroll") for (int n = 0; n < 2; ++n) { \
        if constexpr (F8)   \
            asm volatile("v_mfma_scale_f32_16x16x128_f8f6f4 %0, %1, %2, %0, %3, %3 op_sel_hi:[0,0,0]" : "+v"(acc[ai][bj][m][n]) : "v"(Bt##8[n]), "v"(At##8[m]), "v"(f8_unit_scale));   \
        else { _Pragma("unroll") for (int k = 0; k < 2; ++k) acc[ai][bj][m][n] = __builtin_amdgcn_mfma_f32_16x16x32_bf16(Bt[n][k], At[m][k], acc[ai][bj][m][n], 0, 0, 0); } } \
        __builtin_amdgcn_s_setprio(0); } while (0)
#define PG8_WAIT_V(n) asm volatile("s_waitcnt vmcnt(" #n ")" ::: "memory")
#define PG8_WAIT_L(n) asm volatile("s_waitcnt lgkmcnt(" #n ")" ::: "memory")
#define PG8_BAR __builtin_amdgcn_s_barrier()
#define PG8_SCHED __builtin_amdgcn_sched_barrier(0)
    Unit cur, nxt; int ui = 0;
    if (!S.next(0, cur)) return;
    f32x4 acc[2][2][4][2];
#pragma unroll
    for (int a = 0; a < 2; ++a)
#pragma unroll
        for (int b = 0; b < 2; ++b)
#pragma unroll
            for (int m = 0; m < 4; ++m)
#pragma unroll
                for (int n = 0; n < 2; ++n) acc[a][b][m][n] = (f32x4){0.f, 0.f, 0.f, 0.f};
    const int f8_unit_scale = 0x7f7f7f7f;
    bf16x8 At[4][2], B0[2][2], B1[2][2]; v8i32 At8[4], B08[2], B18[2];
    const char* cA = cur.A; const char* cB = cur.B;
    if constexpr (GATHER) {
#pragma unroll
        for (int h = 0; h < 2; ++h)
#pragma unroll
            for (int i = 0; i < 2; ++i) { int R, C; stage_rc(tid * 16 + i * 8192, R, C); vA[h][i] = S.row_off(cur, h * 128 + R) + (unsigned)C * 2u; }
        cur.slot = 0; S.stage_lists(cur, lds, wid);
    }
    PG8_STAGE(PG8_SB(0, 0), cB, voffB); PG8_STAGE(PG8_SB(0, 1), cB + hstepB, voffB); PG8_STAGE_A(PG8_SA(0, 0), cA, 0); PG8_STAGE_A(PG8_SA(0, 1), cA, 1);
    if (wr == 1) PG8_BAR;
    PG8_WAIT_V(2); PG8_BAR;
    PG8_STAGE(PG8_SB(1, 0), cB + kstep, voffB); PG8_STAGE_A(PG8_SA(1, 0), cA + kstep, 0); PG8_STAGE(PG8_SB(1, 1), cB + hstepB + kstep, voffB);
    PG8_WAIT_V(6); PG8_BAR;
    for (;;) {
        const bool has_next = S.next(ui + 1, nxt);
        const char* nA = has_next ? nxt.A : cA; const char* nB = has_next ? nxt.B : cB;
        if constexpr (GATHER) { nxt.slot = (ui + 1) & 1; if (has_next) S.stage_lists(nxt, lds, wid); }
#pragma unroll 1
        for (int t = 0; t < nt; t += 2) {
            const bool last = (t == nt - 2);
            const char* a1 = cA + (size_t)(t + 1) * kstep;
            const char* a2 = last ? nA : cA + (size_t)(t + 2) * kstep; const char* b2 = last ? nB : cB + (size_t)(t + 2) * kstep;
            const char* a3 = a2 + kstep; const char* b3 = b2 + kstep;
            if (KMID > 0 && t == KMID / 64) E.mid(acc, cur, wr, wc, fr, fq);
            asm volatile("" : "+v"(voffB[0]), "+v"(voffB[1]), "+v"(vA[0][0]), "+v"(vA[0][1]), "+v"(vA[1][0]), "+v"(vA[1][1]));
            PG8_LDB(B0, 0, 0); PG8_LDB(B1, 0, 1); PG8_SCHED; PG8_LDA(At, 0, 0); PG8_STAGE_A(PG8_SA(1, 1), a1, 1);
            if constexpr (GATHER) { if (last && has_next) { int tz = tid; asm volatile("" : "+v"(tz));
#pragma unroll
                for (int h = 0; h < 2; ++h)
#pragma unroll
                    for (int i = 0; i < 2; ++i) { int R, C; stage_rc(tz * 16 + i * 8192, R, C); vA[h][i] = S.row_off_lds(nxt, h * 128 + R, lds) + (unsigned)C * 2u; } } }
            PG8_WAIT_V(8); PG8_WAIT_L(0); PG8_BAR; PG8_MMA(0, 0, At, B0); PG8_MMA(0, 1, At, B1); PG8_BAR; PG8_SCHED;
            PG8_LDA(At, 0, 1); PG8_STAGE(PG8_SB(0, 0), b2, voffB); PG8_STAGE(PG8_SB(0, 1), b2 + hstepB, voffB); PG8_STAGE_A(PG8_SA(0, 0), a2, 0);
            PG8_WAIT_V(8); PG8_WAIT_L(0); PG8_BAR; PG8_MMA(1, 0, At, B0); PG8_MMA(1, 1, At, B1); PG8_BAR; PG8_SCHED;
            PG8_LDB(B0, 1, 0); PG8_LDB(B1, 1, 1); PG8_SCHED; PG8_LDA(At, 1, 0); PG8_STAGE_A(PG8_SA(0, 1), a2, 1);
            PG8_WAIT_V(8); PG8_WAIT_L(0); PG8_BAR; PG8_MMA(0, 0, At, B0); PG8_MMA(0, 1, At, B1); PG8_BAR; PG8_SCHED;
            PG8_LDA(At, 1, 1); PG8_STAGE(PG8_SB(1, 0), b3, voffB); PG8_STAGE(PG8_SB(1, 1), b3 + hstepB, voffB); PG8_STAGE_A(PG8_SA(1, 0), a3, 0);
            PG8_WAIT_V(8); PG8_WAIT_L(0); PG8_BAR; PG8_MMA(1, 0, At, B0); PG8_MMA(1, 1, At, B1); PG8_BAR; PG8_SCHED;
        }
        if (wr == 0) PG8_BAR;
        { int tz = threadIdx.x; asm volatile("" : "+v"(tz));
          E(acc, cur, wr, wc, tz & 15, (tz & 63) >> 4); }
        if (!has_next) break;
#pragma unroll
        for (int a = 0; a < 2; ++a)
#pragma unroll
            for (int b = 0; b < 2; ++b)
#pragma unroll
                for (int m = 0; m < 4; ++m)
#pragma unroll
                    for (int n = 0; n < 2; ++n) acc[a][b][m][n] = (f32x4){0.f, 0.f, 0.f, 0.f};
        cur = nxt; cA = nA; cB = nB; ++ui;
        if (wr == 1) PG8_BAR;
    }
    PG8_WAIT_V(0);
    PG8_BAR;
#undef PG8_SA
#undef PG8_SB
#undef PG8_STAGE
#undef PG8_STAGE_A
#undef PG8_LDA
#undef PG8_LDB
#undef PG8_MMA
#undef PG8_WAIT_V
#undef PG8_WAIT_L
#undef PG8_BAR
#undef PG8_SCHED
}

struct EpiStoreBf16 {
    bf16_t* O; int ldc;
    __device__ __forceinline__ void mid(f32x4 (&)[2][2][4][2], const Unit&, int, int, int, int) const {}
    __device__ __forceinline__ void operator()(const f32x4 (&acc)[2][2][4][2], const Unit& u, int wr, int wc, int fr, int fq) const {
        const int row0 = u.pm * 256 + wr * 64 + fr, col0 = u.pn * 256 + wc * 32 + 8 * fq;
#pragma unroll
        for (int ai = 0; ai < 2; ++ai)
#pragma unroll
            for (int m = 0; m < 4; ++m) { bf16_t* rowp = O + (size_t)(row0 + ai * 128 + m * 16) * ldc + col0;
#pragma unroll
                for (int bj = 0; bj < 2; ++bj) { const f32x4 v0 = acc[ai][bj][m][0], v1 = acc[ai][bj][m][1];
                    u32x4 w; w.x = cvt_pk_bf16(v0[0], v0[1]); w.y = cvt_pk_bf16(v0[2], v0[3]); w.z = cvt_pk_bf16(v1[0], v1[1]); w.w = cvt_pk_bf16(v1[2], v1[3]);
                    *(u32x4*)(rowp + bj * 128) = w; } }
    }
};

__device__ __forceinline__ void unpack8(const u32x4 w, float (&f)[8]) {
    f[0] = __uint_as_float(w.x << 16); f[1] = __uint_as_float(w.x & 0xffff0000u); f[2] = __uint_as_float(w.y << 16); f[3] = __uint_as_float(w.y & 0xffff0000u);
    f[4] = __uint_as_float(w.z << 16); f[5] = __uint_as_float(w.z & 0xffff0000u); f[6] = __uint_as_float(w.w << 16); f[7] = __uint_as_float(w.w & 0xffff0000u);
}

struct EpiMerge {
    bf16_t* O; const bf16_t* proj;
    __device__ __forceinline__ void mid(f32x4 (&acc)[2][2][4][2], const Unit& u, int wr, int wc, int fr, int fq) const {
        const int row0 = u.pm * 256 + wr * 64 + fr, col0 = u.pn * 256 + wc * 32 + 8 * fq;
        u32x4 ra[4][2], rb[4][2];
#define EM_LOAD(gq) do { int rr = row0 + ((gq) >> 2) * 128 + ((gq) & 3) * 16; asm volatile("" : "+v"(rr)); const bf16_t* rowp = proj + (size_t)rr * DIN + col0; \
            ra[(gq) & 3][0] = *(const u32x4*)(rowp + C_GA); ra[(gq) & 3][1] = *(const u32x4*)(rowp + C_GA + 128); rb[(gq) & 3][0] = *(const u32x4*)(rowp + C_GB); rb[(gq) & 3][1] = *(const u32x4*)(rowp + C_GB + 128); } while (0)
        EM_LOAD(0); EM_LOAD(1); EM_LOAD(2);
#pragma unroll
        for (int grp = 0; grp < 8; ++grp) { const int ai = grp >> 2, m = grp & 3, cb = grp & 3;
            if (grp + 3 < 8) EM_LOAD(grp + 3);
            asm volatile("" ::: "memory");
#pragma unroll
            for (int bj = 0; bj < 2; ++bj) { float ga[8], gb[8]; unpack8(ra[cb][bj], ga); unpack8(rb[cb][bj], gb);
#pragma unroll
                for (int j = 0; j < 8; ++j) { const float ratio = (1.0f + __builtin_amdgcn_exp2f(-1.4426950408889634f * gb[j])) * __builtin_amdgcn_rcpf(1.0f + __builtin_amdgcn_exp2f(-1.4426950408889634f * ga[j])); acc[ai][bj][m][j >> 2][j & 3] *= ratio; } }
            asm volatile("" ::: "memory"); }
#undef EM_LOAD
    }
    __device__ __forceinline__ void operator()(const f32x4 (&acc)[2][2][4][2], const Unit& u, int wr, int wc, int fr, int fq) const {
        const int row0 = u.pm * 256 + wr * 64 + fr, col0 = u.pn * 256 + wc * 32 + 8 * fq;
        u32x4 rb[4][2];
#define EM_LOAD(gq) do { int rr = row0 + ((gq) >> 2) * 128 + ((gq) & 3) * 16; asm volatile("" : "+v"(rr)); const bf16_t* rowp = proj + (size_t)rr * DIN + col0; \
            rb[(gq) & 3][0] = *(const u32x4*)(rowp + C_GB); rb[(gq) & 3][1] = *(const u32x4*)(rowp + C_GB + 128); } while (0)
        EM_LOAD(0); EM_LOAD(1); EM_LOAD(2);
#pragma unroll
        for (int grp = 0; grp < 8; ++grp) { const int ai = grp >> 2, m = grp & 3, cb = grp & 3;
            if (grp + 3 < 8) EM_LOAD(grp + 3);
            asm volatile("" ::: "memory");
            const size_t r = (size_t)(row0 + ai * 128 + m * 16);
#pragma unroll
            for (int bj = 0; bj < 2; ++bj) { float gb[8], v[8]; unpack8(rb[cb][bj], gb);
#pragma unroll
                for (int j = 0; j < 8; ++j) v[j] = acc[ai][bj][m][j >> 2][j & 3] * __builtin_amdgcn_rcpf(1.0f + __builtin_amdgcn_exp2f(-1.4426950408889634f * gb[j]));
                u32x4 w; w.x = cvt_pk_bf16(v[0], v[1]); w.y = cvt_pk_bf16(v[2], v[3]); w.z = cvt_pk_bf16(v[4], v[5]); w.w = cvt_pk_bf16(v[6], v[7]);
                *(u32x4*)(O + r * D + col0 + bj * 128) = w; }
            asm volatile("" ::: "memory"); }
#undef EM_LOAD
    }
};

struct EpiResid {
    bf16_t* O; const float* x; unsigned char* O8;
    __device__ __forceinline__ void mid(f32x4 (&)[2][2][4][2], const Unit&, int, int, int, int) const {}
    __device__ __forceinline__ void operator()(const f32x4 (&acc)[2][2][4][2], const Unit& u, int wr, int wc, int fr, int fq) const {
        const int row0 = u.pm * 256 + wr * 64 + fr, col0 = u.pn * 256 + wc * 32 + 8 * fq;
        f32x4 xr[4][4];
#define ER_LOAD(gq) do { int rr = row0 + ((gq) >> 2) * 128 + ((gq) & 3) * 16; asm volatile("" : "+v"(rr)); const float* xp = x + (size_t)rr * D + col0; \
            xr[(gq) & 3][0] = *(const f32x4*)(xp); xr[(gq) & 3][1] = *(const f32x4*)(xp + 4); xr[(gq) & 3][2] = *(const f32x4*)(xp + 128); xr[(gq) & 3][3] = *(const f32x4*)(xp + 132); } while (0)
        ER_LOAD(0); ER_LOAD(1); ER_LOAD(2);
#pragma unroll
        for (int grp = 0; grp < 8; ++grp) { const int ai = grp >> 2, m = grp & 3, cb = grp & 3;
            if (grp + 3 < 8) ER_LOAD(grp + 3);
            asm volatile("" ::: "memory");
            const size_t r = (size_t)(row0 + ai * 128 + m * 16);
#pragma unroll
            for (int bj = 0; bj < 2; ++bj) { const f32x4 v0 = acc[ai][bj][m][0] + xr[cb][2 * bj], v1 = acc[ai][bj][m][1] + xr[cb][2 * bj + 1];
                u32x4 w; w.x = cvt_pk_bf16(v0[0], v0[1]); w.y = cvt_pk_bf16(v0[2], v0[3]); w.z = cvt_pk_bf16(v1[0], v1[1]); w.w = cvt_pk_bf16(v1[2], v1[3]);
                *(u32x4*)(O + r * D + col0 + bj * 128) = w;
                *(u32x2*)(O8 + r * D + col0 + bj * 128) = (u32x2){pack4_fp8(v0[0], v0[1], v0[2], v0[3]), pack4_fp8(v1[0], v1[1], v1[2], v1[3])}; }
            asm volatile("" ::: "memory"); }
#undef ER_LOAD
    }
};

struct EpiAct {
    bf16_t* act; const volatile LAS int* tpre;
    __device__ __forceinline__ void mid(f32x4 (&)[2][2][4][2], const Unit&, int, int, int, int) const {}
    __device__ __forceinline__ void operator()(const f32x4 (&acc)[2][2][4][2], const Unit& u, int wr, int wc, int fr, int fq) const {
        const int tile = __builtin_amdgcn_readfirstlane(tpre[u.e]) + u.pm; const int col0 = u.pn * 128 + wc * 32 + 8 * fq;
        int frl = fr; asm volatile("" : "+v"(frl));
        float rs[8];
        const volatile LAS float* lp = (const volatile LAS float*)tpre + ((LS_OFF - 140 * 1024) / 4 + u.slot * 512 + 256); const int last = (u.cnt < 256 ? u.cnt : 256) - 1;
#pragma unroll
        for (int i = 0; i < 8; ++i) { const int rr = (i >> 2) * 128 + wr * 64 + (i & 3) * 16 + frl; rs[i] = lp[rr < last ? rr : last]; }
#pragma unroll
        for (int i = 0; i < 8; ++i) { const int ai = i >> 2, m = i & 3, rr = ai * 128 + wr * 64 + m * 16 + frl;
            const float rstd = rs[i];
            float v[8];
#pragma unroll
            for (int j = 0; j < 8; ++j) { const float g = acc[ai][0][m][j >> 2][j & 3] * rstd, up = acc[ai][1][m][j >> 2][j & 3] * rstd; v[j] = g * up * __builtin_amdgcn_rcpf(1.0f + __builtin_amdgcn_exp2f(-1.4426950408889634f * g)); }
            *(u32x2*)((unsigned char*)act + ((size_t)tile * 256 + rr) * DE + col0) = (u32x2){pack4_fp8(v[0] * ACT_SCALE, v[1] * ACT_SCALE, v[2] * ACT_SCALE, v[3] * ACT_SCALE), pack4_fp8(v[4] * ACT_SCALE, v[5] * ACT_SCALE, v[6] * ACT_SCALE, v[7] * ACT_SCALE)}; }
    }
};

struct EpiDown {
    bf16_t* y; const volatile LAS int* tpre;
    __device__ __forceinline__ void mid(f32x4 (&)[2][2][4][2], const Unit&, int, int, int, int) const {}
    __device__ __forceinline__ void operator()(const f32x4 (&acc)[2][2][4][2], const Unit& u, int wr, int wc, int fr, int fq) const {
        const int col0 = u.pn * 256 + wc * 32 + 8 * fq;
        int frl = fr; asm volatile("" : "+v"(frl));
        int tk[8]; float wt[8];
        const volatile LAS int* ltk = tpre + ((LS_OFF - 140 * 1024) / 4 + u.slot * 512); const volatile LAS float* lw = (const volatile LAS float*)ltk + 256; const int last = (u.cnt < 256 ? u.cnt : 256) - 1;
#pragma unroll
        for (int i = 0; i < 8; ++i) { const int rr = (i >> 2) * 128 + wr * 64 + (i & 3) * 16 + frl; const int rc = rr < last ? rr : last; const int t = ltk[rc]; tk[i] = (rr <= last) ? t : Y_DUMMY_ROW;
            wt[i] = lw[rc] * (Y_SCALE / (ACT_SCALE * WD_SCALE)); }
#pragma unroll
        for (int i = 0; i < 8; ++i) { const int ai = i >> 2, m = i & 3;
#pragma unroll
            for (int bj = 0; bj < 2; ++bj) { const f32x4 v0 = acc[ai][bj][m][0] * wt[i], v1 = acc[ai][bj][m][1] * wt[i];
                *(u32x2*)((unsigned char*)y + (size_t)tk[i] * D + col0 + bj * 128) = (u32x2){pack4_fp8(v0[0], v0[1], v0[2], v0[3]), pack4_fp8(v1[0], v1[1], v1[2], v1[3])}; } }
    }
};

__device__ __forceinline__ void tr_tile8(const float* src, int ld_src, unsigned char* dst, int ld_dst, int k0, int n0, int drow0, const float* scale, float mul, LAS float* tile) {
    const int lane = threadIdx.x & 63, kq = lane >> 4, n4 = (lane & 15) * 4;
    f32x4 v[16];
#pragma unroll
    for (int it = 0; it < 16; ++it) v[it] = *(const f32x4*)(src + (size_t)(k0 + it * 4 + kq) * ld_src + n0 + n4);
#pragma unroll
    for (int it = 0; it < 16; ++it) { const int k = it * 4 + kq; const float s = (scale ? scale[k0 + k] : 1.0f) * mul;
        tile[k * 65 + n4 + 0] = v[it][0] * s; tile[k * 65 + n4 + 1] = v[it][1] * s; tile[k * 65 + n4 + 2] = v[it][2] * s; tile[k * 65 + n4 + 3] = v[it][3] * s; }
    __builtin_amdgcn_wave_barrier();
    const int kg = lane & 7;
#pragma unroll
    for (int it = 0; it < 8; ++it) { const int nn = (lane >> 3) + 8 * it; float f[8];
#pragma unroll
        for (int j = 0; j < 8; ++j) f[j] = tile[(kg * 8 + j) * 65 + nn];
        *(u32x2*)(dst + (size_t)(drow0 + nn) * ld_dst + k0 + kg * 8) = (u32x2){pack4_fp8(f[0], f[1], f[2], f[3]), pack4_fp8(f[4], f[5], f[6], f[7])}; }
    __builtin_amdgcn_wave_barrier();
}
__device__ __forceinline__ void tr_tile(const float* src, int ld_src, bf16_t* dst, int ld_dst, int k0, int n0, int drow0, const float* scale, LAS float* tile) {
    const int lane = threadIdx.x & 63, kq = lane >> 4, n4 = (lane & 15) * 4;
    f32x4 v[16];
#pragma unroll
    for (int it = 0; it < 16; ++it) v[it] = *(const f32x4*)(src + (size_t)(k0 + it * 4 + kq) * ld_src + n0 + n4);
#pragma unroll
    for (int it = 0; it < 16; ++it) { const int k = it * 4 + kq; const float s = scale ? scale[k0 + k] : 1.0f;
        tile[k * 65 + n4 + 0] = v[it][0] * s; tile[k * 65 + n4 + 1] = v[it][1] * s; tile[k * 65 + n4 + 2] = v[it][2] * s; tile[k * 65 + n4 + 3] = v[it][3] * s; }
    __builtin_amdgcn_wave_barrier();
    const int kg = lane & 7;
#pragma unroll
    for (int it = 0; it < 8; ++it) { const int nn = (lane >> 3) + 8 * it; float f[8];
#pragma unroll
        for (int j = 0; j < 8; ++j) f[j] = tile[(kg * 8 + j) * 65 + nn];
        u32x4 w; w.x = cvt_pk_bf16(f[0], f[1]); w.y = cvt_pk_bf16(f[2], f[3]); w.z = cvt_pk_bf16(f[4], f[5]); w.w = cvt_pk_bf16(f[6], f[7]);
        *(u32x4*)(dst + (size_t)(drow0 + nn) * ld_dst + k0 + kg * 8) = w; }
    __builtin_amdgcn_wave_barrier();
}

constexpr int T_IN = 16 * 96, T_UPA = 8 * 16, T_UPB = 16 * 16, T_OUT = 16 * 16, T_G = NE * 16 * 8, T_U = NE * 16 * 8, T_D = NE * 8 * 16;
constexpr int T_EARLY = T_IN + T_UPA + T_UPB + T_OUT, T_TOTAL = T_EARLY + T_G + T_U + T_D;
constexpr int CONV_TPT = 32, N_CONV_TASKS = (T_TOTAL - T_EARLY) / CONV_TPT;
__device__ __forceinline__ void conv_tile(const Params& P, LAS float* tile, int t) {
    unsigned char* ws = P.ws;
    int j = t;
    if (j < T_IN) { const int kt = j / 96, ntl = j % 96; tr_tile(P.w_in, DIN, (bf16_t*)(ws + WS_WIN), D, kt * 64, ntl * 64, ntl * 64, nullptr, tile); return; }
    j -= T_IN;
    if (j < T_UPA) { const int kt = j / 16, ntl = j % 16; tr_tile(P.w_up_a, D, (bf16_t*)(ws + WS_WUP), KUP, kt * 64, ntl * 64, ntl * 64, nullptr, tile); return; }
    j -= T_UPA;
    if (j < T_UPB) { const int kt = j / 16, ntl = j % 16; tr_tile(P.w_up_b, D, (bf16_t*)(ws + WS_WUP) + 512, KUP, kt * 64, ntl * 64, ntl * 64, nullptr, tile); return; }
    j -= T_UPB;
    if (j < T_OUT) { const int kt = j / 16, ntl = j % 16; tr_tile(P.w_out, D, (bf16_t*)(ws + WS_WOUT), D, kt * 64, ntl * 64, ntl * 64, nullptr, tile); return; }
    j -= T_OUT;
    if (j < T_G + T_U) { const bool up = j >= T_G; if (up) j -= T_G; const int e = j / 128, r = j % 128, kt = r % 16, ntl = r / 16; const int c0 = ntl * 64;
        const int drow = (c0 >> 7) * 256 + (c0 & 127) + (up ? 128 : 0);
        tr_tile8((up ? P.w_up : P.w_gate) + (size_t)e * D * DE, DE, (unsigned char*)(ws + WS_WGU) + (size_t)e * 1024 * D, D, kt * 64, c0, drow, P.norm2_g, WGU_SCALE, tile); return; }
    j -= T_G + T_U;
    { const int e = j / 128, r = j % 128, kt = r % 8, ntl = r / 8;
      tr_tile8(P.w_down + (size_t)e * DE * D, D, (unsigned char*)(ws + WS_WD) + (size_t)e * D * DE, DE, kt * 64, ntl * 64, ntl * 64, nullptr, WD_SCALE, tile); }
}

__device__ void p0_prologue(const Params& P, LAS unsigned char* lds, int bid, int nb) {
    const int tid = threadIdx.x, wid = tid >> 6, lane = tid & 63;
    unsigned char* ws = P.ws;
    LAS float* tile = (LAS float*)lds;
    for (int t = bid * 8 + wid; t < T_EARLY; t += nb * 8) conv_tile(P, tile + wid * (64 * 65), t);
    __syncthreads();
    { LAS float* hm = (LAS float*)lds;
      LAS float* red = (LAS float*)(lds + 65536);
      float* projm = (float*)(ws + WS_PROJM); bf16_t* metat = (bf16_t*)(ws + WS_METAT);
      bool have = false;
      for (int cg = nb - 1 - bid; cg < DIN / 64; cg += nb) {
          if (!have) { __syncthreads();
              for (int r = wid; r < NMETA; r += 8) { const float* mr = P.meta + (size_t)r * D; float ss = 0.f;
                  for (int k = lane; k < D; k += 64) { const float v = mr[k]; ss += v * v; }
                  ss = wave_sum(ss); const float rstd = rsqrtf(ss * (1.0f / D) + EPS);
                  for (int k = lane; k < D; k += 64) hm[r * D + k] = mr[k] * rstd * P.norm1_g[k]; }
              have = true; __syncthreads(); }
          const int c = tid & 63, ks = tid >> 6; float a[16];
#pragma unroll
          for (int r = 0; r < 16; ++r) a[r] = 0.f;
#pragma unroll 1
          for (int k0 = ks * 128; k0 < ks * 128 + 128; k0 += 8) { float w[8];
#pragma unroll
              for (int q = 0; q < 8; ++q) w[q] = P.w_in[(size_t)(k0 + q) * DIN + cg * 64 + c];
#pragma unroll
              for (int q = 0; q < 8; ++q)
#pragma unroll
                  for (int r = 0; r < 16; ++r) a[r] += hm[r * D + k0 + q] * w[q]; }
#pragma unroll
          for (int r = 0; r < 16; ++r) red[(ks * 16 + r) * 64 + c] = a[r];
          __syncthreads();
          for (int o = tid; o < 16 * 64; o += NTHREADS) { const int r = o >> 6, cc = o & 63; float s = 0.f;
#pragma unroll
              for (int q = 0; q < 8; ++q) s += red[(q * 16 + r) * 64 + cc];
              projm[(size_t)r * DIN + cg * 64 + cc] = s; metat[(size_t)(48 + r) * DIN + cg * 64 + cc] = f2bf(s); }
          for (int o = tid; o < 48 * 64; o += NTHREADS) { const int r = o >> 6, col = cg * 64 + (o & 63); metat[(size_t)r * DIN + col] = (col >= C_F && col < C_F + DHG) ? (bf16_t)0x42A0 : (bf16_t)0; }
          __syncthreads(); } }
    { bf16_t* hn = (bf16_t*)(ws + WS_HN);
      f32x4 gq[4];
#pragma unroll
      for (int q = 0; q < 4; ++q) gq[q] = *(const f32x4*)(P.norm1_g + 256 * q + 4 * lane);
      volatile LAS int* shq = (volatile LAS int*)(lds + 141 * 1024 + 64); int* rq = (int*)(ws + WS_CTL + CTL_CNT + 128 + 8);
      for (;;) { __syncthreads(); if (tid == 0) shq[0] = atomicAdd(rq, 1); __syncthreads(); const int grp = __builtin_amdgcn_readfirstlane(shq[0]); if (grp >= NTOK / 32) break;
          const int r0 = grp * 32 + wid * 4;
          f32x4 v[4][4];
#pragma unroll
          for (int rr = 0; rr < 4; ++rr)
#pragma unroll
              for (int q = 0; q < 4; ++q) v[rr][q] = *(const f32x4*)(P.x + (size_t)(r0 + rr) * D + 256 * q + 4 * lane);
#pragma unroll
          for (int rr = 0; rr < 4; ++rr) { float ss = 0.f;
#pragma unroll
              for (int q = 0; q < 4; ++q) ss += v[rr][q][0] * v[rr][q][0] + v[rr][q][1] * v[rr][q][1] + v[rr][q][2] * v[rr][q][2] + v[rr][q][3] * v[rr][q][3];
              ss = wave_sum(ss); const float rstd = rsqrtf(ss * (1.0f / D) + EPS);
#pragma unroll
              for (int q = 0; q < 4; ++q) { const f32x4 o = v[rr][q] * rstd * gq[q];
                  *(u32x2*)(hn + (size_t)(r0 + rr) * D + 256 * q + 4 * lane) = (u32x2){cvt_pk_bf16(o[0], o[1]), cvt_pk_bf16(o[2], o[3])}; } } } }
    { float* lb = (float*)(ws + WS_LB);
      for (int d = bid * NTHREADS + tid; d < DHG; d += nb * NTHREADS) lb[d] = sigmoidf_(P.hg_lb[d] - P.hg_lb[DHG + d]);
      bf16_t* wrt = (bf16_t*)(ws + WS_WR);
      for (int o = bid * NTHREADS + tid; o < 48 * D; o += nb * NTHREADS) { const int j = o / D, k = o % D; float v = 0.f;
          { const int nt = j >> 4, g = (j >> 2) & 3, jj = j & 3;
            if (nt < 2) v = P.w_router[((size_t)g * D + k) * 8 + nt * 4 + jj] * P.norm2_g[k];
            else if (jj == 0) v = P.w_group[(size_t)k * 4 + g] * P.norm2_g[k]; }
          wrt[o] = f2bf(v); }
    }
}

__device__ __forceinline__ float ldproj(const Params& P, int b, int s, int col) {
    if (s < NMETA) return ((const float*)(P.ws + WS_PROJM))[(size_t)s * DIN + col];
    return bf2f(((const bf16_t*)(P.ws + WS_PROJ))[((size_t)b * SEQ + (s - NMETA)) * DIN + col]);
}

__device__ void hgrn_simple(const Params& P, LAS unsigned char* lds, int unit) {
    constexpr int TC = 32;
    const int tid = threadIdx.x, wid = tid >> 6, lane = tid & 63, b = unit >> 2, h = unit & 3, v = tid & 127, dg = tid >> 7;
    LAS float* fb = (LAS float*)lds; LAS float* kb = fb + TC * 128; LAS float* qb = kb + TC * 128; LAS float* vb = qb + TC * 128; LAS float* op = vb + TC * 128;
    const float* lbp = (const float*)(P.ws + WS_LB);
    bf16_t* oab = (bf16_t*)P.out;
    float S[32];
#pragma unroll
    for (int j = 0; j < 32; ++j) S[j] = 0.f;
    for (int c0 = 0; c0 < TSEQ; c0 += TC) {
        const int len = (TSEQ - c0) < TC ? (TSEQ - c0) : TC;
        __syncthreads();
        for (int idx = tid; idx < len * 128; idx += NTHREADS) { const int t = idx >> 7, d = idx & 127, s = c0 + t;
            const float q = ldproj(P, b, s, C_Q + h * 128 + d), fp = ldproj(P, b, s, C_F + h * 128 + d), iv = ldproj(P, b, s, C_I + h * 128 + d);
            const float lb = lbp[h * 128 + d];
            fb[idx] = lb + (1.0f - lb) * sigmoidf_(fp); kb[idx] = (1.0f - lb) * sigmoidf_(-fp); qb[idx] = q; vb[idx] = iv; }
        __syncthreads();
        for (int t = 0; t < len; ++t) { const float vv = vb[t * 128 + v]; float o = 0.f;
#pragma unroll
            for (int j4 = 0; j4 < 8; ++j4) { const f32x4 f4 = *(const LAS f32x4*)(fb + t * 128 + dg * 32 + j4 * 4), k4 = *(const LAS f32x4*)(kb + t * 128 + dg * 32 + j4 * 4), q4 = *(const LAS f32x4*)(qb + t * 128 + dg * 32 + j4 * 4);
#pragma unroll
                for (int j = 0; j < 4; ++j) { S[j4 * 4 + j] = f4[j] * S[j4 * 4 + j] + k4[j] * vv; o += S[j4 * 4 + j] * q4[j]; } }
            op[(t * 4 + dg) * 128 + v] = o; }
        __syncthreads();
        for (int t = wid; t < len; t += 8) { const int s = c0 + t; if (s < NMETA) continue;
            const float o0 = op[(t * 4 + 0) * 128 + lane] + op[(t * 4 + 1) * 128 + lane] + op[(t * 4 + 2) * 128 + lane] + op[(t * 4 + 3) * 128 + lane];
            const float o1 = op[(t * 4 + 0) * 128 + lane + 64] + op[(t * 4 + 1) * 128 + lane + 64] + op[(t * 4 + 2) * 128 + lane + 64] + op[(t * 4 + 3) * 128 + lane + 64];
            const float ss = wave_sum(o0 * o0 + o1 * o1); const float rstd = rsqrtf(ss * (1.0f / 128.0f) + EPS);
            const size_t row = (size_t)b * SEQ + (s - NMETA);
            const float g0 = P.hg_norm_g[h * 128 + lane], g1 = P.hg_norm_g[h * 128 + lane + 64];
            const float og0 = ldproj(P, b, s, C_OG + h * 128 + lane), og1 = ldproj(P, b, s, C_OG + h * 128 + lane + 64);
            oab[row * KUP + h * 128 + lane] = f2bf(o0 * rstd * g0 * sigmoidf_(og0));
            oab[row * KUP + h * 128 + lane + 64] = f2bf(o1 * rstd * g1 * sigmoidf_(og1)); }
    }
}

__device__ void lru_simple(const Params& P, LAS unsigned char* lds, int unit) {
    constexpr int TC = 64;
    const int tid = threadIdx.x, b = unit >> 3, n = unit & 7, c = tid & 127, tq = tid >> 7, ch = n * 128 + c;
    LAS float* xin = (LAS float*)lds;
    LAS float* xc = xin + (TC + 3) * 128;
    LAS float* ab = xc + TC * 128;
    LAS float* ub = ab + TC * 128;
    bf16_t* oab = (bf16_t*)P.out;
    const float cw0 = P.conv_w[0 * D + ch], cw1 = P.conv_w[1 * D + ch], cw2 = P.conv_w[2 * D + ch], cw3 = P.conv_w[3 * D + ch], cb = P.conv_b[ch];
    const float br = P.b_r[ch], bi = P.b_i[ch];
    const float lamv = P.lam[ch]; const float sp = (lamv > 15.f) ? __expf(-lamv) : log1pf(__expf(-lamv));
    const float* wr = P.w_r + (size_t)n * 128 * 128; const float* wi = P.w_i + (size_t)n * 128 * 128;
    float hcar = 0.f;
    for (int c0 = 0; c0 < TSEQ; c0 += TC) {
        const int len = (TSEQ - c0) < TC ? (TSEQ - c0) : TC;
        __syncthreads();
        for (int idx = tid; idx < (len + 3) * 128; idx += NTHREADS) { const int t = idx >> 7, cc = idx & 127, s = c0 + t - 3;
            xin[idx] = (s >= 0) ? ldproj(P, b, s, C_LX + n * 128 + cc) : 0.f; }
        __syncthreads();
        for (int t = tq; t < len; t += 4) xc[t * 128 + c] = cw0 * xin[t * 128 + c] + cw1 * xin[(t + 1) * 128 + c] + cw2 * xin[(t + 2) * 128 + c] + cw3 * xin[(t + 3) * 128 + c] + cb;
        __syncthreads();
        { float ra[16], ia[16];
#pragma unroll
          for (int j = 0; j < 16; ++j) { ra[j] = 0.f; ia[j] = 0.f; }
          for (int i4 = 0; i4 < 128; i4 += 4) { float w_r4[4], w_i4[4];
#pragma unroll
              for (int q = 0; q < 4; ++q) { w_r4[q] = wr[(size_t)(i4 + q) * 128 + c]; w_i4[q] = wi[(size_t)(i4 + q) * 128 + c]; }
#pragma unroll
              for (int j = 0; j < 16; ++j) { const f32x4 xv = *(const LAS f32x4*)(xc + (tq * 16 + j) * 128 + i4);
#pragma unroll
                  for (int q = 0; q < 4; ++q) { ra[j] += xv[q] * w_r4[q]; ia[j] += xv[q] * w_i4[q]; } } }
#pragma unroll
          for (int j = 0; j < 16; ++j) { const int t = tq * 16 + j; const float r = sigmoidf_(ra[j] + br), ig = sigmoidf_(ia[j] + bi);
              const float log_a = -8.0f * r * sp; const float a = __expf(log_a); const float u = sqrtf(-expm1f(2.0f * log_a)) * (ig * xc[t * 128 + c]);
              ab[t * 128 + c] = a; ub[t * 128 + c] = u; } }
        __syncthreads();
        if (tid < 128) { float hh = hcar; for (int t = 0; t < len; ++t) { hh = ab[t * 128 + c] * hh + ub[t * 128 + c]; ub[t * 128 + c] = hh; } hcar = hh; }
        __syncthreads();
        for (int idx = tid; idx < len * 128; idx += NTHREADS) { const int t = idx >> 7, cc = idx & 127, s = c0 + t; if (s < NMETA) continue;
            const float y = ldproj(P, b, s, C_LY + n * 128 + cc);
            oab[((size_t)b * SEQ + (s - NMETA)) * KUP + 512 + n * 128 + cc] = f2bf(ub[idx] * gelu_tanh(y)); }
    }
}


#define BAR_LDS() do { asm volatile("s_waitcnt lgkmcnt(0)" ::: "memory"); __builtin_amdgcn_s_barrier(); asm volatile("" ::: "memory"); } while (0)

constexpr int LT = 272;
__device__ __forceinline__ const bf16_t* seq_row(const Params& P, int b, int c, int t) {
    return c == 0 ? (const bf16_t*)(P.ws + WS_METAT) + (size_t)t * DIN : (const bf16_t*)(P.ws + WS_PROJ) + ((size_t)b * SEQ + (size_t)(c - 1) * 64 + t) * DIN;
}
__device__ __forceinline__ float bflo(unsigned w) { return __uint_as_float(w << 16); }
__device__ __forceinline__ float bfhi(unsigned w) { return __uint_as_float(w & 0xffff0000u); }

__device__ void lru_fast(const Params& P, LAS unsigned char* lds, int unit) {
    const int tid = threadIdx.x, wid = __builtin_amdgcn_readfirstlane(tid >> 6), lane = tid & 63, b = unit >> 3, n = unit & 7, fr = lane & 15, g = lane >> 4;
    constexpr int TP = 136;
    constexpr int XA_B = 64 * LT, CT_B = 128 * TP, SET_B = XA_B + 3 * CT_B;
    static_assert(2 * SET_B <= 140 * 1024, "LRU tiles exceed the LDS budget");
    bf16_t* oab = (bf16_t*)P.out;
    bf16x8 Br[4], Bi[4];
    { const float* wr = P.w_r + (size_t)n * 128 * 128 + wid * 16 + fr; const float* wi = P.w_i + (size_t)n * 128 * 128 + wid * 16 + fr;
#pragma unroll
      for (int ks = 0; ks < 4; ++ks) { unsigned pr[4], pi[4];
#pragma unroll
          for (int j = 0; j < 4; ++j) { const int i0 = 32 * ks + 8 * g + 2 * j;
              pr[j] = cvt_pk_bf16(wr[(size_t)i0 * 128], wr[(size_t)(i0 + 1) * 128]); pi[j] = cvt_pk_bf16(wi[(size_t)i0 * 128], wi[(size_t)(i0 + 1) * 128]); }
          u32x4 tr = {pr[0], pr[1], pr[2], pr[3]}, ti = {pi[0], pi[1], pi[2], pi[3]};
          Br[ks] = __builtin_bit_cast(bf16x8, tr); Bi[ks] = __builtin_bit_cast(bf16x8, ti); } }
    const int chg = n * 128 + wid * 16 + fr;
    const float LOG2E = 1.4426950408889634f;
    const float nbr = -P.b_r[chg] * LOG2E, nbi = -P.b_i[chg] * LOG2E;
    const float lamv = P.lam[chg]; const float c2 = -8.0f * LOG2E * ((lamv > 15.f) ? __expf(-lamv) : log1pf(__expf(-lamv)));
    const int chc = n * 128 + 2 * lane;
    const f32x2 cw0 = *(const f32x2*)(P.conv_w + 0 * D + chc), cw1 = *(const f32x2*)(P.conv_w + 1 * D + chc), cw2 = *(const f32x2*)(P.conv_w + 2 * D + chc), cw3 = *(const f32x2*)(P.conv_w + 3 * D + chc),
                cbv = *(const f32x2*)(P.conv_b + chc);
    float carry = 0.f;
    unsigned xl[11], yl[8];
    unsigned lxo = (unsigned)(C_LX + n * 128 + 2 * lane) * 2u, lyo = (unsigned)(C_LY + n * 128 + 2 * lane) * 2u;
#define LRU_PREFETCH(c) do { const char* r0 = (const char*)seq_row(P, b, (c), wid * 8);        \
        _Pragma("unroll") for (int q = 0; q < 8; ++q) { xl[3 + q] = *(const unsigned*)(r0 + (lxo + (unsigned)q * (DIN * 2u))); yl[q] = *(const unsigned*)(r0 + (lyo + (unsigned)q * (DIN * 2u))); } \
        if (wid > 0) { const char* rm = r0 - 3 * (DIN * 2); _Pragma("unroll") for (int q = 0; q < 3; ++q) xl[q] = *(const unsigned*)(rm + (lxo + (unsigned)q * (DIN * 2u))); } \
        else if ((c) > 0) { const char* rh = (const char*)seq_row(P, b, (c) - 1, 61); _Pragma("unroll") for (int q = 0; q < 3; ++q) xl[q] = *(const unsigned*)(rh + (lxo + (unsigned)q * (DIN * 2u))); } \
        else { xl[0] = 0u; xl[1] = 0u; xl[2] = 0u; } } while (0)
    BAR_LDS();
    LRU_PREFETCH(0);
    { LAS unsigned char* XAw = lds; LAS unsigned char* XTw = XAw + XA_B; LAS unsigned char* YTw = XTw + CT_B;
        { f32x2 xv[11];
#pragma unroll
          for (int q = 0; q < 11; ++q) xv[q] = (f32x2){bflo(xl[q]), bfhi(xl[q])};
          unsigned xp[8];
#pragma unroll
          for (int q = 0; q < 8; ++q) { const f32x2 v = cw0 * xv[q] + cw1 * xv[q + 1] + cw2 * xv[q + 2] + cw3 * xv[q + 3] + cbv; xp[q] = cvt_pk_bf16(v[0], v[1]);
              *(LAS unsigned*)(XAw + (wid * 8 + q) * LT + lane * 4) = xp[q]; }
          u32x4 x0, x1, y0, y1;
          x0.x = __builtin_amdgcn_perm(xp[1], xp[0], 0x05040100u); x0.y = __builtin_amdgcn_perm(xp[3], xp[2], 0x05040100u); x0.z = __builtin_amdgcn_perm(xp[5], xp[4], 0x05040100u); x0.w = __builtin_amdgcn_perm(xp[7], xp[6], 0x05040100u);
          x1.x = __builtin_amdgcn_perm(xp[1], xp[0], 0x07060302u); x1.y = __builtin_amdgcn_perm(xp[3], xp[2], 0x07060302u); x1.z = __builtin_amdgcn_perm(xp[5], xp[4], 0x07060302u); x1.w = __builtin_amdgcn_perm(xp[7], xp[6], 0x07060302u);
          y0.x = __builtin_amdgcn_perm(yl[1], yl[0], 0x05040100u); y0.y = __builtin_amdgcn_perm(yl[3], yl[2], 0x05040100u); y0.z = __builtin_amdgcn_perm(yl[5], yl[4], 0x05040100u); y0.w = __builtin_amdgcn_perm(yl[7], yl[6], 0x05040100u);
          y1.x = __builtin_amdgcn_perm(yl[1], yl[0], 0x07060302u); y1.y = __builtin_amdgcn_perm(yl[3], yl[2], 0x07060302u); y1.z = __builtin_amdgcn_perm(yl[5], yl[4], 0x07060302u); y1.w = __builtin_amdgcn_perm(yl[7], yl[6], 0x07060302u);
          *(LAS u32x2*)(XTw + (2 * lane) * TP + wid * 16) = (u32x2){x0.x, x0.y}; *(LAS u32x2*)(XTw + (2 * lane) * TP + wid * 16 + 8) = (u32x2){x0.z, x0.w};
          *(LAS u32x2*)(XTw + (2 * lane + 1) * TP + wid * 16) = (u32x2){x1.x, x1.y}; *(LAS u32x2*)(XTw + (2 * lane + 1) * TP + wid * 16 + 8) = (u32x2){x1.z, x1.w};
          *(LAS u32x2*)(YTw + (2 * lane) * TP + wid * 16) = (u32x2){y0.x, y0.y}; *(LAS u32x2*)(YTw + (2 * lane) * TP + wid * 16 + 8) = (u32x2){y0.z, y0.w};
          *(LAS u32x2*)(YTw + (2 * lane + 1) * TP + wid * 16) = (u32x2){y1.x, y1.y}; *(LAS u32x2*)(YTw + (2 * lane + 1) * TP + wid * 16 + 8) = (u32x2){y1.z, y1.w}; }
    }
    LRU_PREFETCH(1);
    BAR_LDS();
    for (int c = 0; c < 33; ++c) {
        asm volatile("" : "+v"(lxo), "+v"(lyo));
        LAS unsigned char* XAr = lds + (c & 1) * SET_B; LAS unsigned char* XTr = XAr + XA_B; LAS unsigned char* YTr = XTr + CT_B; LAS unsigned char* OTr = YTr + CT_B;
        if (c + 1 < 33) { LAS unsigned char* XAw = lds + ((c + 1) & 1) * SET_B; LAS unsigned char* XTw = XAw + XA_B; LAS unsigned char* YTw = XTw + CT_B;
        { f32x2 xv[11];
#pragma unroll
          for (int q = 0; q < 11; ++q) xv[q] = (f32x2){bflo(xl[q]), bfhi(xl[q])};
          unsigned xp[8];
#pragma unroll
          for (int q = 0; q < 8; ++q) { const f32x2 v = cw0 * xv[q] + cw1 * xv[q + 1] + cw2 * xv[q + 2] + cw3 * xv[q + 3] + cbv; xp[q] = cvt_pk_bf16(v[0], v[1]);
              *(LAS unsigned*)(XAw + (wid * 8 + q) * LT + lane * 4) = xp[q]; }
          u32x4 x0, x1, y0, y1;
          x0.x = __builtin_amdgcn_perm(xp[1], xp[0], 0x05040100u); x0.y = __builtin_amdgcn_perm(xp[3], xp[2], 0x05040100u); x0.z = __builtin_amdgcn_perm(xp[5], xp[4], 0x05040100u); x0.w = __builtin_amdgcn_perm(xp[7], xp[6], 0x05040100u);
          x1.x = __builtin_amdgcn_perm(xp[1], xp[0], 0x07060302u); x1.y = __builtin_amdgcn_perm(xp[3], xp[2], 0x07060302u); x1.z = __builtin_amdgcn_perm(xp[5], xp[4], 0x07060302u); x1.w = __builtin_amdgcn_perm(xp[7], xp[6], 0x07060302u);
          y0.x = __builtin_amdgcn_perm(yl[1], yl[0], 0x05040100u); y0.y = __builtin_amdgcn_perm(yl[3], yl[2], 0x05040100u); y0.z = __builtin_amdgcn_perm(yl[5], yl[4], 0x05040100u); y0.w = __builtin_amdgcn_perm(yl[7], yl[6], 0x05040100u);
          y1.x = __builtin_amdgcn_perm(yl[1], yl[0], 0x07060302u); y1.y = __builtin_amdgcn_perm(yl[3], yl[2], 0x07060302u); y1.z = __builtin_amdgcn_perm(yl[5], yl[4], 0x07060302u); y1.w = __builtin_amdgcn_perm(yl[7], yl[6], 0x07060302u);
          *(LAS u32x2*)(XTw + (2 * lane) * TP + wid * 16) = (u32x2){x0.x, x0.y}; *(LAS u32x2*)(XTw + (2 * lane) * TP + wid * 16 + 8) = (u32x2){x0.z, x0.w};
          *(LAS u32x2*)(XTw + (2 * lane + 1) * TP + wid * 16) = (u32x2){x1.x, x1.y}; *(LAS u32x2*)(XTw + (2 * lane + 1) * TP + wid * 16 + 8) = (u32x2){x1.z, x1.w};
          *(LAS u32x2*)(YTw + (2 * lane) * TP + wid * 16) = (u32x2){y0.x, y0.y}; *(LAS u32x2*)(YTw + (2 * lane) * TP + wid * 16 + 8) = (u32x2){y0.z, y0.w};
          *(LAS u32x2*)(YTw + (2 * lane + 1) * TP + wid * 16) = (u32x2){y1.x, y1.y}; *(LAS u32x2*)(YTw + (2 * lane + 1) * TP + wid * 16 + 8) = (u32x2){y1.z, y1.w}; }
            if (c + 2 < 33) LRU_PREFETCH(c + 2); }
        {
            f32x4 ar[4], ai[4];
#pragma unroll
            for (int m = 0; m < 4; ++m) { ar[m] = (f32x4){0.f, 0.f, 0.f, 0.f}; ai[m] = (f32x4){0.f, 0.f, 0.f, 0.f}; }
#pragma unroll
            for (int ks = 0; ks < 4; ++ks)
#pragma unroll
                for (int m = 0; m < 4; ++m) { const bf16x8 af = *(const LAS bf16x8*)(XAr + (16 * (fr >> 2) + 4 * m + (fr & 3)) * LT + ks * 64 + g * 16);
                    ar[m] = __builtin_amdgcn_mfma_f32_16x16x32_bf16(af, Br[ks], ar[m], 0, 0, 0); ai[m] = __builtin_amdgcn_mfma_f32_16x16x32_bf16(af, Bi[ks], ai[m], 0, 0, 0); }
            f32x2 a2[4][2], u2[4][2], yg2[4][2];
#pragma unroll
            for (int m = 0; m < 4; ++m) {
                const u32x2 xw = *(const LAS u32x2*)(XTr + (wid * 16 + fr) * TP + (16 * g + 4 * m) * 2), yw = *(const LAS u32x2*)(YTr + (wid * 16 + fr) * TP + (16 * g + 4 * m) * 2);
#pragma unroll
                for (int p = 0; p < 2; ++p) {
                    const unsigned xwp = p ? xw.y : xw.x, ywp = p ? yw.y : yw.x;
                    const f32x2 xc = {bflo(xwp), bfhi(xwp)}, y = {bflo(ywp), bfhi(ywp)};
                    const f32x2 tr = (f32x2){ar[m][2 * p], ar[m][2 * p + 1]} * (-LOG2E) + nbr, ti = (f32x2){ai[m][2 * p], ai[m][2 * p + 1]} * (-LOG2E) + nbi;
                    f32x2 z = y * y; z = z * 0.044715f + 1.0f; z = z * y; z = z * (-2.0f * 0.7978845608028654f * LOG2E);
                    f32x2 er, ei, eg;
                    er[0] = __builtin_amdgcn_exp2f(fminf(tr[0], 40.f)); er[1] = __builtin_amdgcn_exp2f(fminf(tr[1], 40.f));
                    ei[0] = __builtin_amdgcn_exp2f(fminf(ti[0], 40.f)); ei[1] = __builtin_amdgcn_exp2f(fminf(ti[1], 40.f));
                    eg[0] = __builtin_amdgcn_exp2f(fminf(z[0], 40.f)); eg[1] = __builtin_amdgcn_exp2f(fminf(z[1], 40.f));
                    const f32x2 dr = er + 1.0f, di = ei + 1.0f, dg = eg + 1.0f;
                    const f32x2 pd = dr * di, pr = pd * dg;
                    f32x2 inv; inv[0] = __builtin_amdgcn_rcpf(pr[0]); inv[1] = __builtin_amdgcn_rcpf(pr[1]);
                    const f32x2 t1 = inv * dg, r = t1 * di, ig = t1 * dr, sg = inv * pd;
                    const f32x2 ea = r * c2;
                    f32x2 av; av[0] = __builtin_amdgcn_exp2f(ea[0]); av[1] = __builtin_amdgcn_exp2f(ea[1]);
                    const f32x2 om = 1.0f - av * av;
                    f32x2 sq; sq[0] = __builtin_amdgcn_sqrtf(fmaxf(om[0], 0.f)); sq[1] = __builtin_amdgcn_sqrtf(fmaxf(om[1], 0.f));
                    a2[m][p] = av; u2[m][p] = sq * (ig * xc); yg2[m][p] = y * sg; } }
            if (c == 0 && g < 3) {
#pragma unroll
                for (int m = 0; m < 4; ++m)
#pragma unroll
                    for (int p = 0; p < 2; ++p) { a2[m][p] = (f32x2){1.0f, 1.0f}; u2[m][p] = (f32x2){0.f, 0.f}; } }
            float A16 = 1.0f, U16 = 0.f;
#pragma unroll
            for (int m = 0; m < 4; ++m)
#pragma unroll
                for (int p = 0; p < 2; ++p) { U16 = a2[m][p][0] * U16 + u2[m][p][0]; A16 *= a2[m][p][0]; U16 = a2[m][p][1] * U16 + u2[m][p][1]; A16 *= a2[m][p][1]; }
            float H = carry, Hm = carry;
#pragma unroll
            for (int gg = 0; gg < 4; ++gg) { const float Ag = __shfl(A16, fr + 16 * gg), Ug = __shfl(U16, fr + 16 * gg); if (gg == g) Hm = H; H = Ag * H + Ug; }
            carry = H;
            float h = Hm;
#pragma unroll
            for (int m = 0; m < 4; ++m) {
                const float h0 = a2[m][0][0] * h + u2[m][0][0], h1 = a2[m][0][1] * h0 + u2[m][0][1], h2 = a2[m][1][0] * h1 + u2[m][1][0], h3 = a2[m][1][1] * h2 + u2[m][1][1]; h = h3;
                *(LAS u32x2*)(OTr + (wid * 16 + fr) * TP + (16 * g + 4 * m) * 2) = (u32x2){cvt_pk_bf16(h0 * yg2[m][0][0], h1 * yg2[m][0][1]), cvt_pk_bf16(h2 * yg2[m][1][0], h3 * yg2[m][1][1])}; }
        }
        BAR_LDS();
        if (c > 0) {
            const u32x2 o0a = *(const LAS u32x2*)(OTr + (2 * lane) * TP + wid * 16), o0b = *(const LAS u32x2*)(OTr + (2 * lane) * TP + wid * 16 + 8);
            const u32x2 o1a = *(const LAS u32x2*)(OTr + (2 * lane + 1) * TP + wid * 16), o1b = *(const LAS u32x2*)(OTr + (2 * lane + 1) * TP + wid * 16 + 8);
            const u32x4 o0 = {o0a.x, o0a.y, o0b.x, o0b.y}, o1 = {o1a.x, o1a.y, o1b.x, o1b.y};
            bf16_t* op = oab + ((size_t)b * SEQ + (size_t)(c - 1) * 64 + wid * 8) * KUP + 512 + n * 128 + 2 * lane;
            *(unsigned*)(op + 0 * KUP) = __builtin_amdgcn_perm(o1.x, o0.x, 0x05040100u); *(unsigned*)(op + 1 * KUP) = __builtin_amdgcn_perm(o1.x, o0.x, 0x07060302u);
            *(unsigned*)(op + 2 * KUP) = __builtin_amdgcn_perm(o1.y, o0.y, 0x05040100u); *(unsigned*)(op + 3 * KUP) = __builtin_amdgcn_perm(o1.y, o0.y, 0x07060302u);
            *(unsigned*)(op + 4 * KUP) = __builtin_amdgcn_perm(o1.z, o0.z, 0x05040100u); *(unsigned*)(op + 5 * KUP) = __builtin_amdgcn_perm(o1.z, o0.z, 0x07060302u);
            *(unsigned*)(op + 6 * KUP) = __builtin_amdgcn_perm(o1.w, o0.w, 0x05040100u); *(unsigned*)(op + 7 * KUP) = __builtin_amdgcn_perm(o1.w, o0.w, 0x07060302u); }
    }
#undef LRU_PREFETCH
}

constexpr int KEP = 144;
__device__ void hgrn_fast(const Params& P, LAS unsigned char* lds, int unit) {
    const int tid = threadIdx.x, wid = __builtin_amdgcn_readfirstlane(tid >> 6), lane = tid & 63, b = unit >> 2, h = unit & 3, fr = lane & 15, g = lane >> 4;
    LAS unsigned char* QG = lds;
    LAS unsigned char* KG = QG + 64 * LT;
    LAS unsigned char* VT = KG + 64 * LT;
    LAS unsigned char* KE = VT + 64 * LT;
    LAS unsigned char* PT = KE + 128 * KEP;
    LAS float* DEC = (LAS float*)(PT + 64 * KEP);
    LAS float* SEG = DEC + 128;
    LAS float* PART = SEG + 8 * 128;
    LAS unsigned char* OGT = (LAS unsigned char*)(PART + 64 * 8);
    LAS unsigned char* OUT = OGT + 64 * LT;
    bf16_t* oab = (bf16_t*)P.out;
    const float LOG2E = 1.4426950408889634f;
    const float* lbp = (const float*)(P.ws + WS_LB) + h * 128 + 2 * lane;
    const float lb0 = lbp[0], lb1 = lbp[1], om0 = 1.0f - lb0, om1 = 1.0f - lb1;
    int pos; { const int d = 2 * lane, kd = d >> 5, r = d & 31; pos = 32 * kd + 8 * ((r >> 2) & 3) + 4 * (r >> 4) + (r & 3); }
    const f32x4 ng = *(const f32x4*)(P.hg_norm_g + h * 128 + wid * 16 + 4 * g);
    f32x4 S[8];
#pragma unroll
    for (int db = 0; db < 8; ++db) S[db] = (f32x4){0.f, 0.f, 0.f, 0.f};
    unsigned qv[8], fv[8]; u32x4 vv[2], gv[2];
    unsigned hqo = (unsigned)(C_Q + h * 128 + 2 * lane) * 2u, hfo = (unsigned)(C_F + h * 128 + 2 * lane) * 2u;
    unsigned hvo = (unsigned)(C_I + h * 128 + (lane & 15) * 8) * 2u, hoo = (unsigned)(C_OG + h * 128 + (lane & 15) * 8) * 2u;
#define HG_PREFETCH(c) do { const char* r0 = (const char*)seq_row(P, b, (c), wid * 8); \
        _Pragma("unroll") for (int q = 0; q < 8; ++q) { qv[q] = *(const unsigned*)(r0 + (hqo + (unsigned)q * (DIN * 2u))); fv[q] = *(const unsigned*)(r0 + (hfo + (unsigned)q * (DIN * 2u))); } \
        const char* rv = (const char*)seq_row(P, b, (c), wid * 4); \
        _Pragma("unroll") for (int i = 0; i < 2; ++i) { vv[i] = *(const u32x4*)(rv + (hvo + (unsigned)(32 * i + (lane >> 4)) * (DIN * 2u))); gv[i] = *(const u32x4*)(rv + (hoo + (unsigned)(32 * i + (lane >> 4)) * (DIN * 2u))); } } while (0)
    BAR_LDS();
    HG_PREFETCH(0);
    for (int c = 0; c < 33; ++c) {
        asm volatile("" : "+v"(hqo), "+v"(hfo), "+v"(hvo), "+v"(hoo));
        float k0[8], k1[8], c0[8], c1[8];
        { float p0 = 1.0f, p1 = 1.0f;
#pragma unroll
          for (int q = 0; q < 8; ++q) { const float x0 = bflo(fv[q]), x1 = bfhi(fv[q]);
              const float e0 = __builtin_amdgcn_exp2f(fminf(-LOG2E * x0, 80.f)), e1 = __builtin_amdgcn_exp2f(fminf(-LOG2E * x1, 80.f));
              const float r0 = __builtin_amdgcn_rcpf(1.0f + e0), r1 = __builtin_amdgcn_rcpf(1.0f + e1);
              const float f0 = lb0 + om0 * r0, f1 = lb1 + om1 * r1;
              k0[q] = om0 * e0 * r0; k1[q] = om1 * e1 * r1;
              p0 *= f0; p1 *= f1; c0[q] = p0; c1[q] = p1; }
          *(LAS f32x2*)(SEG + wid * 128 + 2 * lane) = (f32x2){p0, p1}; }
        BAR_LDS();
        { float pre0 = 1.0f, pre1 = 1.0f, tot0 = 1.0f, tot1 = 1.0f;
#pragma unroll
          for (int w2 = 0; w2 < 8; ++w2) { const f32x2 sv = *(const LAS f32x2*)(SEG + w2 * 128 + 2 * lane); if (w2 < wid) { pre0 *= sv[0]; pre1 *= sv[1]; } tot0 *= sv[0]; tot1 *= sv[1]; }
          unsigned ke0[4], ke1[4]; float keb0 = 0.f, keb1 = 0.f;
#pragma unroll
          for (int q = 0; q < 8; ++q) { const float G0 = pre0 * c0[q], G1 = pre1 * c1[q];
              const float rg0 = __builtin_amdgcn_rcpf(G0), rg1 = __builtin_amdgcn_rcpf(G1);
              const float kg0 = k0[q] * rg0, kg1 = k1[q] * rg1;
              const int t = wid * 8 + q;
              *(LAS unsigned*)(QG + t * LT + pos * 2) = cvt_pk_bf16(bflo(qv[q]) * G0, bfhi(qv[q]) * G1);
              *(LAS unsigned*)(KG + t * LT + pos * 2) = cvt_pk_bf16(kg0, kg1);
              const float e0 = kg0 * tot0, e1 = kg1 * tot1;
              if (q & 1) { ke0[q >> 1] = cvt_pk_bf16(keb0, e0); ke1[q >> 1] = cvt_pk_bf16(keb1, e1); } else { keb0 = e0; keb1 = e1; } }
          *(LAS u32x4*)(KE + (2 * lane) * KEP + wid * 16) = (u32x4){ke0[0], ke0[1], ke0[2], ke0[3]};
          *(LAS u32x4*)(KE + (2 * lane + 1) * KEP + wid * 16) = (u32x4){ke1[0], ke1[1], ke1[2], ke1[3]};
          if (wid == 0) *(LAS f32x2*)(DEC + 2 * lane) = (f32x2){tot0, tot1};
#pragma unroll
          for (int i = 0; i < 2; ++i) { const int p = tid + NTHREADS * i; *(LAS u32x4*)(VT + (p >> 4) * LT + (p & 15) * 16) = vv[i]; *(LAS u32x4*)(OGT + (p >> 4) * LT + (p & 15) * 16) = gv[i];
              if (c >= 2) { const u32x4 ov4 = *(const LAS u32x4*)(OUT + (p >> 4) * LT + (p & 15) * 16);
                  *(u32x4*)(oab + ((size_t)b * SEQ + (size_t)(c - 2) * 64 + (p >> 4)) * KUP + h * 128 + (p & 15) * 8) = ov4; } } }
        BAR_LDS();
        if (c + 1 < 33) HG_PREFETCH(c + 1);
        if (c > 0) {
            const int tb = wid >> 1;
#pragma unroll
            for (int s2 = 0; s2 < 2; ++s2) { const int sb = 2 * (wid & 1) + s2; f32x4 pt = {0.f, 0.f, 0.f, 0.f};
#pragma unroll
                for (int kd = 0; kd < 4; ++kd) { const bf16x8 kf = *(const LAS bf16x8*)(KG + (16 * sb + fr) * LT + kd * 64 + g * 16), qf = *(const LAS bf16x8*)(QG + (16 * tb + fr) * LT + kd * 64 + g * 16);
                    pt = __builtin_amdgcn_mfma_f32_16x16x32_bf16(kf, qf, pt, 0, 0, 0); }
                const int tg = 16 * tb + fr, sg0 = 16 * sb + 4 * g;
                const float m0 = (sg0 + 0 <= tg) ? pt[0] : 0.f, m1 = (sg0 + 1 <= tg) ? pt[1] : 0.f, m2 = (sg0 + 2 <= tg) ? pt[2] : 0.f, m3 = (sg0 + 3 <= tg) ? pt[3] : 0.f;
                *(LAS u32x2*)(PT + tg * KEP + sg0 * 2) = (u32x2){cvt_pk_bf16(m0, m1), cvt_pk_bf16(m2, m3)}; } }
        BAR_LDS();
        bf16x8 Vf[2];
#pragma unroll
        for (int ks = 0; ks < 2; ++ks) { unsigned w4[4];
#pragma unroll
            for (int j = 0; j < 4; ++j) { const int s0 = 32 * ks + 8 * g + 2 * j;
                const unsigned lo = *(const LAS bf16_t*)(VT + s0 * LT + (wid * 16 + fr) * 2), hi = *(const LAS bf16_t*)(VT + (s0 + 1) * LT + (wid * 16 + fr) * 2);
                w4[j] = lo | (hi << 16); }
            u32x4 tv = {w4[0], w4[1], w4[2], w4[3]}; Vf[ks] = __builtin_bit_cast(bf16x8, tv); }
        f32x4 ov[4];
        if (c > 0) {
            bf16x8 Sf[4];
#pragma unroll
            for (int kd = 0; kd < 4; ++kd) { u32x4 tv = {cvt_pk_bf16(S[2 * kd][0], S[2 * kd][1]), cvt_pk_bf16(S[2 * kd][2], S[2 * kd][3]), cvt_pk_bf16(S[2 * kd + 1][0], S[2 * kd + 1][1]), cvt_pk_bf16(S[2 * kd + 1][2], S[2 * kd + 1][3])};
                Sf[kd] = __builtin_bit_cast(bf16x8, tv); }
#pragma unroll
            for (int m = 0; m < 4; ++m) { f32x4 o = {0.f, 0.f, 0.f, 0.f};
#pragma unroll
                for (int ks = 0; ks < 2; ++ks) { const bf16x8 pf = *(const LAS bf16x8*)(PT + (16 * m + fr) * KEP + ks * 64 + g * 16); o = __builtin_amdgcn_mfma_f32_16x16x32_bf16(Vf[ks], pf, o, 0, 0, 0); }
#pragma unroll
                for (int kd = 0; kd < 4; ++kd) { const bf16x8 qf = *(const LAS bf16x8*)(QG + (16 * m + fr) * LT + kd * 64 + g * 16); o = __builtin_amdgcn_mfma_f32_16x16x32_bf16(Sf[kd], qf, o, 0, 0, 0); }
                ov[m] = o; } }
#pragma unroll
        for (int db = 0; db < 8; ++db) { const f32x4 dc = *(const LAS f32x4*)(DEC + 16 * db + 4 * g); f32x4 sa = S[db] * dc;
#pragma unroll
            for (int ks = 0; ks < 2; ++ks) { const bf16x8 kf = *(const LAS bf16x8*)(KE + (16 * db + fr) * KEP + ks * 64 + g * 16); sa = __builtin_amdgcn_mfma_f32_16x16x32_bf16(kf, Vf[ks], sa, 0, 0, 0); }
            S[db] = sa; }
        if (c > 0) {
#pragma unroll
            for (int m = 0; m < 4; ++m) { float pq = ov[m][0] * ov[m][0] + ov[m][1] * ov[m][1] + ov[m][2] * ov[m][2] + ov[m][3] * ov[m][3];
                pq += __shfl_xor(pq, 16); pq += __shfl_xor(pq, 32);
                if (g == 0) PART[(16 * m + fr) * 8 + wid] = pq; } }
        BAR_LDS();
        if (c > 0) {
#pragma unroll
            for (int m = 0; m < 4; ++m) { const f32x4 pa = *(const LAS f32x4*)(PART + (16 * m + fr) * 8), pb = *(const LAS f32x4*)(PART + (16 * m + fr) * 8 + 4);
                const float ss = ((pa[0] + pa[1]) + (pa[2] + pa[3])) + ((pb[0] + pb[1]) + (pb[2] + pb[3]));
                const float rstd = rsqrtf(ss * (1.0f / 128.0f) + EPS);
                const u32x2 ogw = *(const LAS u32x2*)(OGT + (16 * m + fr) * LT + (wid * 16 + 4 * g) * 2);
                const float g0 = bflo(ogw.x), g1 = bfhi(ogw.x), g2 = bflo(ogw.y), g3 = bfhi(ogw.y);
                const float o0 = ov[m][0] * rstd * ng[0] * __builtin_amdgcn_rcpf(1.0f + __builtin_amdgcn_exp2f(-LOG2E * g0));
                const float o1 = ov[m][1] * rstd * ng[1] * __builtin_amdgcn_rcpf(1.0f + __builtin_amdgcn_exp2f(-LOG2E * g1));
                const float o2 = ov[m][2] * rstd * ng[2] * __builtin_amdgcn_rcpf(1.0f + __builtin_amdgcn_exp2f(-LOG2E * g2));
                const float o3 = ov[m][3] * rstd * ng[3] * __builtin_amdgcn_rcpf(1.0f + __builtin_amdgcn_exp2f(-LOG2E * g3));
                *(LAS u32x2*)(OUT + (16 * m + fr) * LT + (wid * 16 + 4 * g) * 2) = (u32x2){cvt_pk_bf16(o0, o1), cvt_pk_bf16(o2, o3)}; } }
    }
    BAR_LDS();
#pragma unroll
    for (int i = 0; i < 2; ++i) { const int p = tid + NTHREADS * i; const u32x4 ov4 = *(const LAS u32x4*)(OUT + (p >> 4) * LT + (p & 15) * 16);
        *(u32x4*)(oab + ((size_t)b * SEQ + (size_t)31 * 64 + (p >> 4)) * KUP + h * 128 + (p & 15) * 8) = ov4; }
#undef HG_PREFETCH
}

__device__ void p5_router_fast(const Params& P, LAS unsigned char* lds, int bid, int nb) {
    const int tid = threadIdx.x, wid = __builtin_amdgcn_readfirstlane(tid >> 6), lane = tid & 63, fr = lane & 15, g = lane >> 4;
    unsigned char* ws = P.ws;
    const bf16_t* h2 = (const bf16_t*)(ws + WS_H2); const bf16_t* wrt = (const bf16_t*)(ws + WS_WR);
    int* counts = (int*)(ws + WS_CTL + CTL_CNT); int* ltk = (int*)(ws + WS_LTK); float* lw = (float*)(ws + WS_LW);
    LAS int* lcnt = (LAS int*)lds; LAS int* lbase = lcnt + 32; LAS int* ae = lbase + 32; LAS int* al = ae + 512; LAS float* aw = (LAS float*)(al + 512); LAS float* ars = aw + 512;
    float* lrs = (float*)(ws + WS_LRS);
    const float bg = P.b_group[g];
    float br8[8];
#pragma unroll
    for (int e = 0; e < 8; ++e) br8[e] = P.b_router[g * 8 + e];
    __syncthreads();
    for (int p = tid; p < 48 * 128; p += NTHREADS) { const int row = p >> 7, c16 = p & 127;
        *(LAS u32x4*)(lds + 12288 + row * 2064 + c16 * 16) = *(const u32x4*)(wrt + (size_t)row * D + c16 * 8); }
    for (int t0 = bid * 256; t0 < NTOK; t0 += nb * 256) {
        __syncthreads();
        if (tid < 32) lcnt[tid] = 0;
        __syncthreads();
        f32x4 acc[2][3];
#pragma unroll
        for (int tt = 0; tt < 2; ++tt)
#pragma unroll
            for (int nt = 0; nt < 3; ++nt) acc[tt][nt] = (f32x4){0.f, 0.f, 0.f, 0.f};
        const bf16_t* ap = h2 + (size_t)(t0 + wid * 32 + fr) * D + g * 8;
        LAS unsigned char* WL = lds + 12288;
        const LAS unsigned char* bl = WL + fr * 2064 + g * 16;
        float sq0 = 0.f, sq1 = 0.f;
#pragma unroll 1
        for (int k8 = 0; k8 < 32; k8 += 8) {
            bf16x8 a0[8], a1[8];
#pragma unroll
            for (int q = 0; q < 8; ++q) { a0[q] = *(const bf16x8*)(ap + (k8 + q) * 32); a1[q] = *(const bf16x8*)(ap + 16 * D + (k8 + q) * 32); }
#pragma unroll
            for (int q = 0; q < 8; ++q) { const int ks = k8 + q;
                const bf16x8 b0 = *(const LAS bf16x8*)(bl + ks * 64), b1 = *(const LAS bf16x8*)(bl + 16 * 2064 + ks * 64), b2 = *(const LAS bf16x8*)(bl + 32 * 2064 + ks * 64);
                acc[0][0] = __builtin_amdgcn_mfma_f32_16x16x32_bf16(b0, a0[q], acc[0][0], 0, 0, 0); acc[0][1] = __builtin_amdgcn_mfma_f32_16x16x32_bf16(b1, a0[q], acc[0][1], 0, 0, 0);
                acc[0][2] = __builtin_amdgcn_mfma_f32_16x16x32_bf16(b2, a0[q], acc[0][2], 0, 0, 0); acc[1][0] = __builtin_amdgcn_mfma_f32_16x16x32_bf16(b0, a1[q], acc[1][0], 0, 0, 0);
                acc[1][1] = __builtin_amdgcn_mfma_f32_16x16x32_bf16(b1, a1[q], acc[1][1], 0, 0, 0); acc[1][2] = __builtin_amdgcn_mfma_f32_16x16x32_bf16(b2, a1[q], acc[1][2], 0, 0, 0);
                { const u32x4 w0 = __builtin_bit_cast(u32x4, a0[q]), w1 = __builtin_bit_cast(u32x4, a1[q]);
#define SQ_ACC(sq, w) asm volatile("v_dot2c_f32_bf16 %0, %1, %1" : "+v"(sq) : "v"(w))
                  SQ_ACC(sq0, w0.x); SQ_ACC(sq0, w0.y); SQ_ACC(sq0, w0.z); SQ_ACC(sq0, w0.w); SQ_ACC(sq1, w1.x); SQ_ACC(sq1, w1.y); SQ_ACC(sq1, w1.z); SQ_ACC(sq1, w1.w);
#undef SQ_ACC
                } }
        }
        sq0 += __shfl_xor(sq0, 16); sq0 += __shfl_xor(sq0, 32); sq1 += __shfl_xor(sq1, 16); sq1 += __shfl_xor(sq1, 32);
#pragma unroll
        for (int tt = 0; tt < 2; ++tt) {
            const int tl = wid * 32 + tt * 16 + fr;
            const float rstd = rsqrtf((tt ? sq1 : sq0) * (1.0f / D) + EPS);
            const float mygl = acc[tt][2][0] * rstd + bg;
            float gl[4];
#pragma unroll
            for (int gg = 0; gg < 4; ++gg) gl[gg] = __shfl(mygl, fr + 16 * gg);
            int gs = 0; float gm = gl[0];
#pragma unroll
            for (int j = 1; j < 4; ++j) if (gl[j] > gm) { gm = gl[j]; gs = j; }
            float den = 0.f;
#pragma unroll
            for (int j = 0; j < 4; ++j) den += __expf(gl[j] - gm);
            const float psel = 1.0f / den;
            if (g == gs) {
                float el[8];
#pragma unroll
                for (int e = 0; e < 8; ++e) el[e] = acc[tt][e >> 2][e & 3] * rstd + br8[e];
                int i0 = 0; float v0 = el[0];
#pragma unroll
                for (int e = 1; e < 8; ++e) if (el[e] > v0) { v0 = el[e]; i0 = e; }
                int i1 = -1; float v1 = -3.0e38f;
#pragma unroll
                for (int e = 0; e < 8; ++e) if (e != i0 && el[e] > v1) { v1 = el[e]; i1 = e; }
                const float e1 = __expf(v1 - v0); const float w0 = psel / (1.0f + e1), w1 = psel * e1 / (1.0f + e1);
                const int ex0 = gs * 8 + i0, ex1 = gs * 8 + i1;
                ae[tl * 2] = ex0; al[tl * 2] = __hip_atomic_fetch_add(lcnt + ex0, 1, __ATOMIC_RELAXED, __HIP_MEMORY_SCOPE_WORKGROUP); aw[tl * 2] = w0; ars[tl * 2] = rstd * (1.0f / WGU_SCALE);
                ae[tl * 2 + 1] = ex1; al[tl * 2 + 1] = __hip_atomic_fetch_add(lcnt + ex1, 1, __ATOMIC_RELAXED, __HIP_MEMORY_SCOPE_WORKGROUP); aw[tl * 2 + 1] = w1; ars[tl * 2 + 1] = rstd * (1.0f / WGU_SCALE);
            }
        }
        __syncthreads();
        if (tid < 32) lbase[tid] = atomicAdd(counts + tid, lcnt[tid]);
        __syncthreads();
        { const int a = tid; const int e = ae[a]; const int pos = lbase[e] + al[a];
          ltk[(size_t)e * LCAP + pos] = (t0 + (a >> 1)) * 2 + (a & 1); lw[(size_t)e * LCAP + pos] = aw[a]; lrs[(size_t)e * LCAP + pos] = ars[a]; }
    }
}

__device__ void p8_final(const Params& P, int bid, int nb) {
    const int tid = threadIdx.x, wid = tid >> 6, lane = tid & 63;
    const bf16_t* h2 = (const bf16_t*)(P.ws + WS_H2); const unsigned char* yb = (const unsigned char*)(P.ws + WS_Y);
    f32x4 gq[4];
#pragma unroll
    for (int q = 0; q < 4; ++q) gq[q] = *(const f32x4*)(P.final_g + 256 * q + 4 * lane);
    for (int r0 = (bid * 8 + wid) * 4; r0 < NTOK; r0 += nb * 8 * 4) {
        u32x2 hv[4][4]; unsigned y0[4][4], y1[4][4];
#pragma unroll
        for (int rr = 0; rr < 4; ++rr) { const size_t r = (size_t)(r0 + rr);
#pragma unroll
            for (int q = 0; q < 4; ++q) { hv[rr][q] = *(const u32x2*)(h2 + r * D + 256 * q + 4 * lane);
                y0[rr][q] = *(const unsigned*)(yb + (r * 2) * D + 256 * q + 4 * lane); y1[rr][q] = *(const unsigned*)(yb + (r * 2 + 1) * D + 256 * q + 4 * lane); } }
#pragma unroll
        for (int rr = 0; rr < 4; ++rr) { f32x4 v[4]; float ss = 0.f;
#pragma unroll
            for (int q = 0; q < 4; ++q) {
                const f32x2 a01 = __builtin_amdgcn_cvt_pk_f32_fp8((int)y0[rr][q], false), a23 = __builtin_amdgcn_cvt_pk_f32_fp8((int)y0[rr][q], true), b01 = __builtin_amdgcn_cvt_pk_f32_fp8((int)y1[rr][q], false), b23 = __builtin_amdgcn_cvt_pk_f32_fp8((int)y1[rr][q], true);
                v[q][0] = bflo(hv[rr][q].x) + (a01[0] + b01[0]) * (1.0f / Y_SCALE); v[q][1] = bfhi(hv[rr][q].x) + (a01[1] + b01[1]) * (1.0f / Y_SCALE);
                v[q][2] = bflo(hv[rr][q].y) + (a23[0] + b23[0]) * (1.0f / Y_SCALE); v[q][3] = bfhi(hv[rr][q].y) + (a23[1] + b23[1]) * (1.0f / Y_SCALE);
                ss += v[q][0] * v[q][0] + v[q][1] * v[q][1] + v[q][2] * v[q][2] + v[q][3] * v[q][3]; }
            ss = wave_sum(ss); const float rstd = rsqrtf(ss * (1.0f / D) + EPS);
#pragma unroll
            for (int q = 0; q < 4; ++q) *(f32x4*)(P.out + (size_t)(r0 + rr) * D + 256 * q + 4 * lane) = v[q] * rstd * gq[q]; }
    }
}

__device__ __forceinline__ void moe_table(const Params& P, volatile LAS int* tpre) {
    if (threadIdx.x < 64) { const int lane = threadIdx.x; const int* counts = (const int*)(P.ws + WS_CTL + CTL_CNT);
        const int cnt = (lane < NE) ? counts[lane] : 0; const int nt = (cnt + 255) >> 8;
        int inc = nt;
#pragma unroll
        for (int o = 1; o < 32; o <<= 1) { const int v = __shfl_up(inc, o); if (lane >= o) inc += v; }
        if (lane < NE) { tpre[lane] = inc - nt; tpre[40 + lane] = cnt;
#pragma unroll 1
            for (int t = inc - nt; t < inc; ++t) tpre[T2E + t] = lane; }
        if (lane == NE - 1) tpre[NE] = inc; }
    __syncthreads();
}
}

__global__ void __launch_bounds__(NTHREADS, 2) fwd_kernel(Params P) {
    extern __shared__ __attribute__((aligned(16))) unsigned char lds_raw[];
    LAS unsigned char* lds = (LAS unsigned char*)lds_raw;
    const int bid = blockIdx.x, nb = gridDim.x;
    unsigned char* ws = P.ws;
    const int lo = P.ph_lo, hi = P.ph_hi;
    volatile LAS unsigned* xbw = (volatile LAS unsigned*)(lds + LDS_BYTES - 16);
    if (threadIdx.x == 0) { xbw[0] = 0u; xbw[1] = 0u; xbw[2] = 0u; xbw[3] = 0u; }
    __syncthreads();
    XcdBarrier bar; bar.bar = (unsigned*)(ws + WS_CTL + CTL_BAR); bar.x = 0; bar.st = xbw;
    if (hi - lo > 1) bar = xcd_barrier_post((unsigned*)(ws + WS_CTL + CTL_BAR), xbw);
#ifdef PROBE_MASK
    unsigned long long pr_t0 = __builtin_amdgcn_s_memrealtime();
#define SEAM(k) do { if ((PROBE_MASK >> (k)) & 1) { const unsigned long long t1 = __builtin_amdgcn_s_memrealtime(); const unsigned long long dt = t1 - pr_t0; \
        while (__builtin_amdgcn_s_memrealtime() - t1 < dt) __builtin_amdgcn_s_sleep(8); } \
        if (IN(k) && IN((k) + 1)) xcd_barrier(bar); pr_t0 = __builtin_amdgcn_s_memrealtime(); } while (0)
#else
#define SEAM(k) do { if (IN(k) && IN((k) + 1)) xcd_barrier(bar); } while (0)
#endif
#ifdef ONLY_PHASE
#define IN(k) ((k) == ONLY_PHASE && lo <= (k) && (k) < hi)
#else
#define IN(k) (lo <= (k) && (k) < hi)
#endif
    if (IN(0)) p0_prologue(P, lds, bid, nb);
    SEAM(0);
    if (IN(1)) { typedef DenseOrder<DIN / 256> DO1; DO1 S; S.init(ws + WS_HN, D * 2, ws + WS_WIN, D * 2, NTOK, DIN, nb, bid);
        EpiStoreBf16 E{(bf16_t*)(ws + WS_PROJ), DIN};
        if constexpr ((FAST_MASK >> 1) & 1) gemm_phase<EpiStoreBf16, DO1, false, 0>(lds, D * 2, D * 2, D, S, E); else gemm_simple<EpiStoreBf16, DO1, false, 0>(D * 2, D * 2, D, S, E); }
    SEAM(1);
    if (IN(2)) {
        if constexpr (((FAST_MASK >> 9) & 3) == 3) {
            volatile LAS int* shu = (volatile LAS int*)(lds + 141 * 1024);
            int* qhead = (int*)(ws + WS_CTL + CTL_CNT + 128);
            for (int u = bid;;) {
                if (u >= 128 + 256) break;
#if defined(P2_REPEAT_H)
                if (u < 128) { hgrn_fast(P, lds, u); hgrn_fast(P, lds, u); } else lru_fast(P, lds, u - 128);
#elif defined(P2_REPEAT_L)
                if (u < 128) hgrn_fast(P, lds, u); else { lru_fast(P, lds, u - 128); lru_fast(P, lds, u - 128); }
#else
                if (u < 128) hgrn_fast(P, lds, u); else lru_fast(P, lds, u - 128);
#endif
                __syncthreads();
                if (threadIdx.x == 0) shu[0] = nb + atomicAdd(qhead, 1);
                __syncthreads();
                u = __builtin_amdgcn_readfirstlane(shu[0]); }
            for (;;) {
                __syncthreads();
                if (threadIdx.x == 0) shu[0] = atomicAdd(qhead + 1, 1);
                __syncthreads();
                const int task = __builtin_amdgcn_readfirstlane(shu[0]);
                if (task >= N_CONV_TASKS) break;
                const int wv = __builtin_amdgcn_readfirstlane(threadIdx.x >> 6);
#pragma unroll 1
                for (int q = wv * (CONV_TPT / 8); q < (wv + 1) * (CONV_TPT / 8); ++q) conv_tile(P, (LAS float*)lds + wv * (64 * 65), T_EARLY + task * CONV_TPT + q); }
        } else {
            for (int u = bid; u < 128 + 256; u += nb) {
                if (u < 128) { if constexpr ((FAST_MASK >> 10) & 1) hgrn_fast(P, lds, u); else hgrn_simple(P, lds, u); }
                else { if constexpr ((FAST_MASK >> 9) & 1) lru_fast(P, lds, u - 128); else lru_simple(P, lds, u - 128); } } } }
    SEAM(2);
    if (IN(3)) { typedef DenseOrder<D / 256> DO4; DO4 S; S.init(P.out, KUP * 2, ws + WS_WUP, KUP * 2, NTOK, D, nb, bid);
        EpiMerge E{(bf16_t*)(ws + WS_HN), (const bf16_t*)(ws + WS_PROJ)};
        if constexpr ((FAST_MASK >> 3) & 1) gemm_phase<EpiMerge, DO4, false, 512>(lds, KUP * 2, KUP * 2, KUP, S, E); else gemm_simple<EpiMerge, DO4, false, 512>(KUP * 2, KUP * 2, KUP, S, E); }
    SEAM(3);
    if (IN(4)) { typedef DenseOrder<D / 256> DO4; DO4 S; S.init(ws + WS_HN, D * 2, ws + WS_WOUT, D * 2, NTOK, D, nb, bid);
        EpiResid E{(bf16_t*)(ws + WS_H2), P.x, ws + WS_H2Q};
        if constexpr ((FAST_MASK >> 4) & 1) gemm_phase<EpiResid, DO4, false, 0>(lds, D * 2, D * 2, D, S, E); else gemm_simple<EpiResid, DO4, false, 0>(D * 2, D * 2, D, S, E); }
    SEAM(4);
    if (IN(5)) p5_router_fast(P, lds, bid, nb);
    SEAM(5);
    if (IN(6)) { volatile LAS int* tpre = (volatile LAS int*)(lds + 140 * 1024); __syncthreads(); moe_table(P, tpre);
        MoeOrder S; S.A = (const char*)(ws + WS_H2Q); S.B = (const char*)(ws + WS_WGU); S.ltk = (const int*)(ws + WS_LTK); S.lf = (const float*)(ws + WS_LRS); S.tpre = tpre; S.nN = 4; S.nunits = __builtin_amdgcn_readfirstlane(tpre[NE]) * 4; S.G = nb; S.c = bid;
        S.b_exp = (size_t)1024 * D; S.b_tile = (size_t)256 * D; S.a_row = D; S.gather = true;
        EpiAct E{(bf16_t*)(ws + WS_ACT), tpre};
        gemm_phase<EpiAct, MoeOrder, true, 0, true>(lds, D, D, D / 2, S, E); }
    SEAM(6);
    if (IN(7)) { volatile LAS int* tpre = (volatile LAS int*)(lds + 140 * 1024); __syncthreads(); moe_table(P, tpre);
        MoeOrder S; S.A = (const char*)(ws + WS_ACT); S.B = (const char*)(ws + WS_WD); S.ltk = (const int*)(ws + WS_LTK); S.lf = (const float*)(ws + WS_LW); S.tpre = tpre; S.nN = 4; S.nunits = __builtin_amdgcn_readfirstlane(tpre[NE]) * 4; S.G = nb; S.c = bid;
        S.b_exp = (size_t)D * DE; S.b_tile = (size_t)256 * DE; S.a_row = DE; S.gather = false;
        EpiDown E{(bf16_t*)(ws + WS_Y), tpre};
        gemm_phase<EpiDown, MoeOrder, true, 0, true>(lds, DE, DE, DE / 2, S, E); }
    SEAM(7);
    if (IN(8)) p8_final(P, bid, nb);
#ifdef PROBE_MASK
    SEAM(8);
#endif
#undef IN
#undef SEAM
}

extern "C" void kernel_launch(void* const* d_in, const int* in_sizes, int n_in, void* d_out, int out_size, void* d_ws, size_t ws_size, hipStream_t stream) {
    static int grid = 0;
    if (grid == 0) {
        if (n_in != 25 || in_sizes[0] != NTOK * D || out_size != NTOK * D || ws_size < WS_END) {
            fprintf(stderr, "kernel_launch: unexpected shapes (n_in %d, in0 %d, out %d, ws %zu < %zu); nothing launched\n", n_in, n_in > 0 ? in_sizes[0] : -1, out_size, ws_size, (size_t)WS_END); grid = -1; return; }
        int dev = 0, cus = 0;
        if (hipGetDevice(&dev) != hipSuccess || hipDeviceGetAttribute(&cus, hipDeviceAttributeMultiprocessorCount, dev) != hipSuccess) { grid = -1; return; }
        if (hipFuncSetAttribute((const void*)fwd_kernel, hipFuncAttributeMaxDynamicSharedMemorySize, LDS_BYTES) != hipSuccess) { fprintf(stderr, "kernel_launch: hipFuncSetAttribute failed\n"); grid = -1; return; }
        grid = cus;
    }
    if (grid < 0) return;
    (void)hipMemsetAsync((char*)d_ws + WS_CTL, 0, CTL_ZERO_BYTES, stream);
    Params p{};
    const float** f = (const float**)&p;
    for (int i = 0; i < 25; ++i) f[i] = (const float*)d_in[i];
    p.out = (float*)d_out; p.ws = (unsigned char*)d_ws;
#if NLAUNCH == 1
    p.ph_lo = 0; p.ph_hi = 9;
    hipLaunchKernelGGL(fwd_kernel, dim3(grid), dim3(NTHREADS), LDS_BYTES, stream, p);
#else
    for (int ph = 0; ph < 9; ++ph) { p.ph_lo = ph; p.ph_hi = ph + 1;
        hipLaunchKernelGGL(fwd_kernel, dim3(grid), dim3(NTHREADS), LDS_BYTES, stream, p); }
#endif
}
```

```cpp
#include <hip/hip_runtime.h>
#include <cstdio>
#include <cstdint>

#ifndef FAST_MASK
#define FAST_MASK 0x7ff
#endif
#ifndef NLAUNCH
#define NLAUNCH 1
#endif

#define LAS __attribute__((address_space(3)))
typedef unsigned short bf16_t;
typedef short bf16x8 __attribute__((ext_vector_type(8)));
typedef float f32x4 __attribute__((ext_vector_type(4)));
typedef float f32x2 __attribute__((ext_vector_type(2)));
typedef unsigned u32x4 __attribute__((ext_vector_type(4)));
typedef unsigned u32x2 __attribute__((ext_vector_type(2)));
typedef __bf16 bf2_t __attribute__((ext_vector_type(2)));

#define XB_TMO      128
#define XB_XCNT(j)  (256  + 64 * (j))
#define XB_XSUB(j)  (1280 + 64 * (j))
#define XB_XGEN(j)  (2304 + 64 * (j))
#define XB_TOP      3328
#define XB_TOPGEN   3392
#define XCD_BAR_WORDS 3456
#define XB_SPIN_CAP (1u << 18)

__device__ __forceinline__ unsigned xb_ld(unsigned* p)              { return __hip_atomic_load(p, __ATOMIC_RELAXED, __HIP_MEMORY_SCOPE_AGENT); }
__device__ __forceinline__ unsigned xb_add(unsigned* p, unsigned v) { return __hip_atomic_fetch_add(p, v, __ATOMIC_RELAXED, __HIP_MEMORY_SCOPE_AGENT); }
__device__ __forceinline__ unsigned xb_xcc_id() { return (unsigned)__builtin_amdgcn_s_getreg((3 << 11) | 20) & 0xFu; }
#define XB_SPIN(cond, bar) do { unsigned _sp = 0; while (cond) { __builtin_amdgcn_s_sleep(1); \
    if ((++_sp & 255u) == 0u) { if (xb_ld(&(bar)[XB_TMO])) break; if (_sp > XB_SPIN_CAP) { atomicAdd(&(bar)[XB_TMO], 1u); break; } } } } while (0)

struct XcdBarrier {
    unsigned* bar; unsigned x;
    volatile LAS unsigned* st;
};

__device__ __forceinline__ XcdBarrier xcd_barrier_post(unsigned* bar, volatile LAS unsigned* st) {
    XcdBarrier b; b.bar = bar; b.x = xb_xcc_id(); b.st = st;
    if (threadIdx.x == 0) (void)xb_add(&bar[XB_XCNT(b.x)], 1u);
    return b;
}
__device__ __forceinline__ void xcd_barrier_complete(unsigned* bar, unsigned x, unsigned& nloc, unsigned& nx) {
    const unsigned G = gridDim.x * gridDim.y * gridDim.z;
    unsigned sum, cnt, mine, sp = 0u;
    for (;;) {
        sum = 0u; cnt = 0u; mine = 0u;
#pragma unroll
        for (unsigned j = 0; j < 16; ++j) { const unsigned c = xb_ld(&bar[XB_XCNT(j)]); sum += c; cnt += (c > 0u) ? 1u : 0u; mine = (j == x) ? c : mine; }
        if (sum == G) break;
        __builtin_amdgcn_s_sleep(1);
        if ((++sp & 255u) == 0u) { if (xb_ld(&bar[XB_TMO])) break; if (sp > XB_SPIN_CAP) { atomicAdd(&bar[XB_TMO], 1u); break; } }
    }
    nloc = mine > 0u ? mine : 1u; nx = cnt > 0u ? cnt : 1u;
}

__device__ __forceinline__ void xcd_barrier(const XcdBarrier& b) {
    asm volatile("s_waitcnt vmcnt(0)" ::: "memory");
    __syncthreads();
    if (threadIdx.x == 0) {
        unsigned* bar = b.bar;
        __builtin_amdgcn_s_waitcnt(0);
        unsigned nloc = b.st[0], nx = b.st[1];
        if (nloc == 0u) { xcd_barrier_complete(bar, b.x, nloc, nx); b.st[0] = nloc; b.st[1] = nx; }
        const unsigned old = xb_add(&bar[XB_XSUB(b.x)], 1u);
        const unsigned gen = old / nloc;
        if (old + 1u == (gen + 1u) * nloc) {
            __builtin_amdgcn_fence(__ATOMIC_RELEASE, "agent");
            asm volatile("s_waitcnt vmcnt(0)" ::: "memory");
            const unsigned og = xb_add(&bar[XB_TOP], 1u);
            const unsigned tg = og / nx;
            if (og + 1u == (tg + 1u) * nx) xb_add(&bar[XB_TOPGEN], 1u);
            else XB_SPIN(xb_ld(&bar[XB_TOPGEN]) == tg, bar);
            __builtin_amdgcn_fence(__ATOMIC_ACQUIRE, "agent");
            xb_add(&bar[XB_XGEN(b.x)], 1u);
            asm volatile("s_waitcnt vmcnt(0)" ::: "memory");
        } else {
            XB_SPIN(xb_ld(&bar[XB_XGEN(b.x)]) == gen, bar);
            __builtin_amdgcn_fence(__ATOMIC_ACQUIRE, "agent");
            asm volatile("s_waitcnt vmcnt(0)" ::: "memory");
        }
    }
    __syncthreads();
}


namespace {
constexpr int NB = 32, SEQ = 2048, NMETA = 16, D = 1024, NTOK = NB * SEQ;
constexpr int TSEQ = SEQ + NMETA;
constexpr int DIN = 6144, DHG = 512, NE = 32, DE = 512;
constexpr int C_Q = 0, C_F = 512, C_I = 1024, C_OG = 1536, C_LX = 2048, C_LY = 3072, C_GA = 4096, C_GB = 5120;
constexpr int KUP = 1536;
constexpr float EPS = 1e-6f;
constexpr int NTHREADS = 512;
constexpr int LDS_BYTES = 144 * 1024;
constexpr int ACT_ROWS = 139264;
constexpr int LCAP = 65536;
constexpr float WD_SCALE = 32.0f, WGU_SCALE = 64.0f, ACT_SCALE = 8.0f, Y_SCALE = 16.0f;

constexpr size_t MiB = 1024ull * 1024ull;
constexpr size_t WS_PROJ = 0;
constexpr size_t WS_H2   = 0;
constexpr size_t WS_Y    = 128 * MiB;
constexpr size_t WS_ACT  = 384 * MiB;
constexpr size_t WS_LTK  = 520 * MiB;
constexpr size_t WS_LW   = 528 * MiB;
constexpr size_t WS_LRS  = 608 * MiB;
constexpr size_t WS_YDUMMY = 600 * MiB;
constexpr int Y_DUMMY_ROW = (int)((600 * MiB - 128 * MiB) / 1024);
constexpr size_t WS_H2Q  = 536 * MiB;
constexpr size_t WS_HN   = 768 * MiB;
constexpr size_t WS_W    = 896 * MiB;
constexpr size_t WS_WIN  = WS_W;
constexpr size_t WS_WUP  = WS_WIN + (size_t)DIN * D * 2;
constexpr size_t WS_WOUT = WS_WUP + (size_t)D * KUP * 2;
constexpr size_t WS_WGU  = WS_WOUT + (size_t)D * D * 2;
constexpr size_t WS_WD   = WS_WGU + (size_t)NE * 1024 * D * 2;
constexpr size_t WS_WR   = WS_WD + (size_t)NE * D * DE * 2;
constexpr size_t WS_CTL  = WS_WR + 128 * 1024;
constexpr size_t CTL_BAR = 0, CTL_CNT = 16384;
constexpr size_t CTL_ZERO_BYTES = 16384 + 256;
constexpr size_t WS_SSQ  = WS_CTL + 32768;
constexpr size_t WS_PROJM = WS_SSQ + (size_t)NTOK * 4;
constexpr size_t WS_LB   = WS_PROJM + (size_t)NMETA * DIN * 4;
constexpr size_t WS_METAT = WS_LB + 4096;
constexpr size_t WS_END  = WS_METAT + (size_t)64 * DIN * 2;

struct Params {
    const float *x, *meta, *norm1_g, *w_in, *hg_lb, *hg_norm_g, *conv_w, *conv_b, *w_r, *b_r, *w_i, *b_i, *lam, *w_up_a, *w_up_b, *w_out,
                *norm2_g, *w_group, *b_group, *w_router, *b_router, *w_gate, *w_up, *w_down, *final_g;
    float* out; unsigned char* ws;
    int ph_lo, ph_hi;
};

__device__ __forceinline__ float bf2f(bf16_t b) { return __uint_as_float(((unsigned)b) << 16); }
__device__ __forceinline__ unsigned cvt_pk_bf16(float lo, float hi) { unsigned r; asm volatile("v_cvt_pk_bf16_f32 %0, %1, %2" : "=v"(r) : "v"(lo), "v"(hi)); return r; }
__device__ __forceinline__ bf16_t f2bf(float f) { return (bf16_t)(cvt_pk_bf16(f, 0.f) & 0xffffu); }
__device__ __forceinline__ float sigmoidf_(float x) { return 1.0f / (1.0f + __expf(-x)); }
__device__ __forceinline__ float gelu_tanh(float y) { const float z = 0.7978845608028654f * (y + 0.044715f * y * y * y); const float t = 1.0f - 2.0f / (1.0f + __expf(2.0f * z)); return 0.5f * y * (1.0f + t); }
__device__ __forceinline__ float wave_sum(float v) {
#pragma unroll
    for (int o = 32; o > 0; o >>= 1) v += __shfl_xor(v, o);
    return v;
}
__device__ __forceinline__ unsigned pack4_fp8(float a, float b, float c, float d) {
    a = __builtin_amdgcn_fmed3f(a, -448.f, 448.f); b = __builtin_amdgcn_fmed3f(b, -448.f, 448.f); c = __builtin_amdgcn_fmed3f(c, -448.f, 448.f); d = __builtin_amdgcn_fmed3f(d, -448.f, 448.f);
    int v = __builtin_amdgcn_cvt_pk_fp8_f32(a, b, 0, false); v = __builtin_amdgcn_cvt_pk_fp8_f32(c, d, v, true); return (unsigned)v; }
__device__ __forceinline__ int perm32(int rho) { const int n = rho >> 4, i = rho & 15; return 8 * (i >> 2) + 4 * n + (i & 3); }

struct Unit { const char* A; const char* B; int pm, pn, e, cnt, tile, slot; };

__device__ __forceinline__ int xcd_remap(int L, int nwg) {
    const int q = nwg / 8, r = nwg % 8, xcd = L % 8, off = L / 8; return (xcd < r ? xcd * (q + 1) : r * (q + 1) + (xcd - r) * q) + off; }
template <int NN>
struct DenseOrder {
    const char* A; const char* B; int nunits, G, c; size_t a_tile, b_tile;
    __device__ void init(const void* A_, size_t lda_b, const void* B_, size_t ldb_b, int M, int N, int G_, int c_) {
        A = (const char*)A_; B = (const char*)B_; nunits = (M / 256) * NN; G = G_; c = c_; a_tile = 256 * lda_b; b_tile = 256 * ldb_b; }
    __device__ __forceinline__ bool next(int i, Unit& u) const {
        const int L = i * G + c; if (L >= nunits) return false;
        const int W = xcd_remap(L, nunits);
        constexpr int nig = 8 * NN; const int gid = W / nig, w = W - gid * nig;
        u.pm = gid * 8 + (w & 7); u.pn = w >> 3; u.e = 0; u.cnt = 256; u.tile = 0; u.A = A + (size_t)u.pm * a_tile; u.B = B + (size_t)u.pn * b_tile; return true; }
    __device__ __forceinline__ unsigned row_off(const Unit&, int) const { return 0u; }
};

constexpr int T2E = 128;
constexpr int LS_OFF = 136 * 1024;
struct MoeOrder {
    const char* A; const char* B; const int* ltk; const float* lf; const volatile LAS int* tpre; int nN, nunits, G, c; size_t b_exp, b_tile, a_row; bool gather;
    __device__ __forceinline__ void stage_lists(const Unit& u, LAS unsigned char* lds, int wid) const {
        const size_t base = (size_t)u.e * LCAP + (size_t)u.pm * 256; LAS unsigned char* slot = lds + LS_OFF + u.slot * 2048; const int lane = threadIdx.x & 63;
        if (wid == 4) __builtin_amdgcn_global_load_lds((const unsigned*)(ltk + base) + lane * 4, (LAS unsigned*)slot, 16, 0, 0);
        else if (wid == 5) __builtin_amdgcn_global_load_lds((const unsigned*)(lf + base) + lane * 4, (LAS unsigned*)(slot + 1024), 16, 0, 0); }
    __device__ __forceinline__ unsigned row_off_lds(const Unit& u, int r, LAS unsigned char* lds) const {
        if (!gather) return (unsigned)(u.tile * 256 + r) * (unsigned)a_row;
        const volatile LAS int* ls = (const volatile LAS int*)(lds + LS_OFF + u.slot * 2048); const int tk = (r < u.cnt) ? ls[r] : 0; return (unsigned)(tk >> 1) * (unsigned)a_row; }
    __device__ __forceinline__ bool next(int i, Unit& u) const {
        const int L0 = i * G + c; if (L0 >= nunits) return false;
        const int L = xcd_remap(L0, nunits);
        const int tile = L / nN; u.pn = L % nN;
        const int e = __builtin_amdgcn_readfirstlane(tpre[T2E + tile]);
        u.e = e; u.pm = tile - __builtin_amdgcn_readfirstlane(tpre[e]); u.cnt = __builtin_amdgcn_readfirstlane(tpre[40 + e]) - u.pm * 256;
        u.B = B + (size_t)e * b_exp + (size_t)u.pn * b_tile; u.tile = tile;
        u.A = A; return true; }
    __device__ __forceinline__ unsigned row_off(const Unit& u, int r) const {
        if (!gather) return (unsigned)(u.tile * 256 + r) * (unsigned)a_row;
        const int idx = u.pm * 256 + r; const int tk = (r < u.cnt) ? ltk[(size_t)u.e * LCAP + idx] : 0; return (unsigned)(tk >> 1) * (unsigned)a_row; }
};

template <class Epi, class Sched, bool GATHER, int KMID>
__device__ __forceinline__ void gemm_simple(unsigned lda_b, unsigned ldb_b, int K, const Sched& S, const Epi& E) {
    const int tid = threadIdx.x, wid = tid >> 6, lane = tid & 63, wr = wid >> 2, wc = wid & 3, fr = lane & 15, fq = lane >> 4;
    for (int i = 0;; ++i) {
        Unit u; if (!S.next(i, u)) break;
        f32x4 acc[2][2][4][2];
#pragma unroll
        for (int a = 0; a < 2; ++a)
#pragma unroll
            for (int b = 0; b < 2; ++b)
#pragma unroll
                for (int m = 0; m < 4; ++m)
#pragma unroll
                    for (int n = 0; n < 2; ++n) acc[a][b][m][n] = (f32x4){0.f, 0.f, 0.f, 0.f};
        unsigned aoff[2][4], boff[2][2];
#pragma unroll
        for (int a = 0; a < 2; ++a)
#pragma unroll
            for (int m = 0; m < 4; ++m) { const int r = 128 * a + 64 * wr + 16 * m + fr; aoff[a][m] = (GATHER ? S.row_off(u, r) : (unsigned)r * lda_b) + fq * 16; }
#pragma unroll
        for (int b = 0; b < 2; ++b)
#pragma unroll
            for (int n = 0; n < 2; ++n) { const int wrow = 128 * b + 32 * wc + perm32(16 * n + fr); boff[b][n] = (unsigned)wrow * ldb_b + fq * 16; }
#define GS_KLOOP(k0, k1) _Pragma("unroll 1") for (int k = (k0); k < (k1); k += 32) { \
            bf16x8 av[2][4], bv[2][2]; \
            _Pragma("unroll") for (int a = 0; a < 2; ++a) _Pragma("unroll") for (int m = 0; m < 4; ++m) av[a][m] = *(const bf16x8*)(u.A + aoff[a][m] + k * 2); \
            _Pragma("unroll") for (int b = 0; b < 2; ++b) _Pragma("unroll") for (int n = 0; n < 2; ++n) bv[b][n] = *(const bf16x8*)(u.B + boff[b][n] + k * 2); \
            _Pragma("unroll") for (int a = 0; a < 2; ++a) _Pragma("unroll") for (int b = 0; b < 2; ++b) _Pragma("unroll") for (int m = 0; m < 4; ++m) _Pragma("unroll") for (int n = 0; n < 2; ++n) \
                acc[a][b][m][n] = __builtin_amdgcn_mfma_f32_16x16x32_bf16(bv[b][n], av[a][m], acc[a][b][m][n], 0, 0, 0); }
        if (KMID > 0) { GS_KLOOP(0, KMID) E.mid(acc, u, wr, wc, fr, fq); GS_KLOOP(KMID, K) } else { GS_KLOOP(0, K) }
#undef GS_KLOOP
        E(acc, u, wr, wc, fr, fq);
    }
}


constexpr int HTB = 128 * 64 * 2;
__device__ __forceinline__ int lds_byte(int r, int c) { const int st = (r >> 4) * 2 + (c >> 5), rr = r & 15, cc = c & 31, ob = rr * 64 + cc * 2; return st * 1024 + (ob ^ (((ob >> 9) & 1) << 5)); }
__device__ __forceinline__ void stage_rc(int b, int& R, int& C) { const int st = b / 1024, sb = b % 1024, swz = sb ^ (((sb >> 9) & 1) << 5); R = (st >> 1) * 16 + swz / 64; C = (st & 1) * 32 + (swz % 64) / 2; }

typedef int v8i32 __attribute__((ext_vector_type(8)));
typedef int v4i32 __attribute__((ext_vector_type(4)));
template <class Epi, class Sched, bool GATHER, int KMID, bool F8 = false>
__device__ __forceinline__ void gemm_phase(LAS unsigned char* lds, unsigned lda_b, unsigned ldb_b, int K  , const Sched& S, const Epi& E) {
    const int tid = threadIdx.x, wid = __builtin_amdgcn_readfirstlane(tid >> 6), lane = tid & 63, wr = wid >> 2, wc = wid & 3, fr = lane & 15, fq = lane >> 4;
    const int nt = K / 64;
    unsigned voffB[2], vA[2][2];
#pragma unroll
    for (int i = 0; i < 2; ++i) { int R, C; stage_rc(tid * 16 + i * 8192, R, C); const int Rb = (R & ~31) + perm32(R & 31);
        voffB[i] = (unsigned)Rb * ldb_b + (unsigned)C * 2u; vA[0][i] = (unsigned)R * lda_b + (unsigned)C * 2u; vA[1][i] = vA[0][i]; }
    const size_t kstep = 128;
    const size_t hstepA = GATHER ? 0 : (size_t)128 * lda_b, hstepB = (size_t)128 * ldb_b;
    const unsigned ldsw = (unsigned)wid * 1024u;
    const int aoff = lds_byte(wr * 64 + fr, fq * 8), boff = lds_byte(wc * 32 + fr, fq * 8);
#define PG8_SA(b, h) (((b) * 2 + (h)) * HTB)
#define PG8_SB(b, h) ((4 + (b) * 2 + (h)) * HTB)
#define PG8_STAGE(bufoff, gbase, voff) do { _Pragma("unroll") for (int _i = 0; _i < 2; ++_i) \
        __builtin_amdgcn_global_load_lds((const unsigned*)((const char*)(gbase) + (voff)[_i]), (LAS unsigned*)(lds + (bufoff) + ldsw + _i * 8192), 16, 0, 0); } while (0)
#define PG8_STAGE_A(bufoff, gbase, h) PG8_STAGE(bufoff, (gbase) + (h) * hstepA, vA[GATHER ? (h) : 0])
#define PG8_LDA(dst, b, h) do { _Pragma("unroll") for (int m = 0; m < 4; ++m) { if constexpr (F8) { const v4i32 _l = *(const LAS v4i32*)(lds + PG8_SA(b, h) + aoff + m * 2048), _h = *(const LAS v4i32*)(lds + PG8_SA(b, h) + aoff + m * 2048 + 1024); \
            dst##8[m] = __builtin_shufflevector(_l, _h, 0, 1, 2, 3, 4, 5, 6, 7); } else { _Pragma("unroll") for (int k = 0; k < 2; ++k) dst[m][k] = *(const LAS bf16x8*)(lds + PG8_SA(b, h) + aoff + m * 2048 + k * 1024); } } } while (0)
#define PG8_LDB(dst, b, h) do { _Pragma("unroll") for (int n = 0; n < 2; ++n) { if constexpr (F8) { const v4i32 _l = *(const LAS v4i32*)(lds + PG8_SB(b, h) + boff + n * 2048), _h = *(const LAS v4i32*)(lds + PG8_SB(b, h) + boff + n * 2048 + 1024); \
            dst##8[n] = __builtin_shufflevector(_l, _h, 0, 1, 2, 3, 4, 5, 6, 7); } else { _Pragma("unroll") for (int k = 0; k < 2; ++k) dst[n][k] = *(const LAS bf16x8*)(lds + PG8_SB(b, h) + boff + n * 2048 + k * 1024); } } } while (0)
#define PG8_MMA(ai, bj, At, Bt) do { __builtin_amdgcn_s_setprio(1); _Pragma("unroll") for (int m = 0; m < 4; ++m) _Pragma("unroll") for (int n = 0; n < 2; ++n) { \
        if constexpr (F8)   \
            asm volatile("v_mfma_scale_f32_16x16x128_f8f6f4 %0, %1, %2, %0, %3, %3 op_sel_hi:[0,0,0]" : "+v"(acc[ai][bj][m][n]) : "v"(Bt##8[n]), "v"(At##8[m]), "v"(f8_unit_scale));   \
        else { _Pragma("unroll") for (int k = 0; k < 2; ++k) acc[ai][bj][m][n] = __builtin_amdgcn_mfma_f32_16x16x32_bf16(Bt[n][k], At[m][k], acc[ai][bj][m][n], 0, 0, 0); } } \
        __builtin_amdgcn_s_setprio(0); } while (0)
#define PG8_WAIT_V(n) asm volatile("s_waitcnt vmcnt(" #n ")" ::: "memory")
#define PG8_WAIT_L(n) asm volatile("s_waitcnt lgkmcnt(" #n ")" ::: "memory")
#define PG8_BAR __builtin_amdgcn_s_barrier()
#define PG8_SCHED __builtin_amdgcn_sched_barrier(0)
    Unit cur, nxt; int ui = 0;
    if (!S.next(0, cur)) return;
    f32x4 acc[2][2][4][2];
#pragma unroll
    for (int a = 0; a < 2; ++a)
#pragma unroll
        for (int b = 0; b < 2; ++b)
#pragma unroll
            for (int m = 0; m < 4; ++m)
#pragma unroll
                for (int n = 0; n < 2; ++n) acc[a][b][m][n] = (f32x4){0.f, 0.f, 0.f, 0.f};
    const int f8_unit_scale = 0x7f7f7f7f;
    bf16x8 At[4][2], B0[2][2], B1[2][2]; v8i32 At8[4], B08[2], B18[2];
    const char* cA = cur.A; const char* cB = cur.B;
    if constexpr (GATHER) {
#pragma unroll
        for (int h = 0; h < 2; ++h)
#pragma unroll
            for (int i = 0; i < 2; ++i) { int R, C; stage_rc(tid * 16 + i * 8192, R, C); vA[h][i] = S.row_off(cur, h * 128 + R) + (unsigned)C * 2u; }
        cur.slot = 0; S.stage_lists(cur, lds, wid);
    }
    PG8_STAGE(PG8_SB(0, 0), cB, voffB); PG8_STAGE(PG8_SB(0, 1), cB + hstepB, voffB); PG8_STAGE_A(PG8_SA(0, 0), cA, 0); PG8_STAGE_A(PG8_SA(0, 1), cA, 1);
    if (wr == 1) PG8_BAR;
    PG8_WAIT_V(2); PG8_BAR;
    PG8_STAGE(PG8_SB(1, 0), cB + kstep, voffB); PG8_STAGE_A(PG8_SA(1, 0), cA + kstep, 0); PG8_STAGE(PG8_SB(1, 1), cB + hstepB + kstep, voffB);
    PG8_WAIT_V(6); PG8_BAR;
    for (;;) {
        const bool has_next = S.next(ui + 1, nxt);
        const char* nA = has_next ? nxt.A : cA; const char* nB = has_next ? nxt.B : cB;
        if constexpr (GATHER) { nxt.slot = (ui + 1) & 1; if (has_next) S.stage_lists(nxt, lds, wid); }
#pragma unroll 1
        for (int t = 0; t < nt; t += 2) {
            const bool last = (t == nt - 2);
            const char* a1 = cA + (size_t)(t + 1) * kstep;
            const char* a2 = last ? nA : cA + (size_t)(t + 2) * kstep; const char* b2 = last ? nB : cB + (size_t)(t + 2) * kstep;
            const char* a3 = a2 + kstep; const char* b3 = b2 + kstep;
            if (KMID > 0 && t == KMID / 64) E.mid(acc, cur, wr, wc, fr, fq);
            asm volatile("" : "+v"(voffB[0]), "+v"(voffB[1]), "+v"(vA[0][0]), "+v"(vA[0][1]), "+v"(vA[1][0]), "+v"(vA[1][1]));
            PG8_LDB(B0, 0, 0); PG8_LDB(B1, 0, 1); PG8_SCHED; PG8_LDA(At, 0, 0); PG8_STAGE_A(PG8_SA(1, 1), a1, 1);
            if constexpr (GATHER) { if (last && has_next) { int tz = tid; asm volatile("" : "+v"(tz));
#pragma unroll
                for (int h = 0; h < 2; ++h)
#pragma unroll
                    for (int i = 0; i < 2; ++i) { int R, C; stage_rc(tz * 16 + i * 8192, R, C); vA[h][i] = S.row_off_lds(nxt, h * 128 + R, lds) + (unsigned)C * 2u; } } }
            PG8_WAIT_V(8); PG8_WAIT_L(0); PG8_BAR; PG8_MMA(0, 0, At, B0); PG8_MMA(0, 1, At, B1); PG8_BAR; PG8_SCHED;
            PG8_LDA(At, 0, 1); PG8_STAGE(PG8_SB(0, 0), b2, voffB); PG8_STAGE(PG8_SB(0, 1), b2 + hstepB, voffB); PG8_STAGE_A(PG8_SA(0, 0), a2, 0);
            PG8_WAIT_V(8); PG8_WAIT_L(0); PG8_BAR; PG8_MMA(1, 0, At, B0); PG8_MMA(1, 1, At, B1); PG8_BAR; PG8_SCHED;
            PG8_LDB(B0, 1, 0); PG8_LDB(B1, 1, 1); PG8_SCHED; PG8_LDA(At, 1, 0); PG8_STAGE_A(PG8_SA(0, 1), a2, 1);
            PG8_WAIT_V(8); PG8_WAIT_L(0); PG8_BAR; PG8_MMA(0, 0, At, B0); PG8_MMA(0, 1, At, B1); PG8_BAR; PG8_SCHED;
            PG8_LDA(At, 1, 1); PG8_STAGE(PG8_SB(1, 0), b3, voffB); PG8_STAGE(PG8_SB(1, 1), b3 + hstepB, voffB); PG8_STAGE_A(PG8_SA(1, 0), a3, 0);
            PG8_WAIT_V(8); PG8_WAIT_L(0); PG8_BAR; PG8_MMA(1, 0, At, B0); PG8_MMA(1, 1, At, B1); PG8_BAR; PG8_SCHED;
        }
        if (wr == 0) PG8_BAR;
        { int tz = threadIdx.x; asm volatile("" : "+v"(tz));
          E(acc, cur, wr, wc, tz & 15, (tz & 63) >> 4); }
        if (!has_next) break;
#pragma unroll
        for (int a = 0; a < 2; ++a)
#pragma unroll
            for (int b = 0; b < 2; ++b)
#pragma unroll
                for (int m = 0; m < 4; ++m)
#pragma unroll
                    for (int n = 0; n < 2; ++n) acc[a][b][m][n] = (f32x4){0.f, 0.f, 0.f, 0.f};
        cur = nxt; cA = nA; cB = nB; ++ui;
        if (wr == 1) PG8_BAR;
    }
    PG8_WAIT_V(0);
    PG8_BAR;
#undef PG8_SA
#undef PG8_SB
#undef PG8_STAGE
#undef PG8_STAGE_A
#undef PG8_LDA
#undef PG8_LDB
#undef PG8_MMA
#undef PG8_WAIT_V
#undef PG8_WAIT_L
#undef PG8_BAR
#undef PG8_SCHED
}

struct EpiStoreBf16 {
    bf16_t* O; int ldc;
    __device__ __forceinline__ void mid(f32x4 (&)[2][2][4][2], const Unit&, int, int, int, int) const {}
    __device__ __forceinline__ void operator()(const f32x4 (&acc)[2][2][4][2], const Unit& u, int wr, int wc, int fr, int fq) const {
        const int row0 = u.pm * 256 + wr * 64 + fr, col0 = u.pn * 256 + wc * 32 + 8 * fq;
        if (u.pn >= C_GA / 256) {
#pragma unroll
            for (int ai = 0; ai < 2; ++ai)
#pragma unroll
                for (int m = 0; m < 4; ++m) { bf16_t* rowp = O + (size_t)(row0 + ai * 128 + m * 16) * ldc + col0; float rt[8], sb[8];
#pragma unroll
                    for (int j = 0; j < 8; ++j) { const float ea = __builtin_amdgcn_exp2f(fminf(-1.4426950408889634f * acc[ai][0][m][j >> 2][j & 3], 80.f)), eb = __builtin_amdgcn_exp2f(fminf(-1.4426950408889634f * acc[ai][1][m][j >> 2][j & 3], 80.f));
                        rt[j] = (1.0f + eb) * __builtin_amdgcn_rcpf(1.0f + ea); sb[j] = __builtin_amdgcn_rcpf(1.0f + eb); }
                    u32x4 w; w.x = cvt_pk_bf16(rt[0], rt[1]); w.y = cvt_pk_bf16(rt[2], rt[3]); w.z = cvt_pk_bf16(rt[4], rt[5]); w.w = cvt_pk_bf16(rt[6], rt[7]);
                    *(u32x4*)(rowp) = w;
                    w.x = cvt_pk_bf16(sb[0], sb[1]); w.y = cvt_pk_bf16(sb[2], sb[3]); w.z = cvt_pk_bf16(sb[4], sb[5]); w.w = cvt_pk_bf16(sb[6], sb[7]);
                    *(u32x4*)(rowp + 128) = w; }
            return; }
#pragma unroll
        for (int ai = 0; ai < 2; ++ai)
#pragma unroll
            for (int m = 0; m < 4; ++m) { bf16_t* rowp = O + (size_t)(row0 + ai * 128 + m * 16) * ldc + col0;
#pragma unroll
                for (int bj = 0; bj < 2; ++bj) { const f32x4 v0 = acc[ai][bj][m][0], v1 = acc[ai][bj][m][1];
                    u32x4 w; w.x = cvt_pk_bf16(v0[0], v0[1]); w.y = cvt_pk_bf16(v0[2], v0[3]); w.z = cvt_pk_bf16(v1[0], v1[1]); w.w = cvt_pk_bf16(v1[2], v1[3]);
                    *(u32x4*)(rowp + bj * 128) = w; } }
    }
};

__device__ __forceinline__ void unpack8(const u32x4 w, float (&f)[8]) {
    f[0] = __uint_as_float(w.x << 16); f[1] = __uint_as_float(w.x & 0xffff0000u); f[2] = __uint_as_float(w.y << 16); f[3] = __uint_as_float(w.y & 0xffff0000u);
    f[4] = __uint_as_float(w.z << 16); f[5] = __uint_as_float(w.z & 0xffff0000u); f[6] = __uint_as_float(w.w << 16); f[7] = __uint_as_float(w.w & 0xffff0000u);
}

struct EpiMerge {
    bf16_t* O; const bf16_t* proj;
    __device__ __forceinline__ void mid(f32x4 (&acc)[2][2][4][2], const Unit& u, int wr, int wc, int fr, int fq) const {
        const int row0 = u.pm * 256 + wr * 64 + fr, gcol = C_GA + u.pn * 512 + wc * 32 + 8 * fq;
        u32x4 ra[4][2];
#define EM_LOAD(gq) do { int rr = row0 + ((gq) >> 2) * 128 + ((gq) & 3) * 16; asm volatile("" : "+v"(rr)); const bf16_t* rowp = proj + (size_t)rr * DIN + gcol; \
            ra[(gq) & 3][0] = *(const u32x4*)(rowp); ra[(gq) & 3][1] = *(const u32x4*)(rowp + 256); } while (0)
        EM_LOAD(0); EM_LOAD(1); EM_LOAD(2);
#pragma unroll
        for (int grp = 0; grp < 8; ++grp) { const int ai = grp >> 2, m = grp & 3, cb = grp & 3;
            if (grp + 3 < 8) EM_LOAD(grp + 3);
            asm volatile("" ::: "memory");
#pragma unroll
            for (int bj = 0; bj < 2; ++bj) { float rt[8]; unpack8(ra[cb][bj], rt);
#pragma unroll
                for (int j = 0; j < 8; ++j) acc[ai][bj][m][j >> 2][j & 3] *= rt[j]; }
            asm volatile("" ::: "memory"); }
#undef EM_LOAD
    }
    __device__ __forceinline__ void operator()(const f32x4 (&acc)[2][2][4][2], const Unit& u, int wr, int wc, int fr, int fq) const {
        const int row0 = u.pm * 256 + wr * 64 + fr, col0 = u.pn * 256 + wc * 32 + 8 * fq, gcol = C_GA + u.pn * 512 + wc * 32 + 8 * fq + 128;
        u32x4 rb[4][2];
#define EM_LOAD(gq) do { int rr = row0 + ((gq) >> 2) * 128 + ((gq) & 3) * 16; asm volatile("" : "+v"(rr)); const bf16_t* rowp = proj + (size_t)rr * DIN + gcol; \
            rb[(gq) & 3][0] = *(const u32x4*)(rowp); rb[(gq) & 3][1] = *(const u32x4*)(rowp + 256); } while (0)
        EM_LOAD(0); EM_LOAD(1); EM_LOAD(2);
#pragma unroll
        for (int grp = 0; grp < 8; ++grp) { const int ai = grp >> 2, m = grp & 3, cb = grp & 3;
            if (grp + 3 < 8) EM_LOAD(grp + 3);
            asm volatile("" ::: "memory");
            const size_t r = (size_t)(row0 + ai * 128 + m * 16);
#pragma unroll
            for (int bj = 0; bj < 2; ++bj) { float sb[8], v[8]; unpack8(rb[cb][bj], sb);
#pragma unroll
                for (int j = 0; j < 8; ++j) v[j] = acc[ai][bj][m][j >> 2][j & 3] * sb[j];
                u32x4 w; w.x = cvt_pk_bf16(v[0], v[1]); w.y = cvt_pk_bf16(v[2], v[3]); w.z = cvt_pk_bf16(v[4], v[5]); w.w = cvt_pk_bf16(v[6], v[7]);
                *(u32x4*)(O + r * D + col0 + bj * 128) = w; }
            asm volatile("" ::: "memory"); }
#undef EM_LOAD
    }
};

struct EpiResid {
    bf16_t* O; const float* x; unsigned char* O8;
    __device__ __forceinline__ void mid(f32x4 (&)[2][2][4][2], const Unit&, int, int, int, int) const {}
    __device__ __forceinline__ void operator()(const f32x4 (&acc)[2][2][4][2], const Unit& u, int wr, int wc, int fr, int fq) const {
        const int row0 = u.pm * 256 + wr * 64 + fr, col0 = u.pn * 256 + wc * 32 + 8 * fq;
        f32x4 xr[4][4];
#define ER_LOAD(gq) do { int rr = row0 + ((gq) >> 2) * 128 + ((gq) & 3) * 16; asm volatile("" : "+v"(rr)); const float* xp = x + (size_t)rr * D + col0; \
            xr[(gq) & 3][0] = *(const f32x4*)(xp); xr[(gq) & 3][1] = *(const f32x4*)(xp + 4); xr[(gq) & 3][2] = *(const f32x4*)(xp + 128); xr[(gq) & 3][3] = *(const f32x4*)(xp + 132); } while (0)
        ER_LOAD(0); ER_LOAD(1); ER_LOAD(2);
#pragma unroll
        for (int grp = 0; grp < 8; ++grp) { const int ai = grp >> 2, m = grp & 3, cb = grp & 3;
            if (grp + 3 < 8) ER_LOAD(grp + 3);
            asm volatile("" ::: "memory");
            const size_t r = (size_t)(row0 + ai * 128 + m * 16);
#pragma unroll
            for (int bj = 0; bj < 2; ++bj) { const f32x4 v0 = acc[ai][bj][m][0] + xr[cb][2 * bj], v1 = acc[ai][bj][m][1] + xr[cb][2 * bj + 1];
                u32x4 w; w.x = cvt_pk_bf16(v0[0], v0[1]); w.y = cvt_pk_bf16(v0[2], v0[3]); w.z = cvt_pk_bf16(v1[0], v1[1]); w.w = cvt_pk_bf16(v1[2], v1[3]);
                *(u32x4*)(O + r * D + col0 + bj * 128) = w;
                *(u32x2*)(O8 + r * D + col0 + bj * 128) = (u32x2){pack4_fp8(v0[0], v0[1], v0[2], v0[3]), pack4_fp8(v1[0], v1[1], v1[2], v1[3])}; }
            asm volatile("" ::: "memory"); }
#undef ER_LOAD
    }
};

struct EpiAct {
    bf16_t* act; const volatile LAS int* tpre;
    __device__ __forceinline__ void mid(f32x4 (&)[2][2][4][2], const Unit&, int, int, int, int) const {}
    __device__ __forceinline__ void operator()(const f32x4 (&acc)[2][2][4][2], const Unit& u, int wr, int wc, int fr, int fq) const {
        const int tile = __builtin_amdgcn_readfirstlane(tpre[u.e]) + u.pm; const int col0 = u.pn * 128 + wc * 32 + 8 * fq;
        int frl = fr; asm volatile("" : "+v"(frl));
        float rs[8];
        const volatile LAS float* lp = (const volatile LAS float*)tpre + ((LS_OFF - 140 * 1024) / 4 + u.slot * 512 + 256); const int last = (u.cnt < 256 ? u.cnt : 256) - 1;
#pragma unroll
        for (int i = 0; i < 8; ++i) { const int rr = (i >> 2) * 128 + wr * 64 + (i & 3) * 16 + frl; rs[i] = lp[rr < last ? rr : last]; }
#pragma unroll
        for (int i = 0; i < 8; ++i) { const int ai = i >> 2, m = i & 3, rr = ai * 128 + wr * 64 + m * 16 + frl;
            const float rstd = rs[i];
            float v[8];
#pragma unroll
            for (int j = 0; j < 8; ++j) { const float g = acc[ai][0][m][j >> 2][j & 3] * rstd, up = acc[ai][1][m][j >> 2][j & 3] * rstd; v[j] = g * up * __builtin_amdgcn_rcpf(1.0f + __builtin_amdgcn_exp2f(-1.4426950408889634f * g)); }
            *(u32x2*)((unsigned char*)act + ((size_t)tile * 256 + rr) * DE + col0) = (u32x2){pack4_fp8(v[0] * ACT_SCALE, v[1] * ACT_SCALE, v[2] * ACT_SCALE, v[3] * ACT_SCALE), pack4_fp8(v[4] * ACT_SCALE, v[5] * ACT_SCALE, v[6] * ACT_SCALE, v[7] * ACT_SCALE)}; }
    }
};

struct EpiDown {
    bf16_t* y; const volatile LAS int* tpre;
    __device__ __forceinline__ void mid(f32x4 (&)[2][2][4][2], const Unit&, int, int, int, int) const {}
    __device__ __forceinline__ void operator()(const f32x4 (&acc)[2][2][4][2], const Unit& u, int wr, int wc, int fr, int fq) const {
        const int col0 = u.pn * 256 + wc * 32 + 8 * fq;
        int frl = fr; asm volatile("" : "+v"(frl));
        int tk[8]; float wt[8];
        const volatile LAS int* ltk = tpre + ((LS_OFF - 140 * 1024) / 4 + u.slot * 512); const volatile LAS float* lw = (const volatile LAS float*)ltk + 256; const int last = (u.cnt < 256 ? u.cnt : 256) - 1;
#pragma unroll
        for (int i = 0; i < 8; ++i) { const int rr = (i >> 2) * 128 + wr * 64 + (i & 3) * 16 + frl; const int rc = rr < last ? rr : last; const int t = ltk[rc]; tk[i] = (rr <= last) ? t : Y_DUMMY_ROW;
            wt[i] = lw[rc] * (Y_SCALE / (ACT_SCALE * WD_SCALE)); }
#pragma unroll
        for (int i = 0; i < 8; ++i) { const int ai = i >> 2, m = i & 3;
#pragma unroll
            for (int bj = 0; bj < 2; ++bj) { const f32x4 v0 = acc[ai][bj][m][0] * wt[i], v1 = acc[ai][bj][m][1] * wt[i];
                *(u32x2*)((unsigned char*)y + (size_t)tk[i] * D + col0 + bj * 128) = (u32x2){pack4_fp8(v0[0], v0[1], v0[2], v0[3]), pack4_fp8(v1[0], v1[1], v1[2], v1[3])}; } }
    }
};

__device__ __forceinline__ void tr_tile8(const float* src, int ld_src, unsigned char* dst, int ld_dst, int k0, int n0, int drow0, const float* scale, float mul, LAS float* tile) {
    const int lane = threadIdx.x & 63, kq = lane >> 4, n4 = (lane & 15) * 4;
    f32x4 v[16];
#pragma unroll
    for (int it = 0; it < 16; ++it) v[it] = *(const f32x4*)(src + (size_t)(k0 + it * 4 + kq) * ld_src + n0 + n4);
#pragma unroll
    for (int it = 0; it < 16; ++it) { const int k = it * 4 + kq; const float s = (scale ? scale[k0 + k] : 1.0f) * mul;
        tile[k * 65 + n4 + 0] = v[it][0] * s; tile[k * 65 + n4 + 1] = v[it][1] * s; tile[k * 65 + n4 + 2] = v[it][2] * s; tile[k * 65 + n4 + 3] = v[it][3] * s; }
    __builtin_amdgcn_wave_barrier();
    const int kg = lane & 7;
#pragma unroll
    for (int it = 0; it < 8; ++it) { const int nn = (lane >> 3) + 8 * it; float f[8];
#pragma unroll
        for (int j = 0; j < 8; ++j) f[j] = tile[(kg * 8 + j) * 65 + nn];
        *(u32x2*)(dst + (size_t)(drow0 + nn) * ld_dst + k0 + kg * 8) = (u32x2){pack4_fp8(f[0], f[1], f[2], f[3]), pack4_fp8(f[4], f[5], f[6], f[7])}; }
    __builtin_amdgcn_wave_barrier();
}
__device__ __forceinline__ void tr_tile(const float* src, int ld_src, bf16_t* dst, int ld_dst, int k0, int n0, int drow0, const float* scale, LAS float* tile) {
    const int lane = threadIdx.x & 63, kq = lane >> 4, n4 = (lane & 15) * 4;
    f32x4 v[16];
#pragma unroll
    for (int it = 0; it < 16; ++it) v[it] = *(const f32x4*)(src + (size_t)(k0 + it * 4 + kq) * ld_src + n0 + n4);
#pragma unroll
    for (int it = 0; it < 16; ++it) { const int k = it * 4 + kq; const float s = scale ? scale[k0 + k] : 1.0f;
        tile[k * 65 + n4 + 0] = v[it][0] * s; tile[k * 65 + n4 + 1] = v[it][1] * s; tile[k * 65 + n4 + 2] = v[it][2] * s; tile[k * 65 + n4 + 3] = v[it][3] * s; }
    __builtin_amdgcn_wave_barrier();
    const int kg = lane & 7;
#pragma unroll
    for (int it = 0; it < 8; ++it) { const int nn = (lane >> 3) + 8 * it; float f[8];
#pragma unroll
        for (int j = 0; j < 8; ++j) f[j] = tile[(kg * 8 + j) * 65 + nn];
        u32x4 w; w.x = cvt_pk_bf16(f[0], f[1]); w.y = cvt_pk_bf16(f[2], f[3]); w.z = cvt_pk_bf16(f[4], f[5]); w.w = cvt_pk_bf16(f[6], f[7]);
        *(u32x4*)(dst + (size_t)(drow0 + nn) * ld_dst + k0 + kg * 8) = w; }
    __builtin_amdgcn_wave_barrier();
}

constexpr int T_IN = 16 * 96, T_UPA = 8 * 16, T_UPB = 16 * 16, T_OUT = 16 * 16, T_G = NE * 16 * 8, T_U = NE * 16 * 8, T_D = NE * 8 * 16;
constexpr int T_EARLY = T_IN + T_UPA + T_UPB + T_OUT, T_TOTAL = T_EARLY + T_G + T_U + T_D;
constexpr int CONV_TPT = 32, N_CONV_TASKS = (T_TOTAL - T_EARLY) / CONV_TPT;
__device__ __forceinline__ void conv_tile(const Params& P, LAS float* tile, int t) {
    unsigned char* ws = P.ws;
    int j = t;
    if (j < T_IN) { const int kt = j / 96, ntl = j % 96; const int n0 = ntl * 64;
        const int c = (n0 - C_GA) & 1023, drow = n0 < C_GA ? n0 : C_GA + 256 * (c >> 7) + (c & 127) + (n0 >= C_GB ? 128 : 0);
        tr_tile(P.w_in, DIN, (bf16_t*)(ws + WS_WIN), D, kt * 64, n0, drow, nullptr, tile); return; }
    j -= T_IN;
    if (j < T_UPA) { const int kt = j / 16, ntl = j % 16; tr_tile(P.w_up_a, D, (bf16_t*)(ws + WS_WUP), KUP, kt * 64, ntl * 64, ntl * 64, nullptr, tile); return; }
    j -= T_UPA;
    if (j < T_UPB) { const int kt = j / 16, ntl = j % 16; tr_tile(P.w_up_b, D, (bf16_t*)(ws + WS_WUP) + 512, KUP, kt * 64, ntl * 64, ntl * 64, nullptr, tile); return; }
    j -= T_UPB;
    if (j < T_OUT) { const int kt = j / 16, ntl = j % 16; tr_tile(P.w_out, D, (bf16_t*)(ws + WS_WOUT), D, kt * 64, ntl * 64, ntl * 64, nullptr, tile); return; }
    j -= T_OUT;
    if (j < T_G + T_U) { const bool up = j >= T_G; if (up) j -= T_G; const int e = j / 128, r = j % 128, kt = r % 16, ntl = r / 16; const int c0 = ntl * 64;
        const int drow = (c0 >> 7) * 256 + (c0 & 127) + (up ? 128 : 0);
        tr_tile8((up ? P.w_up : P.w_gate) + (size_t)e * D * DE, DE, (unsigned char*)(ws + WS_WGU) + (size_t)e * 1024 * D, D, kt * 64, c0, drow, P.norm2_g, WGU_SCALE, tile); return; }
    j -= T_G + T_U;
    { const int e = j / 128, r = j % 128, kt = r % 8, ntl = r / 8;
      tr_tile8(P.w_down + (size_t)e * DE * D, D, (unsigned char*)(ws + WS_WD) + (size_t)e * D * DE, DE, kt * 64, ntl * 64, ntl * 64, nullptr, WD_SCALE, tile); }
}

__device__ void p0_prologue(const Params& P, LAS unsigned char* lds, int bid, int nb) {
    const int tid = threadIdx.x, wid = tid >> 6, lane = tid & 63;
    unsigned char* ws = P.ws;
    LAS float* tile = (LAS float*)lds;
    for (int t = bid * 8 + wid; t < T_EARLY; t += nb * 8) conv_tile(P, tile + wid * (64 * 65), t);
    __syncthreads();
    { LAS float* hm = (LAS float*)lds;
      LAS float* red = (LAS float*)(lds + 65536);
      float* projm = (float*)(ws + WS_PROJM); bf16_t* metat = (bf16_t*)(ws + WS_METAT);
      bool have = false;
      for (int cg = nb - 1 - bid; cg < DIN / 64; cg += nb) {
          if (!have) { __syncthreads();
              for (int r = wid; r < NMETA; r += 8) { const float* mr = P.meta + (size_t)r * D; float ss = 0.f;
                  for (int k = lane; k < D; k += 64) { const float v = mr[k]; ss += v * v; }
                  ss = wave_sum(ss); const float rstd = rsqrtf(ss * (1.0f / D) + EPS);
                  for (int k = lane; k < D; k += 64) hm[r * D + k] = mr[k] * rstd * P.norm1_g[k]; }
              have = true; __syncthreads(); }
          const int c = tid & 63, ks = tid >> 6; float a[16];
#pragma unroll
          for (int r = 0; r < 16; ++r) a[r] = 0.f;
#pragma unroll 1
          for (int k0 = ks * 128; k0 < ks * 128 + 128; k0 += 8) { float w[8];
#pragma unroll
              for (int q = 0; q < 8; ++q) w[q] = P.w_in[(size_t)(k0 + q) * DIN + cg * 64 + c];
#pragma unroll
              for (int q = 0; q < 8; ++q)
#pragma unroll
                  for (int r = 0; r < 16; ++r) a[r] += hm[r * D + k0 + q] * w[q]; }
#pragma unroll
          for (int r = 0; r < 16; ++r) red[(ks * 16 + r) * 64 + c] = a[r];
          __syncthreads();
          for (int o = tid; o < 16 * 64; o += NTHREADS) { const int r = o >> 6, cc = o & 63; float s = 0.f;
#pragma unroll
              for (int q = 0; q < 8; ++q) s += red[(q * 16 + r) * 64 + cc];
              projm[(size_t)r * DIN + cg * 64 + cc] = s; metat[(size_t)(48 + r) * DIN + cg * 64 + cc] = f2bf(s); }
          for (int o = tid; o < 48 * 64; o += NTHREADS) { const int r = o >> 6, col = cg * 64 + (o & 63); metat[(size_t)r * DIN + col] = (col >= C_F && col < C_F + DHG) ? (bf16_t)0x42A0 : (bf16_t)0; }
          __syncthreads(); } }
    { bf16_t* hn = (bf16_t*)(ws + WS_HN);
      f32x4 gq[4];
#pragma unroll
      for (int q = 0; q < 4; ++q) gq[q] = *(const f32x4*)(P.norm1_g + 256 * q + 4 * lane);
      volatile LAS int* shq = (volatile LAS int*)(lds + 141 * 1024 + 64); int* rq = (int*)(ws + WS_CTL + CTL_CNT + 128 + 8);
      for (;;) { __syncthreads(); if (tid == 0) shq[0] = atomicAdd(rq, 1); __syncthreads(); const int grp = __builtin_amdgcn_readfirstlane(shq[0]); if (grp >= NTOK / 32) break;
          const int r0 = grp * 32 + wid * 4;
          f32x4 v[4][4];
#pragma unroll
          for (int rr = 0; rr < 4; ++rr)
#pragma unroll
              for (int q = 0; q < 4; ++q) v[rr][q] = *(const f32x4*)(P.x + (size_t)(r0 + rr) * D + 256 * q + 4 * lane);
#pragma unroll
          for (int rr = 0; rr < 4; ++rr) { float ss = 0.f;
#pragma unroll
              for (int q = 0; q < 4; ++q) ss += v[rr][q][0] * v[rr][q][0] + v[rr][q][1] * v[rr][q][1] + v[rr][q][2] * v[rr][q][2] + v[rr][q][3] * v[rr][q][3];
              ss = wave_sum(ss); const float rstd = rsqrtf(ss * (1.0f / D) + EPS);
#pragma unroll
              for (int q = 0; q < 4; ++q) { const f32x4 o = v[rr][q] * rstd * gq[q];
                  *(u32x2*)(hn + (size_t)(r0 + rr) * D + 256 * q + 4 * lane) = (u32x2){cvt_pk_bf16(o[0], o[1]), cvt_pk_bf16(o[2], o[3])}; } } } }
    { float* lb = (float*)(ws + WS_LB);
      for (int d = bid * NTHREADS + tid; d < DHG; d += nb * NTHREADS) lb[d] = sigmoidf_(P.hg_lb[d] - P.hg_lb[DHG + d]);
      bf16_t* wrt = (bf16_t*)(ws + WS_WR);
      for (int o = bid * NTHREADS + tid; o < 48 * D; o += nb * NTHREADS) { const int j = o / D, k = o % D; float v = 0.f;
          { const int nt = j >> 4, g = (j >> 2) & 3, jj = j & 3;
            if (nt < 2) v = P.w_router[((size_t)g * D + k) * 8 + nt * 4 + jj] * P.norm2_g[k];
            else if (jj == 0) v = P.w_group[(size_t)k * 4 + g] * P.norm2_g[k]; }
          wrt[o] = f2bf(v); }
    }
}

__device__ __forceinline__ float ldproj(const Params& P, int b, int s, int col) {
    if (s < NMETA) return ((const float*)(P.ws + WS_PROJM))[(size_t)s * DIN + col];
    return bf2f(((const bf16_t*)(P.ws + WS_PROJ))[((size_t)b * SEQ + (s - NMETA)) * DIN + col]);
}

__device__ void hgrn_simple(const Params& P, LAS unsigned char* lds, int unit) {
    constexpr int TC = 32;
    const int tid = threadIdx.x, wid = tid >> 6, lane = tid & 63, b = unit >> 2, h = unit & 3, v = tid & 127, dg = tid >> 7;
    LAS float* fb = (LAS float*)lds; LAS float* kb = fb + TC * 128; LAS float* qb = kb + TC * 128; LAS float* vb = qb + TC * 128; LAS float* op = vb + TC * 128;
    const float* lbp = (const float*)(P.ws + WS_LB);
    bf16_t* oab = (bf16_t*)P.out;
    float S[32];
#pragma unroll
    for (int j = 0; j < 32; ++j) S[j] = 0.f;
    for (int c0 = 0; c0 < TSEQ; c0 += TC) {
        const int len = (TSEQ - c0) < TC ? (TSEQ - c0) : TC;
        __syncthreads();
        for (int idx = tid; idx < len * 128; idx += NTHREADS) { const int t = idx >> 7, d = idx & 127, s = c0 + t;
            const float q = ldproj(P, b, s, C_Q + h * 128 + d), fp = ldproj(P, b, s, C_F + h * 128 + d), iv = ldproj(P, b, s, C_I + h * 128 + d);
            const float lb = lbp[h * 128 + d];
            fb[idx] = lb + (1.0f - lb) * sigmoidf_(fp); kb[idx] = (1.0f - lb) * sigmoidf_(-fp); qb[idx] = q; vb[idx] = iv; }
        __syncthreads();
        for (int t = 0; t < len; ++t) { const float vv = vb[t * 128 + v]; float o = 0.f;
#pragma unroll
            for (int j4 = 0; j4 < 8; ++j4) { const f32x4 f4 = *(const LAS f32x4*)(fb + t * 128 + dg * 32 + j4 * 4), k4 = *(const LAS f32x4*)(kb + t * 128 + dg * 32 + j4 * 4), q4 = *(const LAS f32x4*)(qb + t * 128 + dg * 32 + j4 * 4);
#pragma unroll
                for (int j = 0; j < 4; ++j) { S[j4 * 4 + j] = f4[j] * S[j4 * 4 + j] + k4[j] * vv; o += S[j4 * 4 + j] * q4[j]; } }
            op[(t * 4 + dg) * 128 + v] = o; }
        __syncthreads();
        for (int t = wid; t < len; t += 8) { const int s = c0 + t; if (s < NMETA) continue;
            const float o0 = op[(t * 4 + 0) * 128 + lane] + op[(t * 4 + 1) * 128 + lane] + op[(t * 4 + 2) * 128 + lane] + op[(t * 4 + 3) * 128 + lane];
            const float o1 = op[(t * 4 + 0) * 128 + lane + 64] + op[(t * 4 + 1) * 128 + lane + 64] + op[(t * 4 + 2) * 128 + lane + 64] + op[(t * 4 + 3) * 128 + lane + 64];
            const float ss = wave_sum(o0 * o0 + o1 * o1); const float rstd = rsqrtf(ss * (1.0f / 128.0f) + EPS);
            const size_t row = (size_t)b * SEQ + (s - NMETA);
            const float g0 = P.hg_norm_g[h * 128 + lane], g1 = P.hg_norm_g[h * 128 + lane + 64];
            const float og0 = ldproj(P, b, s, C_OG + h * 128 + lane), og1 = ldproj(P, b, s, C_OG + h * 128 + lane + 64);
            oab[row * KUP + h * 128 + lane] = f2bf(o0 * rstd * g0 * sigmoidf_(og0));
            oab[row * KUP + h * 128 + lane + 64] = f2bf(o1 * rstd * g1 * sigmoidf_(og1)); }
    }
}

__device__ void lru_simple(const Params& P, LAS unsigned char* lds, int unit) {
    constexpr int TC = 64;
    const int tid = threadIdx.x, b = unit >> 3, n = unit & 7, c = tid & 127, tq = tid >> 7, ch = n * 128 + c;
    LAS float* xin = (LAS float*)lds;
    LAS float* xc = xin + (TC + 3) * 128;
    LAS float* ab = xc + TC * 128;
    LAS float* ub = ab + TC * 128;
    bf16_t* oab = (bf16_t*)P.out;
    const float cw0 = P.conv_w[0 * D + ch], cw1 = P.conv_w[1 * D + ch], cw2 = P.conv_w[2 * D + ch], cw3 = P.conv_w[3 * D + ch], cb = P.conv_b[ch];
    const float br = P.b_r[ch], bi = P.b_i[ch];
    const float lamv = P.lam[ch]; const float sp = (lamv > 15.f) ? __expf(-lamv) : log1pf(__expf(-lamv));
    const float* wr = P.w_r + (size_t)n * 128 * 128; const float* wi = P.w_i + (size_t)n * 128 * 128;
    float hcar = 0.f;
    for (int c0 = 0; c0 < TSEQ; c0 += TC) {
        const int len = (TSEQ - c0) < TC ? (TSEQ - c0) : TC;
        __syncthreads();
        for (int idx = tid; idx < (len + 3) * 128; idx += NTHREADS) { const int t = idx >> 7, cc = idx & 127, s = c0 + t - 3;
            xin[idx] = (s >= 0) ? ldproj(P, b, s, C_LX + n * 128 + cc) : 0.f; }
        __syncthreads();
        for (int t = tq; t < len; t += 4) xc[t * 128 + c] = cw0 * xin[t * 128 + c] + cw1 * xin[(t + 1) * 128 + c] + cw2 * xin[(t + 2) * 128 + c] + cw3 * xin[(t + 3) * 128 + c] + cb;
        __syncthreads();
        { float ra[16], ia[16];
#pragma unroll
          for (int j = 0; j < 16; ++j) { ra[j] = 0.f; ia[j] = 0.f; }
          for (int i4 = 0; i4 < 128; i4 += 4) { float w_r4[4], w_i4[4];
#pragma unroll
              for (int q = 0; q < 4; ++q) { w_r4[q] = wr[(size_t)(i4 + q) * 128 + c]; w_i4[q] = wi[(size_t)(i4 + q) * 128 + c]; }
#pragma unroll
              for (int j = 0; j < 16; ++j) { const f32x4 xv = *(const LAS f32x4*)(xc + (tq * 16 + j) * 128 + i4);
#pragma unroll
                  for (int q = 0; q < 4; ++q) { ra[j] += xv[q] * w_r4[q]; ia[j] += xv[q] * w_i4[q]; } } }
#pragma unroll
          for (int j = 0; j < 16; ++j) { const int t = tq * 16 + j; const float r = sigmoidf_(ra[j] + br), ig = sigmoidf_(ia[j] + bi);
              const float log_a = -8.0f * r * sp; const float a = __expf(log_a); const float u = sqrtf(-expm1f(2.0f * log_a)) * (ig * xc[t * 128 + c]);
              ab[t * 128 + c] = a; ub[t * 128 + c] = u; } }
        __syncthreads();
        if (tid < 128) { float hh = hcar; for (int t = 0; t < len; ++t) { hh = ab[t * 128 + c] * hh + ub[t * 128 + c]; ub[t * 128 + c] = hh; } hcar = hh; }
        __syncthreads();
        for (int idx = tid; idx < len * 128; idx += NTHREADS) { const int t = idx >> 7, cc = idx & 127, s = c0 + t; if (s < NMETA) continue;
            const float y = ldproj(P, b, s, C_LY + n * 128 + cc);
            oab[((size_t)b * SEQ + (s - NMETA)) * KUP + 512 + n * 128 + cc] = f2bf(ub[idx] * gelu_tanh(y)); }
    }
}


#define BAR_LDS() do { asm volatile("s_waitcnt lgkmcnt(0)" ::: "memory"); __builtin_amdgcn_s_barrier(); asm volatile("" ::: "memory"); } while (0)

constexpr int LT = 272;
__device__ __forceinline__ const bf16_t* seq_row(const Params& P, int b, int c, int t) {
    return c == 0 ? (const bf16_t*)(P.ws + WS_METAT) + (size_t)t * DIN : (const bf16_t*)(P.ws + WS_PROJ) + ((size_t)b * SEQ + (size_t)(c - 1) * 64 + t) * DIN;
}
__device__ __forceinline__ float bflo(unsigned w) { return __uint_as_float(w << 16); }
__device__ __forceinline__ float bfhi(unsigned w) { return __uint_as_float(w & 0xffff0000u); }

__device__ void lru_fast(const Params& P, LAS unsigned char* lds, int unit) {
    const int tid = threadIdx.x, wid = __builtin_amdgcn_readfirstlane(tid >> 6), lane = tid & 63, b = unit >> 3, n = unit & 7, fr = lane & 15, g = lane >> 4;
    constexpr int TP = 136;
    constexpr int XA_B = 64 * LT, CT_B = 128 * TP, SET_B = XA_B + 3 * CT_B;
    static_assert(2 * SET_B <= 140 * 1024, "LRU tiles exceed the LDS budget");
    bf16_t* oab = (bf16_t*)P.out;
    bf16x8 Br[4], Bi[4];
    { const float* wr = P.w_r + (size_t)n * 128 * 128 + wid * 16 + fr; const float* wi = P.w_i + (size_t)n * 128 * 128 + wid * 16 + fr;
#pragma unroll
      for (int ks = 0; ks < 4; ++ks) { unsigned pr[4], pi[4];
#pragma unroll
          for (int j = 0; j < 4; ++j) { const int i0 = 32 * ks + 8 * g + 2 * j;
              pr[j] = cvt_pk_bf16(wr[(size_t)i0 * 128], wr[(size_t)(i0 + 1) * 128]); pi[j] = cvt_pk_bf16(wi[(size_t)i0 * 128], wi[(size_t)(i0 + 1) * 128]); }
          u32x4 tr = {pr[0], pr[1], pr[2], pr[3]}, ti = {pi[0], pi[1], pi[2], pi[3]};
          Br[ks] = __builtin_bit_cast(bf16x8, tr); Bi[ks] = __builtin_bit_cast(bf16x8, ti); } }
    const int chg = n * 128 + wid * 16 + fr;
    const float LOG2E = 1.4426950408889634f;
    const float nbr = -P.b_r[chg] * LOG2E, nbi = -P.b_i[chg] * LOG2E;
    const float lamv = P.lam[chg]; const float c2 = -8.0f * LOG2E * ((lamv > 15.f) ? __expf(-lamv) : log1pf(__expf(-lamv)));
    const int chc = n * 128 + 2 * lane;
    const f32x2 cw0 = *(const f32x2*)(P.conv_w + 0 * D + chc), cw1 = *(const f32x2*)(P.conv_w + 1 * D + chc), cw2 = *(const f32x2*)(P.conv_w + 2 * D + chc), cw3 = *(const f32x2*)(P.conv_w + 3 * D + chc),
                cbv = *(const f32x2*)(P.conv_b + chc);
    float carry = 0.f;
    unsigned xl[11], yl[8];
    unsigned lxo = (unsigned)(C_LX + n * 128 + 2 * lane) * 2u, lyo = (unsigned)(C_LY + n * 128 + 2 * lane) * 2u;
#define LRU_PREFETCH(c) do { const char* r0 = (const char*)seq_row(P, b, (c), wid * 8);        \
        _Pragma("unroll") for (int q = 0; q < 8; ++q) { xl[3 + q] = *(const unsigned*)(r0 + (lxo + (unsigned)q * (DIN * 2u))); yl[q] = *(const unsigned*)(r0 + (lyo + (unsigned)q * (DIN * 2u))); } \
        if (wid > 0) { const char* rm = r0 - 3 * (DIN * 2); _Pragma("unroll") for (int q = 0; q < 3; ++q) xl[q] = *(const unsigned*)(rm + (lxo + (unsigned)q * (DIN * 2u))); } \
        else if ((c) > 0) { const char* rh = (const char*)seq_row(P, b, (c) - 1, 61); _Pragma("unroll") for (int q = 0; q < 3; ++q) xl[q] = *(const unsigned*)(rh + (lxo + (unsigned)q * (DIN * 2u))); } \
        else { xl[0] = 0u; xl[1] = 0u; xl[2] = 0u; } } while (0)
    BAR_LDS();
    LRU_PREFETCH(0);
    { LAS unsigned char* XAw = lds; LAS unsigned char* XTw = XAw + XA_B; LAS unsigned char* YTw = XTw + CT_B;
        { f32x2 xv[11];
#pragma unroll
          for (int q = 0; q < 11; ++q) xv[q] = (f32x2){bflo(xl[q]), bfhi(xl[q])};
          unsigned xp[8];
#pragma unroll
          for (int q = 0; q < 8; ++q) { const f32x2 v = cw0 * xv[q] + cw1 * xv[q + 1] + cw2 * xv[q + 2] + cw3 * xv[q + 3] + cbv; xp[q] = cvt_pk_bf16(v[0], v[1]);
              *(LAS unsigned*)(XAw + (wid * 8 + q) * LT + lane * 4) = xp[q]; }
          u32x4 x0, x1, y0, y1;
          x0.x = __builtin_amdgcn_perm(xp[1], xp[0], 0x05040100u); x0.y = __builtin_amdgcn_perm(xp[3], xp[2], 0x05040100u); x0.z = __builtin_amdgcn_perm(xp[5], xp[4], 0x05040100u); x0.w = __builtin_amdgcn_perm(xp[7], xp[6], 0x05040100u);
          x1.x = __builtin_amdgcn_perm(xp[1], xp[0], 0x07060302u); x1.y = __builtin_amdgcn_perm(xp[3], xp[2], 0x07060302u); x1.z = __builtin_amdgcn_perm(xp[5], xp[4], 0x07060302u); x1.w = __builtin_amdgcn_perm(xp[7], xp[6], 0x07060302u);
          y0.x = __builtin_amdgcn_perm(yl[1], yl[0], 0x05040100u); y0.y = __builtin_amdgcn_perm(yl[3], yl[2], 0x05040100u); y0.z = __builtin_amdgcn_perm(yl[5], yl[4], 0x05040100u); y0.w = __builtin_amdgcn_perm(yl[7], yl[6], 0x05040100u);
          y1.x = __builtin_amdgcn_perm(yl[1], yl[0], 0x07060302u); y1.y = __builtin_amdgcn_perm(yl[3], yl[2], 0x07060302u); y1.z = __builtin_amdgcn_perm(yl[5], yl[4], 0x07060302u); y1.w = __builtin_amdgcn_perm(yl[7], yl[6], 0x07060302u);
          *(LAS u32x2*)(XTw + (2 * lane) * TP + wid * 16) = (u32x2){x0.x, x0.y}; *(LAS u32x2*)(XTw + (2 * lane) * TP + wid * 16 + 8) = (u32x2){x0.z, x0.w};
          *(LAS u32x2*)(XTw + (2 * lane + 1) * TP + wid * 16) = (u32x2){x1.x, x1.y}; *(LAS u32x2*)(XTw + (2 * lane + 1) * TP + wid * 16 + 8) = (u32x2){x1.z, x1.w};
          *(LAS u32x2*)(YTw + (2 * lane) * TP + wid * 16) = (u32x2){y0.x, y0.y}; *(LAS u32x2*)(YTw + (2 * lane) * TP + wid * 16 + 8) = (u32x2){y0.z, y0.w};
          *(LAS u32x2*)(YTw + (2 * lane + 1) * TP + wid * 16) = (u32x2){y1.x, y1.y}; *(LAS u32x2*)(YTw + (2 * lane + 1) * TP + wid * 16 + 8) = (u32x2){y1.z, y1.w}; }
    }
    LRU_PREFETCH(1);
    BAR_LDS();
    for (int c = 0; c < 33; ++c) {
        asm volatile("" : "+v"(lxo), "+v"(lyo));
        LAS unsigned char* XAr = lds + (c & 1) * SET_B; LAS unsigned char* XTr = XAr + XA_B; LAS unsigned char* YTr = XTr + CT_B; LAS unsigned char* OTr = YTr + CT_B;
        if (c + 1 < 33) { LAS unsigned char* XAw = lds + ((c + 1) & 1) * SET_B; LAS unsigned char* XTw = XAw + XA_B; LAS unsigned char* YTw = XTw + CT_B;
        { f32x2 xv[11];
#pragma unroll
          for (int q = 0; q < 11; ++q) xv[q] = (f32x2){bflo(xl[q]), bfhi(xl[q])};
          unsigned xp[8];
#pragma unroll
          for (int q = 0; q < 8; ++q) { const f32x2 v = cw0 * xv[q] + cw1 * xv[q + 1] + cw2 * xv[q + 2] + cw3 * xv[q + 3] + cbv; xp[q] = cvt_pk_bf16(v[0], v[1]);
              *(LAS unsigned*)(XAw + (wid * 8 + q) * LT + lane * 4) = xp[q]; }
          u32x4 x0, x1, y0, y1;
          x0.x = __builtin_amdgcn_perm(xp[1], xp[0], 0x05040100u); x0.y = __builtin_amdgcn_perm(xp[3], xp[2], 0x05040100u); x0.z = __builtin_amdgcn_perm(xp[5], xp[4], 0x05040100u); x0.w = __builtin_amdgcn_perm(xp[7], xp[6], 0x05040100u);
          x1.x = __builtin_amdgcn_perm(xp[1], xp[0], 0x07060302u); x1.y = __builtin_amdgcn_perm(xp[3], xp[2], 0x07060302u); x1.z = __builtin_amdgcn_perm(xp[5], xp[4], 0x07060302u); x1.w = __builtin_amdgcn_perm(xp[7], xp[6], 0x07060302u);
          y0.x = __builtin_amdgcn_perm(yl[1], yl[0], 0x05040100u); y0.y = __builtin_amdgcn_perm(yl[3], yl[2], 0x05040100u); y0.z = __builtin_amdgcn_perm(yl[5], yl[4], 0x05040100u); y0.w = __builtin_amdgcn_perm(yl[7], yl[6], 0x05040100u);
          y1.x = __builtin_amdgcn_perm(yl[1], yl[0], 0x07060302u); y1.y = __builtin_amdgcn_perm(yl[3], yl[2], 0x07060302u); y1.z = __builtin_amdgcn_perm(yl[5], yl[4], 0x07060302u); y1.w = __builtin_amdgcn_perm(yl[7], yl[6], 0x07060302u);
          *(LAS u32x2*)(XTw + (2 * lane) * TP + wid * 16) = (u32x2){x0.x, x0.y}; *(LAS u32x2*)(XTw + (2 * lane) * TP + wid * 16 + 8) = (u32x2){x0.z, x0.w};
          *(LAS u32x2*)(XTw + (2 * lane + 1) * TP + wid * 16) = (u32x2){x1.x, x1.y}; *(LAS u32x2*)(XTw + (2 * lane + 1) * TP + wid * 16 + 8) = (u32x2){x1.z, x1.w};
          *(LAS u32x2*)(YTw + (2 * lane) * TP + wid * 16) = (u32x2){y0.x, y0.y}; *(LAS u32x2*)(YTw + (2 * lane) * TP + wid * 16 + 8) = (u32x2){y0.z, y0.w};
          *(LAS u32x2*)(YTw + (2 * lane + 1) * TP + wid * 16) = (u32x2){y1.x, y1.y}; *(LAS u32x2*)(YTw + (2 * lane + 1) * TP + wid * 16 + 8) = (u32x2){y1.z, y1.w}; }
            if (c + 2 < 33) LRU_PREFETCH(c + 2); }
        {
            f32x4 ar[4], ai[4];
#pragma unroll
            for (int m = 0; m < 4; ++m) { ar[m] = (f32x4){0.f, 0.f, 0.f, 0.f}; ai[m] = (f32x4){0.f, 0.f, 0.f, 0.f}; }
#pragma unroll
            for (int ks = 0; ks < 4; ++ks)
#pragma unroll
                for (int m = 0; m < 4; ++m) { const bf16x8 af = *(const LAS bf16x8*)(XAr + (16 * (fr >> 2) + 4 * m + (fr & 3)) * LT + ks * 64 + g * 16);
                    ar[m] = __builtin_amdgcn_mfma_f32_16x16x32_bf16(af, Br[ks], ar[m], 0, 0, 0); ai[m] = __builtin_amdgcn_mfma_f32_16x16x32_bf16(af, Bi[ks], ai[m], 0, 0, 0); }
            f32x2 a2[4][2], u2[4][2], yg2[4][2];
#pragma unroll
            for (int m = 0; m < 4; ++m) {
                const u32x2 xw = *(const LAS u32x2*)(XTr + (wid * 16 + fr) * TP + (16 * g + 4 * m) * 2), yw = *(const LAS u32x2*)(YTr + (wid * 16 + fr) * TP + (16 * g + 4 * m) * 2);
#pragma unroll
                for (int p = 0; p < 2; ++p) {
                    const unsigned xwp = p ? xw.y : xw.x, ywp = p ? yw.y : yw.x;
                    const f32x2 xc = {bflo(xwp), bfhi(xwp)}, y = {bflo(ywp), bfhi(ywp)};
                    const f32x2 tr = (f32x2){ar[m][2 * p], ar[m][2 * p + 1]} * (-LOG2E) + nbr, ti = (f32x2){ai[m][2 * p], ai[m][2 * p + 1]} * (-LOG2E) + nbi;
                    f32x2 z = y * y; z = z * 0.044715f + 1.0f; z = z * y; z = z * (-2.0f * 0.7978845608028654f * LOG2E);
                    f32x2 er, ei, eg;
                    er[0] = __builtin_amdgcn_exp2f(fminf(tr[0], 40.f)); er[1] = __builtin_amdgcn_exp2f(fminf(tr[1], 40.f));
                    ei[0] = __builtin_amdgcn_exp2f(fminf(ti[0], 40.f)); ei[1] = __builtin_amdgcn_exp2f(fminf(ti[1], 40.f));
                    eg[0] = __builtin_amdgcn_exp2f(fminf(z[0], 40.f)); eg[1] = __builtin_amdgcn_exp2f(fminf(z[1], 40.f));
                    const f32x2 dr = er + 1.0f, di = ei + 1.0f, dg = eg + 1.0f;
                    const f32x2 pd = dr * di, pr = pd * dg;
                    f32x2 inv; inv[0] = __builtin_amdgcn_rcpf(pr[0]); inv[1] = __builtin_amdgcn_rcpf(pr[1]);
                    const f32x2 t1 = inv * dg, r = t1 * di, ig = t1 * dr, sg = inv * pd;
                    const f32x2 ea = r * c2;
                    f32x2 av; av[0] = __builtin_amdgcn_exp2f(ea[0]); av[1] = __builtin_amdgcn_exp2f(ea[1]);
                    const f32x2 om = 1.0f - av * av;
                    f32x2 sq; sq[0] = __builtin_amdgcn_sqrtf(fmaxf(om[0], 0.f)); sq[1] = __builtin_amdgcn_sqrtf(fmaxf(om[1], 0.f));
                    a2[m][p] = av; u2[m][p] = sq * (ig * xc); yg2[m][p] = y * sg; } }
            if (c == 0 && g < 3) {
#pragma unroll
                for (int m = 0; m < 4; ++m)
#pragma unroll
                    for (int p = 0; p < 2; ++p) { a2[m][p] = (f32x2){1.0f, 1.0f}; u2[m][p] = (f32x2){0.f, 0.f}; } }
            float A16 = 1.0f, U16 = 0.f;
#pragma unroll
            for (int m = 0; m < 4; ++m)
#pragma unroll
                for (int p = 0; p < 2; ++p) { U16 = a2[m][p][0] * U16 + u2[m][p][0]; A16 *= a2[m][p][0]; U16 = a2[m][p][1] * U16 + u2[m][p][1]; A16 *= a2[m][p][1]; }
            float H = carry, Hm = carry;
#pragma unroll
            for (int gg = 0; gg < 4; ++gg) { const float Ag = __shfl(A16, fr + 16 * gg), Ug = __shfl(U16, fr + 16 * gg); if (gg == g) Hm = H; H = Ag * H + Ug; }
            carry = H;
            float h = Hm;
#pragma unroll
            for (int m = 0; m < 4; ++m) {
                const float h0 = a2[m][0][0] * h + u2[m][0][0], h1 = a2[m][0][1] * h0 + u2[m][0][1], h2 = a2[m][1][0] * h1 + u2[m][1][0], h3 = a2[m][1][1] * h2 + u2[m][1][1]; h = h3;
                *(LAS u32x2*)(OTr + (wid * 16 + fr) * TP + (16 * g + 4 * m) * 2) = (u32x2){cvt_pk_bf16(h0 * yg2[m][0][0], h1 * yg2[m][0][1]), cvt_pk_bf16(h2 * yg2[m][1][0], h3 * yg2[m][1][1])}; }
        }
        BAR_LDS();
        if (c > 0) {
            const u32x2 o0a = *(const LAS u32x2*)(OTr + (2 * lane) * TP + wid * 16), o0b = *(const LAS u32x2*)(OTr + (2 * lane) * TP + wid * 16 + 8);
            const u32x2 o1a = *(const LAS u32x2*)(OTr + (2 * lane + 1) * TP + wid * 16), o1b = *(const LAS u32x2*)(OTr + (2 * lane + 1) * TP + wid * 16 + 8);
            const u32x4 o0 = {o0a.x, o0a.y, o0b.x, o0b.y}, o1 = {o1a.x, o1a.y, o1b.x, o1b.y};
            bf16_t* op = oab + ((size_t)b * SEQ + (size_t)(c - 1) * 64 + wid * 8) * KUP + 512 + n * 128 + 2 * lane;
            *(unsigned*)(op + 0 * KUP) = __builtin_amdgcn_perm(o1.x, o0.x, 0x05040100u); *(unsigned*)(op + 1 * KUP) = __builtin_amdgcn_perm(o1.x, o0.x, 0x07060302u);
            *(unsigned*)(op + 2 * KUP) = __builtin_amdgcn_perm(o1.y, o0.y, 0x05040100u); *(unsigned*)(op + 3 * KUP) = __builtin_amdgcn_perm(o1.y, o0.y, 0x07060302u);
            *(unsigned*)(op + 4 * KUP) = __builtin_amdgcn_perm(o1.z, o0.z, 0x05040100u); *(unsigned*)(op + 5 * KUP) = __builtin_amdgcn_perm(o1.z, o0.z, 0x07060302u);
            *(unsigned*)(op + 6 * KUP) = __builtin_amdgcn_perm(o1.w, o0.w, 0x05040100u); *(unsigned*)(op + 7 * KUP) = __builtin_amdgcn_perm(o1.w, o0.w, 0x07060302u); }
    }
#undef LRU_PREFETCH
}

constexpr int KEP = 144;
__device__ void hgrn_fast(const Params& P, LAS unsigned char* lds, int unit) {
    const int tid = threadIdx.x, wid = __builtin_amdgcn_readfirstlane(tid >> 6), lane = tid & 63, b = unit >> 2, h = unit & 3, fr = lane & 15, g = lane >> 4;
    LAS unsigned char* QG = lds;
    LAS unsigned char* KG = QG + 64 * LT;
    LAS unsigned char* VT = KG + 64 * LT;
    LAS unsigned char* KE = VT + 64 * LT;
    LAS unsigned char* PT = KE + 128 * KEP;
    LAS float* DEC = (LAS float*)(PT + 64 * KEP);
    LAS float* SEG = DEC + 128;
    LAS float* PART = SEG + 8 * 128;
    LAS unsigned char* OGT = (LAS unsigned char*)(PART + 64 * 8);
    LAS unsigned char* OUT = OGT + 64 * LT;
    bf16_t* oab = (bf16_t*)P.out;
    const float LOG2E = 1.4426950408889634f;
    const float* lbp = (const float*)(P.ws + WS_LB) + h * 128 + 2 * lane;
    const float lb0 = lbp[0], lb1 = lbp[1], om0 = 1.0f - lb0, om1 = 1.0f - lb1;
    int pos; { const int d = 2 * lane, kd = d >> 5, r = d & 31; pos = 32 * kd + 8 * ((r >> 2) & 3) + 4 * (r >> 4) + (r & 3); }
    const f32x4 ng = *(const f32x4*)(P.hg_norm_g + h * 128 + wid * 16 + 4 * g);
    f32x4 S[8];
#pragma unroll
    for (int db = 0; db < 8; ++db) S[db] = (f32x4){0.f, 0.f, 0.f, 0.f};
    unsigned qv[8], fv[8]; u32x4 vv[2], gv[2];
    unsigned hqo = (unsigned)(C_Q + h * 128 + 2 * lane) * 2u, hfo = (unsigned)(C_F + h * 128 + 2 * lane) * 2u;
    unsigned hvo = (unsigned)(C_I + h * 128 + (lane & 15) * 8) * 2u, hoo = (unsigned)(C_OG + h * 128 + (lane & 15) * 8) * 2u;
#define HG_PREFETCH(c) do { const char* r0 = (const char*)seq_row(P, b, (c), wid * 8); \
        _Pragma("unroll") for (int q = 0; q < 8; ++q) { qv[q] = *(const unsigned*)(r0 + (hqo + (unsigned)q * (DIN * 2u))); fv[q] = *(const unsigned*)(r0 + (hfo + (unsigned)q * (DIN * 2u))); } \
        const char* rv = (const char*)seq_row(P, b, (c), wid * 4); \
        _Pragma("unroll") for (int i = 0; i < 2; ++i) { vv[i] = *(const u32x4*)(rv + (hvo + (unsigned)(32 * i + (lane >> 4)) * (DIN * 2u))); gv[i] = *(const u32x4*)(rv + (hoo + (unsigned)(32 * i + (lane >> 4)) * (DIN * 2u))); } } while (0)
    BAR_LDS();
    HG_PREFETCH(0);
    for (int c = 0; c < 33; ++c) {
        asm volatile("" : "+v"(hqo), "+v"(hfo), "+v"(hvo), "+v"(hoo));
        float k0[8], k1[8], c0[8], c1[8];
        { float p0 = 1.0f, p1 = 1.0f;
#pragma unroll
          for (int q = 0; q < 8; ++q) { const float x0 = bflo(fv[q]), x1 = bfhi(fv[q]);
              const float e0 = __builtin_amdgcn_exp2f(fminf(-LOG2E * x0, 80.f)), e1 = __builtin_amdgcn_exp2f(fminf(-LOG2E * x1, 80.f));
              const float r0 = __builtin_amdgcn_rcpf(1.0f + e0), r1 = __builtin_amdgcn_rcpf(1.0f + e1);
              const float f0 = lb0 + om0 * r0, f1 = lb1 + om1 * r1;
              k0[q] = om0 * e0 * r0; k1[q] = om1 * e1 * r1;
              p0 *= f0; p1 *= f1; c0[q] = p0; c1[q] = p1; }
          *(LAS f32x2*)(SEG + wid * 128 + 2 * lane) = (f32x2){p0, p1}; }
        BAR_LDS();
        { float pre0 = 1.0f, pre1 = 1.0f, tot0 = 1.0f, tot1 = 1.0f;
#pragma unroll
          for (int w2 = 0; w2 < 8; ++w2) { const f32x2 sv = *(const LAS f32x2*)(SEG + w2 * 128 + 2 * lane); if (w2 < wid) { pre0 *= sv[0]; pre1 *= sv[1]; } tot0 *= sv[0]; tot1 *= sv[1]; }
          unsigned ke0[4], ke1[4]; float keb0 = 0.f, keb1 = 0.f;
#pragma unroll
          for (int q = 0; q < 8; ++q) { const float G0 = pre0 * c0[q], G1 = pre1 * c1[q];
              const float rg0 = __builtin_amdgcn_rcpf(G0), rg1 = __builtin_amdgcn_rcpf(G1);
              const float kg0 = k0[q] * rg0, kg1 = k1[q] * rg1;
              const int t = wid * 8 + q;
              *(LAS unsigned*)(QG + t * LT + pos * 2) = cvt_pk_bf16(bflo(qv[q]) * G0, bfhi(qv[q]) * G1);
              *(LAS unsigned*)(KG + t * LT + pos * 2) = cvt_pk_bf16(kg0, kg1);
              const float e0 = kg0 * tot0, e1 = kg1 * tot1;
              if (q & 1) { ke0[q >> 1] = cvt_pk_bf16(keb0, e0); ke1[q >> 1] = cvt_pk_bf16(keb1, e1); } else { keb0 = e0; keb1 = e1; } }
          *(LAS u32x4*)(KE + (2 * lane) * KEP + wid * 16) = (u32x4){ke0[0], ke0[1], ke0[2], ke0[3]};
          *(LAS u32x4*)(KE + (2 * lane + 1) * KEP + wid * 16) = (u32x4){ke1[0], ke1[1], ke1[2], ke1[3]};
          if (wid == 0) *(LAS f32x2*)(DEC + 2 * lane) = (f32x2){tot0, tot1};
#pragma unroll
          for (int i = 0; i < 2; ++i) { const int p = tid + NTHREADS * i; *(LAS u32x4*)(VT + (p >> 4) * LT + (p & 15) * 16) = vv[i]; *(LAS u32x4*)(OGT + (p >> 4) * LT + (p & 15) * 16) = gv[i];
              if (c >= 2) { const u32x4 ov4 = *(const LAS u32x4*)(OUT + (p >> 4) * LT + (p & 15) * 16);
                  *(u32x4*)(oab + ((size_t)b * SEQ + (size_t)(c - 2) * 64 + (p >> 4)) * KUP + h * 128 + (p & 15) * 8) = ov4; } } }
        BAR_LDS();
        if (c + 1 < 33) HG_PREFETCH(c + 1);
        if (c > 0) {
            const int tb = wid >> 1;
#pragma unroll
            for (int s2 = 0; s2 < 2; ++s2) { const int sb = 2 * (wid & 1) + s2; f32x4 pt = {0.f, 0.f, 0.f, 0.f};
#pragma unroll
                for (int kd = 0; kd < 4; ++kd) { const bf16x8 kf = *(const LAS bf16x8*)(KG + (16 * sb + fr) * LT + kd * 64 + g * 16), qf = *(const LAS bf16x8*)(QG + (16 * tb + fr) * LT + kd * 64 + g * 16);
                    pt = __builtin_amdgcn_mfma_f32_16x16x32_bf16(kf, qf, pt, 0, 0, 0); }
                const int tg = 16 * tb + fr, sg0 = 16 * sb + 4 * g;
                const float m0 = (sg0 + 0 <= tg) ? pt[0] : 0.f, m1 = (sg0 + 1 <= tg) ? pt[1] : 0.f, m2 = (sg0 + 2 <= tg) ? pt[2] : 0.f, m3 = (sg0 + 3 <= tg) ? pt[3] : 0.f;
                *(LAS u32x2*)(PT + tg * KEP + sg0 * 2) = (u32x2){cvt_pk_bf16(m0, m1), cvt_pk_bf16(m2, m3)}; } }
        BAR_LDS();
        bf16x8 Vf[2];
#pragma unroll
        for (int ks = 0; ks < 2; ++ks) { unsigned w4[4];
#pragma unroll
            for (int j = 0; j < 4; ++j) { const int s0 = 32 * ks + 8 * g + 2 * j;
                const unsigned lo = *(const LAS bf16_t*)(VT + s0 * LT + (wid * 16 + fr) * 2), hi = *(const LAS bf16_t*)(VT + (s0 + 1) * LT + (wid * 16 + fr) * 2);
                w4[j] = lo | (hi << 16); }
            u32x4 tv = {w4[0], w4[1], w4[2], w4[3]}; Vf[ks] = __builtin_bit_cast(bf16x8, tv); }
        f32x4 ov[4];
        if (c > 0) {
            bf16x8 Sf[4];
#pragma unroll
            for (int kd = 0; kd < 4; ++kd) { u32x4 tv = {cvt_pk_bf16(S[2 * kd][0], S[2 * kd][1]), cvt_pk_bf16(S[2 * kd][2], S[2 * kd][3]), cvt_pk_bf16(S[2 * kd + 1][0], S[2 * kd + 1][1]), cvt_pk_bf16(S[2 * kd + 1][2], S[2 * kd + 1][3])};
                Sf[kd] = __builtin_bit_cast(bf16x8, tv); }
#pragma unroll
            for (int m = 0; m < 4; ++m) { f32x4 o = {0.f, 0.f, 0.f, 0.f};
#pragma unroll
                for (int ks = 0; ks < 2; ++ks) { const bf16x8 pf = *(const LAS bf16x8*)(PT + (16 * m + fr) * KEP + ks * 64 + g * 16); o = __builtin_amdgcn_mfma_f32_16x16x32_bf16(Vf[ks], pf, o, 0, 0, 0); }
#pragma unroll
                for (int kd = 0; kd < 4; ++kd) { const bf16x8 qf = *(const LAS bf16x8*)(QG + (16 * m + fr) * LT + kd * 64 + g * 16); o = __builtin_amdgcn_mfma_f32_16x16x32_bf16(Sf[kd], qf, o, 0, 0, 0); }
                ov[m] = o; } }
#pragma unroll
        for (int db = 0; db < 8; ++db) { const f32x4 dc = *(const LAS f32x4*)(DEC + 16 * db + 4 * g); f32x4 sa = S[db] * dc;
#pragma unroll
            for (int ks = 0; ks < 2; ++ks) { const bf16x8 kf = *(const LAS bf16x8*)(KE + (16 * db + fr) * KEP + ks * 64 + g * 16); sa = __builtin_amdgcn_mfma_f32_16x16x32_bf16(kf, Vf[ks], sa, 0, 0, 0); }
            S[db] = sa; }
        if (c > 0) {
#pragma unroll
            for (int m = 0; m < 4; ++m) { float pq = ov[m][0] * ov[m][0] + ov[m][1] * ov[m][1] + ov[m][2] * ov[m][2] + ov[m][3] * ov[m][3];
                pq += __shfl_xor(pq, 16); pq += __shfl_xor(pq, 32);
                if (g == 0) PART[(16 * m + fr) * 8 + wid] = pq; } }
        BAR_LDS();
        if (c > 0) {
#pragma unroll
            for (int m = 0; m < 4; ++m) { const f32x4 pa = *(const LAS f32x4*)(PART + (16 * m + fr) * 8), pb = *(const LAS f32x4*)(PART + (16 * m + fr) * 8 + 4);
                const float ss = ((pa[0] + pa[1]) + (pa[2] + pa[3])) + ((pb[0] + pb[1]) + (pb[2] + pb[3]));
                const float rstd = rsqrtf(ss * (1.0f / 128.0f) + EPS);
                const u32x2 ogw = *(const LAS u32x2*)(OGT + (16 * m + fr) * LT + (wid * 16 + 4 * g) * 2);
                const float g0 = bflo(ogw.x), g1 = bfhi(ogw.x), g2 = bflo(ogw.y), g3 = bfhi(ogw.y);
                const float o0 = ov[m][0] * rstd * ng[0] * __builtin_amdgcn_rcpf(1.0f + __builtin_amdgcn_exp2f(-LOG2E * g0));
                const float o1 = ov[m][1] * rstd * ng[1] * __builtin_amdgcn_rcpf(1.0f + __builtin_amdgcn_exp2f(-LOG2E * g1));
                const float o2 = ov[m][2] * rstd * ng[2] * __builtin_amdgcn_rcpf(1.0f + __builtin_amdgcn_exp2f(-LOG2E * g2));
                const float o3 = ov[m][3] * rstd * ng[3] * __builtin_amdgcn_rcpf(1.0f + __builtin_amdgcn_exp2f(-LOG2E * g3));
                *(LAS u32x2*)(OUT + (16 * m + fr) * LT + (wid * 16 + 4 * g) * 2) = (u32x2){cvt_pk_bf16(o0, o1), cvt_pk_bf16(o2, o3)}; } }
    }
    BAR_LDS();
#pragma unroll
    for (int i = 0; i < 2; ++i) { const int p = tid + NTHREADS * i; const u32x4 ov4 = *(const LAS u32x4*)(OUT + (p >> 4) * LT + (p & 15) * 16);
        *(u32x4*)(oab + ((size_t)b * SEQ + (size_t)31 * 64 + (p >> 4)) * KUP + h * 128 + (p & 15) * 8) = ov4; }
#undef HG_PREFETCH
}

__device__ void p5_router_fast(const Params& P, LAS unsigned char* lds, int bid, int nb) {
    const int tid = threadIdx.x, wid = __builtin_amdgcn_readfirstlane(tid >> 6), lane = tid & 63, fr = lane & 15, g = lane >> 4;
    unsigned char* ws = P.ws;
    const bf16_t* h2 = (const bf16_t*)(ws + WS_H2); const bf16_t* wrt = (const bf16_t*)(ws + WS_WR);
    int* counts = (int*)(ws + WS_CTL + CTL_CNT); int* ltk = (int*)(ws + WS_LTK); float* lw = (float*)(ws + WS_LW);
    LAS int* lcnt = (LAS int*)lds; LAS int* lbase = lcnt + 32; LAS int* ae = lbase + 32; LAS int* al = ae + 512; LAS float* aw = (LAS float*)(al + 512); LAS float* ars = aw + 512;
    float* lrs = (float*)(ws + WS_LRS);
    const float bg = P.b_group[g];
    float br8[8];
#pragma unroll
    for (int e = 0; e < 8; ++e) br8[e] = P.b_router[g * 8 + e];
    __syncthreads();
    for (int p = tid; p < 48 * 128; p += NTHREADS) { const int row = p >> 7, c16 = p & 127;
        *(LAS u32x4*)(lds + 12288 + row * 2064 + c16 * 16) = *(const u32x4*)(wrt + (size_t)row * D + c16 * 8); }
    for (int t0 = bid * 256; t0 < NTOK; t0 += nb * 256) {
        __syncthreads();
        if (tid < 32) lcnt[tid] = 0;
        __syncthreads();
        f32x4 acc[2][3];
#pragma unroll
        for (int tt = 0; tt < 2; ++tt)
#pragma unroll
            for (int nt = 0; nt < 3; ++nt) acc[tt][nt] = (f32x4){0.f, 0.f, 0.f, 0.f};
        const bf16_t* ap = h2 + (size_t)(t0 + wid * 32 + fr) * D + g * 8;
        LAS unsigned char* WL = lds + 12288;
        const LAS unsigned char* bl = WL + fr * 2064 + g * 16;
        float sq0 = 0.f, sq1 = 0.f;
#pragma unroll 1
        for (int k8 = 0; k8 < 32; k8 += 8) {
            bf16x8 a0[8], a1[8];
#pragma unroll
            for (int q = 0; q < 8; ++q) { a0[q] = *(const bf16x8*)(ap + (k8 + q) * 32); a1[q] = *(const bf16x8*)(ap + 16 * D + (k8 + q) * 32); }
#pragma unroll
            for (int q = 0; q < 8; ++q) { const int ks = k8 + q;
                const bf16x8 b0 = *(const LAS bf16x8*)(bl + ks * 64), b1 = *(const LAS bf16x8*)(bl + 16 * 2064 + ks * 64), b2 = *(const LAS bf16x8*)(bl + 32 * 2064 + ks * 64);
                acc[0][0] = __builtin_amdgcn_mfma_f32_16x16x32_bf16(b0, a0[q], acc[0][0], 0, 0, 0); acc[0][1] = __builtin_amdgcn_mfma_f32_16x16x32_bf16(b1, a0[q], acc[0][1], 0, 0, 0);
                acc[0][2] = __builtin_amdgcn_mfma_f32_16x16x32_bf16(b2, a0[q], acc[0][2], 0, 0, 0); acc[1][0] = __builtin_amdgcn_mfma_f32_16x16x32_bf16(b0, a1[q], acc[1][0], 0, 0, 0);
                acc[1][1] = __builtin_amdgcn_mfma_f32_16x16x32_bf16(b1, a1[q], acc[1][1], 0, 0, 0); acc[1][2] = __builtin_amdgcn_mfma_f32_16x16x32_bf16(b2, a1[q], acc[1][2], 0, 0, 0);
                { const u32x4 w0 = __builtin_bit_cast(u32x4, a0[q]), w1 = __builtin_bit_cast(u32x4, a1[q]);
#define SQ_ACC(sq, w) asm volatile("v_dot2c_f32_bf16 %0, %1, %1" : "+v"(sq) : "v"(w))
                  SQ_ACC(sq0, w0.x); SQ_ACC(sq0, w0.y); SQ_ACC(sq0, w0.z); SQ_ACC(sq0, w0.w); SQ_ACC(sq1, w1.x); SQ_ACC(sq1, w1.y); SQ_ACC(sq1, w1.z); SQ_ACC(sq1, w1.w);
#undef SQ_ACC
                } }
        }
        sq0 += __shfl_xor(sq0, 16); sq0 += __shfl_xor(sq0, 32); sq1 += __shfl_xor(sq1, 16); sq1 += __shfl_xor(sq1, 32);
#pragma unroll
        for (int tt = 0; tt < 2; ++tt) {
            const int tl = wid * 32 + tt * 16 + fr;
            const float rstd = rsqrtf((tt ? sq1 : sq0) * (1.0f / D) + EPS);
            const float mygl = acc[tt][2][0] * rstd + bg;
            float gl[4];
#pragma unroll
            for (int gg = 0; gg < 4; ++gg) gl[gg] = __shfl(mygl, fr + 16 * gg);
            int gs = 0; float gm = gl[0];
#pragma unroll
            for (int j = 1; j < 4; ++j) if (gl[j] > gm) { gm = gl[j]; gs = j; }
            float den = 0.f;
#pragma unroll
            for (int j = 0; j < 4; ++j) den += __expf(gl[j] - gm);
            const float psel = 1.0f / den;
            if (g == gs) {
                float el[8];
#pragma unroll
                for (int e = 0; e < 8; ++e) el[e] = acc[tt][e >> 2][e & 3] * rstd + br8[e];
                int i0 = 0; float v0 = el[0];
#pragma unroll
                for (int e = 1; e < 8; ++e) if (el[e] > v0) { v0 = el[e]; i0 = e; }
                int i1 = -1; float v1 = -3.0e38f;
#pragma unroll
                for (int e = 0; e < 8; ++e) if (e != i0 && el[e] > v1) { v1 = el[e]; i1 = e; }
                const float e1 = __expf(v1 - v0); const float w0 = psel / (1.0f + e1), w1 = psel * e1 / (1.0f + e1);
                const int ex0 = gs * 8 + i0, ex1 = gs * 8 + i1;
                ae[tl * 2] = ex0; al[tl * 2] = __hip_atomic_fetch_add(lcnt + ex0, 1, __ATOMIC_RELAXED, __HIP_MEMORY_SCOPE_WORKGROUP); aw[tl * 2] = w0; ars[tl * 2] = rstd * (1.0f / WGU_SCALE);
                ae[tl * 2 + 1] = ex1; al[tl * 2 + 1] = __hip_atomic_fetch_add(lcnt + ex1, 1, __ATOMIC_RELAXED, __HIP_MEMORY_SCOPE_WORKGROUP); aw[tl * 2 + 1] = w1; ars[tl * 2 + 1] = rstd * (1.0f / WGU_SCALE);
            }
        }
        __syncthreads();
        if (tid < 32) lbase[tid] = atomicAdd(counts + tid, lcnt[tid]);
        __syncthreads();
        { const int a = tid; const int e = ae[a]; const int pos = lbase[e] + al[a];
          ltk[(size_t)e * LCAP + pos] = (t0 + (a >> 1)) * 2 + (a & 1); lw[(size_t)e * LCAP + pos] = aw[a]; lrs[(size_t)e * LCAP + pos] = ars[a]; }
    }
}

__device__ void p8_final(const Params& P, int bid, int nb) {
    const int tid = threadIdx.x, wid = tid >> 6, lane = tid & 63;
    const bf16_t* h2 = (const bf16_t*)(P.ws + WS_H2); const unsigned char* yb = (const unsigned char*)(P.ws + WS_Y);
    f32x4 gq[4];
#pragma unroll
    for (int q = 0; q < 4; ++q) gq[q] = *(const f32x4*)(P.final_g + 256 * q + 4 * lane);
    for (int r0 = (bid * 8 + wid) * 4; r0 < NTOK; r0 += nb * 8 * 4) {
        u32x2 hv[4][4]; unsigned y0[4][4], y1[4][4];
#pragma unroll
        for (int rr = 0; rr < 4; ++rr) { const size_t r = (size_t)(r0 + rr);
#pragma unroll
            for (int q = 0; q < 4; ++q) { hv[rr][q] = *(const u32x2*)(h2 + r * D + 256 * q + 4 * lane);
                y0[rr][q] = *(const unsigned*)(yb + (r * 2) * D + 256 * q + 4 * lane); y1[rr][q] = *(const unsigned*)(yb + (r * 2 + 1) * D + 256 * q + 4 * lane); } }
#pragma unroll
        for (int rr = 0; rr < 4; ++rr) { f32x4 v[4]; float ss = 0.f;
#pragma unroll
            for (int q = 0; q < 4; ++q) {
                const f32x2 a01 = __builtin_amdgcn_cvt_pk_f32_fp8((int)y0[rr][q], false), a23 = __builtin_amdgcn_cvt_pk_f32_fp8((int)y0[rr][q], true), b01 = __builtin_amdgcn_cvt_pk_f32_fp8((int)y1[rr][q], false), b23 = __builtin_amdgcn_cvt_pk_f32_fp8((int)y1[rr][q], true);
                v[q][0] = bflo(hv[rr][q].x) + (a01[0] + b01[0]) * (1.0f / Y_SCALE); v[q][1] = bfhi(hv[rr][q].x) + (a01[1] + b01[1]) * (1.0f / Y_SCALE);
                v[q][2] = bflo(hv[rr][q].y) + (a23[0] + b23[0]) * (1.0f / Y_SCALE); v[q][3] = bfhi(hv[rr][q].y) + (a23[1] + b23[1]) * (1.0f / Y_SCALE);
                ss += v[q][0] * v[q][0] + v[q][1] * v[q][1] + v[q][2] * v[q][2] + v[q][3] * v[q][3]; }
            ss = wave_sum(ss); const float rstd = rsqrtf(ss * (1.0f / D) + EPS);
#pragma unroll
            for (int q = 0; q < 4; ++q) *(f32x4*)(P.out + (size_t)(r0 + rr) * D + 256 * q + 4 * lane) = v[q] * rstd * gq[q]; }
    }
}

__device__ __forceinline__ void moe_table(const Params& P, volatile LAS int* tpre) {
    if (threadIdx.x < 64) { const int lane = threadIdx.x; const int* counts = (const int*)(P.ws + WS_CTL + CTL_CNT);
        const int cnt = (lane < NE) ? counts[lane] : 0; const int nt = (cnt + 255) >> 8;
        int inc = nt;
#pragma unroll
        for (int o = 1; o < 32; o <<= 1) { const int v = __shfl_up(inc, o); if (lane >= o) inc += v; }
        if (lane < NE) { tpre[lane] = inc - nt; tpre[40 + lane] = cnt;
#pragma unroll 1
            for (int t = inc - nt; t < inc; ++t) tpre[T2E + t] = lane; }
        if (lane == NE - 1) tpre[NE] = inc; }
    __syncthreads();
}
}

__global__ void __launch_bounds__(NTHREADS, 2) fwd_kernel(Params P) {
    extern __shared__ __attribute__((aligned(16))) unsigned char lds_raw[];
    LAS unsigned char* lds = (LAS unsigned char*)lds_raw;
    const int bid = blockIdx.x, nb = gridDim.x;
    unsigned char* ws = P.ws;
    const int lo = P.ph_lo, hi = P.ph_hi;
    volatile LAS unsigned* xbw = (volatile LAS unsigned*)(lds + LDS_BYTES - 16);
    if (threadIdx.x == 0) { xbw[0] = 0u; xbw[1] = 0u; xbw[2] = 0u; xbw[3] = 0u; }
    __syncthreads();
    XcdBarrier bar; bar.bar = (unsigned*)(ws + WS_CTL + CTL_BAR); bar.x = 0; bar.st = xbw;
    if (hi - lo > 1) bar = xcd_barrier_post((unsigned*)(ws + WS_CTL + CTL_BAR), xbw);
#ifdef PROBE_MASK
    unsigned long long pr_t0 = __builtin_amdgcn_s_memrealtime();
#define SEAM(k) do { if ((PROBE_MASK >> (k)) & 1) { const unsigned long long t1 = __builtin_amdgcn_s_memrealtime(); const unsigned long long dt = t1 - pr_t0; \
        while (__builtin_amdgcn_s_memrealtime() - t1 < dt) __builtin_amdgcn_s_sleep(8); } \
        if (IN(k) && IN((k) + 1)) xcd_barrier(bar); pr_t0 = __builtin_amdgcn_s_memrealtime(); } while (0)
#else
#define SEAM(k) do { if (IN(k) && IN((k) + 1)) xcd_barrier(bar); } while (0)
#endif
#ifdef ONLY_PHASE
#define IN(k) ((k) == ONLY_PHASE && lo <= (k) && (k) < hi)
#else
#define IN(k) (lo <= (k) && (k) < hi)
#endif
    if (IN(0)) p0_prologue(P, lds, bid, nb);
    SEAM(0);
    if (IN(1)) { typedef DenseOrder<DIN / 256> DO1; DO1 S; S.init(ws + WS_HN, D * 2, ws + WS_WIN, D * 2, NTOK, DIN, nb, bid);
        EpiStoreBf16 E{(bf16_t*)(ws + WS_PROJ), DIN};
        if constexpr ((FAST_MASK >> 1) & 1) gemm_phase<EpiStoreBf16, DO1, false, 0>(lds, D * 2, D * 2, D, S, E); else gemm_simple<EpiStoreBf16, DO1, false, 0>(D * 2, D * 2, D, S, E); }
    SEAM(1);
    if (IN(2)) {
        if constexpr (((FAST_MASK >> 9) & 3) == 3) {
            volatile LAS int* shu = (volatile LAS int*)(lds + 141 * 1024);
            int* qhead = (int*)(ws + WS_CTL + CTL_CNT + 128);
            for (int u = bid;;) {
                if (u >= 128 + 256) break;
#if defined(P2_REPEAT_H)
                if (u < 128) { hgrn_fast(P, lds, u); hgrn_fast(P, lds, u); } else lru_fast(P, lds, u - 128);
#elif defined(P2_REPEAT_L)
                if (u < 128) hgrn_fast(P, lds, u); else { lru_fast(P, lds, u - 128); lru_fast(P, lds, u - 128); }
#else
                if (u < 128) hgrn_fast(P, lds, u); else lru_fast(P, lds, u - 128);
#endif
                __syncthreads();
                if (threadIdx.x == 0) shu[0] = nb + atomicAdd(qhead, 1);
                __syncthreads();
                u = __builtin_amdgcn_readfirstlane(shu[0]); }
            for (;;) {
                __syncthreads();
                if (threadIdx.x == 0) shu[0] = atomicAdd(qhead + 1, 1);
                __syncthreads();
                const int task = __builtin_amdgcn_readfirstlane(shu[0]);
                if (task >= N_CONV_TASKS) break;
                const int wv = __builtin_amdgcn_readfirstlane(threadIdx.x >> 6);
#pragma unroll 1
                for (int q = wv * (CONV_TPT / 8); q < (wv + 1) * (CONV_TPT / 8); ++q) conv_tile(P, (LAS float*)lds + wv * (64 * 65), T_EARLY + task * CONV_TPT + q); }
        } else {
            for (int u = bid; u < 128 + 256; u += nb) {
                if (u < 128) { if constexpr ((FAST_MASK >> 10) & 1) hgrn_fast(P, lds, u); else hgrn_simple(P, lds, u); }
                else { if constexpr ((FAST_MASK >> 9) & 1) lru_fast(P, lds, u - 128); else lru_simple(P, lds, u - 128); } } } }
    SEAM(2);
    if (IN(3)) { typedef DenseOrder<D / 256> DO4; DO4 S; S.init(P.out, KUP * 2, ws + WS_WUP, KUP * 2, NTOK, D, nb, bid);
        EpiMerge E{(bf16_t*)(ws + WS_HN), (const bf16_t*)(ws + WS_PROJ)};
        if constexpr ((FAST_MASK >> 3) & 1) gemm_phase<EpiMerge, DO4, false, 512>(lds, KUP * 2, KUP * 2, KUP, S, E); else gemm_simple<EpiMerge, DO4, false, 512>(KUP * 2, KUP * 2, KUP, S, E); }
    SEAM(3);
    if (IN(4)) { typedef DenseOrder<D / 256> DO4; DO4 S; S.init(ws + WS_HN, D * 2, ws + WS_WOUT, D * 2, NTOK, D, nb, bid);
        EpiResid E{(bf16_t*)(ws + WS_H2), P.x, ws + WS_H2Q};
        if constexpr ((FAST_MASK >> 4) & 1) gemm_phase<EpiResid, DO4, false, 0>(lds, D * 2, D * 2, D, S, E); else gemm_simple<EpiResid, DO4, false, 0>(D * 2, D * 2, D, S, E); }
    SEAM(4);
    if (IN(5)) p5_router_fast(P, lds, bid, nb);
    SEAM(5);
    if (IN(6)) { volatile LAS int* tpre = (volatile LAS int*)(lds + 140 * 1024); __syncthreads(); moe_table(P, tpre);
        MoeOrder S; S.A = (const char*)(ws + WS_H2Q); S.B = (const char*)(ws + WS_WGU); S.ltk = (const int*)(ws + WS_LTK); S.lf = (const float*)(ws + WS_LRS); S.tpre = tpre; S.nN = 4; S.nunits = __builtin_amdgcn_readfirstlane(tpre[NE]) * 4; S.G = nb; S.c = bid;
        S.b_exp = (size_t)1024 * D; S.b_tile = (size_t)256 * D; S.a_row = D; S.gather = true;
        EpiAct E{(bf16_t*)(ws + WS_ACT), tpre};
        gemm_phase<EpiAct, MoeOrder, true, 0, true>(lds, D, D, D / 2, S, E); }
    SEAM(6);
    if (IN(7)) { volatile LAS int* tpre = (volatile LAS int*)(lds + 140 * 1024); __syncthreads(); moe_table(P, tpre);
        MoeOrder S; S.A = (const char*)(ws + WS_ACT); S.B = (const char*)(ws + WS_WD); S.ltk = (const int*)(ws + WS_LTK); S.lf = (const float*)(ws + WS_LW); S.tpre = tpre; S.nN = 4; S.nunits = __builtin_amdgcn_readfirstlane(tpre[NE]) * 4; S.G = nb; S.c = bid;
        S.b_exp = (size_t)D * DE; S.b_tile = (size_t)256 * DE; S.a_row = DE; S.gather = false;
        EpiDown E{(bf16_t*)(ws + WS_Y), tpre};
        gemm_phase<EpiDown, MoeOrder, true, 0, true>(lds, DE, DE, DE / 2, S, E); }
    SEAM(7);
    if (IN(8)) p8_final(P, bid, nb);
#ifdef PROBE_MASK
    SEAM(8);
#endif
#undef IN
#undef SEAM
}

extern "C" void kernel_launch(void* const* d_in, const int* in_sizes, int n_in, void* d_out, int out_size, void* d_ws, size_t ws_size, hipStream_t stream) {
    static int grid = 0;
    if (grid == 0) {
        if (n_in != 25 || in_sizes[0] != NTOK * D || out_size != NTOK * D || ws_size < WS_END) {
            fprintf(stderr, "kernel_launch: unexpected shapes (n_in %d, in0 %d, out %d, ws %zu < %zu); nothing launched\n", n_in, n_in > 0 ? in_sizes[0] : -1, out_size, ws_size, (size_t)WS_END); grid = -1; return; }
        int dev = 0, cus = 0;
        if (hipGetDevice(&dev) != hipSuccess || hipDeviceGetAttribute(&cus, hipDeviceAttributeMultiprocessorCount, dev) != hipSuccess) { grid = -1; return; }
        if (hipFuncSetAttribute((const void*)fwd_kernel, hipFuncAttributeMaxDynamicSharedMemorySize, LDS_BYTES) != hipSuccess) { fprintf(stderr, "kernel_launch: hipFuncSetAttribute failed\n"); grid = -1; return; }
        grid = cus;
    }
    if (grid < 0) return;
    (void)hipMemsetAsync((char*)d_ws + WS_CTL, 0, CTL_ZERO_BYTES, stream);
    Params p{};
    const float** f = (const float**)&p;
    for (int i = 0; i < 25; ++i) f[i] = (const float*)d_in[i];
    p.out = (float*)d_out; p.ws = (unsigned char*)d_ws;
#if NLAUNCH == 1
    p.ph_lo = 0; p.ph_hi = 9;
    hipLaunchKernelGGL(fwd_kernel, dim3(grid), dim3(NTHREADS), LDS_BYTES, stream, p);
#else
    for (int ph = 0; ph < 9; ++ph) { p.ph_lo = ph; p.ph_hi = ph + 1;
        hipLaunchKernelGGL(fwd_kernel, dim3(grid), dim3(NTHREADS), LDS_BYTES, stream, p); }
#endif
}
```

```cpp
#include <hip/hip_runtime.h>
#include <cstdio>
#include <cstdint>

#ifndef FAST_MASK
#define FAST_MASK 0x7ff
#endif
#ifndef NLAUNCH
#define NLAUNCH 1
#endif

#define LAS __attribute__((address_space(3)))
typedef unsigned short bf16_t;
typedef short bf16x8 __attribute__((ext_vector_type(8)));
typedef float f32x4 __attribute__((ext_vector_type(4)));
typedef float f32x2 __attribute__((ext_vector_type(2)));
typedef unsigned u32x4 __attribute__((ext_vector_type(4)));
typedef unsigned u32x2 __attribute__((ext_vector_type(2)));
typedef __bf16 bf2_t __attribute__((ext_vector_type(2)));

#define XB_TMO      128
#define XB_XCNT(j)  (256  + 64 * (j))
#define XB_XSUB(j)  (1280 + 64 * (j))
#define XB_XGEN(j)  (2304 + 64 * (j))
#define XB_TOP      3328
#define XB_TOPGEN   3392
#define XCD_BAR_WORDS 3456
#define XB_SPIN_CAP (1u << 18)

__device__ __forceinline__ unsigned xb_ld(unsigned* p)              { return __hip_atomic_load(p, __ATOMIC_RELAXED, __HIP_MEMORY_SCOPE_AGENT); }
__device__ __forceinline__ unsigned xb_add(unsigned* p, unsigned v) { return __hip_atomic_fetch_add(p, v, __ATOMIC_RELAXED, __HIP_MEMORY_SCOPE_AGENT); }
__device__ __forceinline__ unsigned xb_xcc_id() { return (unsigned)__builtin_amdgcn_s_getreg((3 << 11) | 20) & 0xFu; }
#define XB_SPIN(cond, bar) do { unsigned _sp = 0; while (cond) { __builtin_amdgcn_s_sleep(1); \
    if ((++_sp & 255u) == 0u) { if (xb_ld(&(bar)[XB_TMO])) break; if (_sp > XB_SPIN_CAP) { atomicAdd(&(bar)[XB_TMO], 1u); break; } } } } while (0)

struct XcdBarrier {
    unsigned* bar; unsigned x;
    volatile LAS unsigned* st;
};

__device__ __forceinline__ XcdBarrier xcd_barrier_post(unsigned* bar, volatile LAS unsigned* st) {
    XcdBarrier b; b.bar = bar; b.x = xb_xcc_id(); b.st = st;
    if (threadIdx.x == 0) (void)xb_add(&bar[XB_XCNT(b.x)], 1u);
    return b;
}
__device__ __forceinline__ void xcd_barrier_complete(unsigned* bar, unsigned x, unsigned& nloc, unsigned& nx) {
    const unsigned G = gridDim.x * gridDim.y * gridDim.z;
    unsigned sum, cnt, mine, sp = 0u;
    for (;;) {
        sum = 0u; cnt = 0u; mine = 0u;
#pragma unroll
        for (unsigned j = 0; j < 16; ++j) { const unsigned c = xb_ld(&bar[XB_XCNT(j)]); sum += c; cnt += (c > 0u) ? 1u : 0u; mine = (j == x) ? c : mine; }
        if (sum == G) break;
        __builtin_amdgcn_s_sleep(1);
        if ((++sp & 255u) == 0u) { if (xb_ld(&bar[XB_TMO])) break; if (sp > XB_SPIN_CAP) { atomicAdd(&bar[XB_TMO], 1u); break; } }
    }
    nloc = mine > 0u ? mine : 1u; nx = cnt > 0u ? cnt : 1u;
}

__device__ __forceinline__ void xcd_barrier(const XcdBarrier& b) {
    asm volatile("s_waitcnt vmcnt(0)" ::: "memory");
    __syncthreads();
    if (threadIdx.x == 0) {
        unsigned* bar = b.bar;
        __builtin_amdgcn_s_waitcnt(0);
        unsigned nloc = b.st[0], nx = b.st[1];
        if (nloc == 0u) { xcd_barrier_complete(bar, b.x, nloc, nx); b.st[0] = nloc; b.st[1] = nx; }
        const unsigned old = xb_add(&bar[XB_XSUB(b.x)], 1u);
        const unsigned gen = old / nloc;
        if (old + 1u == (gen + 1u) * nloc) {
            __builtin_amdgcn_fence(__ATOMIC_RELEASE, "agent");
            asm volatile("s_waitcnt vmcnt(0)" ::: "memory");
            const unsigned og = xb_add(&bar[XB_TOP], 1u);
            const unsigned tg = og / nx;
            if (og + 1u == (tg + 1u) * nx) xb_add(&bar[XB_TOPGEN], 1u);
            else XB_SPIN(xb_ld(&bar[XB_TOPGEN]) == tg, bar);
            __builtin_amdgcn_fence(__ATOMIC_ACQUIRE, "agent");
            xb_add(&bar[XB_XGEN(b.x)], 1u);
            asm volatile("s_waitcnt vmcnt(0)" ::: "memory");
        } else {
            XB_SPIN(xb_ld(&bar[XB_XGEN(b.x)]) == gen, bar);
            __builtin_amdgcn_fence(__ATOMIC_ACQUIRE, "agent");
            asm volatile("s_waitcnt vmcnt(0)" ::: "memory");
        }
    }
    __syncthreads();
}


namespace {
constexpr int NB = 32, SEQ = 2048, NMETA = 16, D = 1024, NTOK = NB * SEQ;
constexpr int TSEQ = SEQ + NMETA;
constexpr int DIN = 6144, DHG = 512, NE = 32, DE = 512;
constexpr int C_Q = 0, C_F = 512, C_I = 1024, C_OG = 1536, C_LX = 2048, C_LY = 3072, C_GA = 4096, C_GB = 5120;
constexpr int KUP = 1536;
constexpr float EPS = 1e-6f;
constexpr int NTHREADS = 512;
constexpr int LDS_BYTES = 144 * 1024;
constexpr int ACT_ROWS = 139264;
constexpr int LCAP = 65536;
constexpr float WD_SCALE = 32.0f, WGU_SCALE = 64.0f, ACT_SCALE = 8.0f, Y_SCALE = 16.0f;

constexpr size_t MiB = 1024ull * 1024ull;
constexpr size_t WS_PROJ = 0;
constexpr size_t WS_Y    = 128 * MiB;
constexpr size_t WS_ACT  = 384 * MiB;
constexpr size_t WS_LTK  = 520 * MiB;
constexpr size_t WS_LW   = 528 * MiB;
constexpr size_t WS_LRS  = 608 * MiB;
constexpr size_t WS_YDUMMY = 600 * MiB;
constexpr int Y_DUMMY_ROW = (int)((600 * MiB - 128 * MiB) / 1024);
constexpr size_t WS_HN   = 768 * MiB;
constexpr size_t WS_H2   = WS_HN;
constexpr size_t WS_W    = 896 * MiB;
constexpr size_t WS_WIN  = WS_W;
constexpr size_t WS_WUP  = WS_WIN + (size_t)DIN * D * 2;
constexpr size_t WS_WOUT = WS_WUP + (size_t)D * KUP * 2;
constexpr size_t WS_WGU  = WS_WOUT + (size_t)D * D * 2;
constexpr size_t WS_WD   = WS_WGU + (size_t)NE * 1024 * D * 2;
constexpr size_t WS_WR   = WS_WD + (size_t)NE * D * DE * 2;
constexpr size_t WS_CTL  = WS_WR + 128 * 1024;
constexpr size_t CTL_BAR = 0, CTL_CNT = 16384;
constexpr size_t CTL_ZERO_BYTES = 16384 + 256;
constexpr size_t WS_SSQ  = WS_CTL + 32768;
constexpr size_t WS_RINV = WS_SSQ;
constexpr size_t WS_PROJM = WS_SSQ + (size_t)NTOK * 4;
constexpr size_t WS_LB   = WS_PROJM + (size_t)NMETA * DIN * 4;
constexpr size_t WS_METAT = WS_LB + 4096;
constexpr size_t WS_END  = WS_METAT + (size_t)64 * DIN * 2;

struct Params {
    const float *x, *meta, *norm1_g, *w_in, *hg_lb, *hg_norm_g, *conv_w, *conv_b, *w_r, *b_r, *w_i, *b_i, *lam, *w_up_a, *w_up_b, *w_out,
                *norm2_g, *w_group, *b_group, *w_router, *b_router, *w_gate, *w_up, *w_down, *final_g;
    float* out; unsigned char* ws;
    int ph_lo, ph_hi;
};

__device__ __forceinline__ float bf2f(bf16_t b) { return __uint_as_float(((unsigned)b) << 16); }
__device__ __forceinline__ unsigned cvt_pk_bf16(float lo, float hi) { unsigned r; asm volatile("v_cvt_pk_bf16_f32 %0, %1, %2" : "=v"(r) : "v"(lo), "v"(hi)); return r; }
__device__ __forceinline__ bf16_t f2bf(float f) { return (bf16_t)(cvt_pk_bf16(f, 0.f) & 0xffffu); }
__device__ __forceinline__ float sigmoidf_(float x) { return 1.0f / (1.0f + __expf(-x)); }
__device__ __forceinline__ float gelu_tanh(float y) { const float z = 0.7978845608028654f * (y + 0.044715f * y * y * y); const float t = 1.0f - 2.0f / (1.0f + __expf(2.0f * z)); return 0.5f * y * (1.0f + t); }
__device__ __forceinline__ float wave_sum(float v) {
#pragma unroll
    for (int o = 32; o > 0; o >>= 1) v += __shfl_xor(v, o);
    return v;
}
__device__ __forceinline__ unsigned pack4_fp8(float a, float b, float c, float d) {
    a = __builtin_amdgcn_fmed3f(a, -448.f, 448.f); b = __builtin_amdgcn_fmed3f(b, -448.f, 448.f); c = __builtin_amdgcn_fmed3f(c, -448.f, 448.f); d = __builtin_amdgcn_fmed3f(d, -448.f, 448.f);
    int v = __builtin_amdgcn_cvt_pk_fp8_f32(a, b, 0, false); v = __builtin_amdgcn_cvt_pk_fp8_f32(c, d, v, true); return (unsigned)v; }
__device__ __forceinline__ int perm32(int rho) { const int n = rho >> 4, i = rho & 15; return 8 * (i >> 2) + 4 * n + (i & 3); }

struct Unit { const char* A; const char* B; int pm, pn, e, cnt, tile, slot; };

__device__ __forceinline__ int xcd_remap(int L, int nwg) {
    const int q = nwg / 8, r = nwg % 8, xcd = L % 8, off = L / 8; return (xcd < r ? xcd * (q + 1) : r * (q + 1) + (xcd - r) * q) + off; }
template <int NN>
struct DenseOrder {
    const char* A; const char* B; int nunits, G, c; size_t a_tile, b_tile;
    __device__ void init(const void* A_, size_t lda_b, const void* B_, size_t ldb_b, int M, int N, int G_, int c_) {
        A = (const char*)A_; B = (const char*)B_; nunits = (M / 256) * NN; G = G_; c = c_; a_tile = 256 * lda_b; b_tile = 256 * ldb_b; }
    __device__ __forceinline__ bool next(int i, Unit& u) const {
        const int L = i * G + c; if (L >= nunits) return false;
        const int W = xcd_remap(L, nunits);
        constexpr int nig = 8 * NN; const int gid = W / nig, w = W - gid * nig;
        u.pm = gid * 8 + (w & 7); u.pn = w >> 3; u.e = 0; u.cnt = 256; u.tile = 0; u.A = A + (size_t)u.pm * a_tile; u.B = B + (size_t)u.pn * b_tile; return true; }
    __device__ __forceinline__ unsigned row_off(const Unit&, int) const { return 0u; }
};

constexpr int T2E = 128;
constexpr int LS_OFF = 136 * 1024;
struct MoeOrder {
    const char* A; const char* B; const int* ltk; const float* lf; const volatile LAS int* tpre; int nN, nunits, G, c; size_t b_exp, b_tile, a_row; bool gather;
    __device__ __forceinline__ void stage_lists(const Unit& u, LAS unsigned char* lds, int wid) const {
        const size_t base = (size_t)u.e * LCAP + (size_t)u.pm * 256; LAS unsigned char* slot = lds + LS_OFF + u.slot * 2048; const int lane = threadIdx.x & 63;
        if (wid == 4) __builtin_amdgcn_global_load_lds((const unsigned*)(ltk + base) + lane * 4, (LAS unsigned*)slot, 16, 0, 0);
        else if (wid == 5) __builtin_amdgcn_global_load_lds((const unsigned*)(lf + base) + lane * 4, (LAS unsigned*)(slot + 1024), 16, 0, 0); }
    __device__ __forceinline__ unsigned row_off_lds(const Unit& u, int r, LAS unsigned char* lds) const {
        if (!gather) return (unsigned)(u.tile * 256 + r) * (unsigned)a_row;
        const volatile LAS int* ls = (const volatile LAS int*)(lds + LS_OFF + u.slot * 2048); const int tk = (r < u.cnt) ? ls[r] : 0; return (unsigned)(tk >> 1) * (unsigned)a_row; }
    __device__ __forceinline__ bool next(int i, Unit& u) const {
        const int L0 = i * G + c; if (L0 >= nunits) return false;
        const int L = xcd_remap(L0, nunits);
        const int tile = L / nN; u.pn = L % nN;
        const int e = __builtin_amdgcn_readfirstlane(tpre[T2E + tile]);
        u.e = e; u.pm = tile - __builtin_amdgcn_readfirstlane(tpre[e]); u.cnt = __builtin_amdgcn_readfirstlane(tpre[40 + e]) - u.pm * 256;
        u.B = B + (size_t)e * b_exp + (size_t)u.pn * b_tile; u.tile = tile;
        u.A = A; return true; }
    __device__ __forceinline__ unsigned row_off(const Unit& u, int r) const {
        if (!gather) return (unsigned)(u.tile * 256 + r) * (unsigned)a_row;
        const int idx = u.pm * 256 + r; const int tk = (r < u.cnt) ? ltk[(size_t)u.e * LCAP + idx] : 0; return (unsigned)(tk >> 1) * (unsigned)a_row; }
};

template <class Epi, class Sched, bool GATHER, int KMID>
__device__ __forceinline__ void gemm_simple(unsigned lda_b, unsigned ldb_b, int K, const Sched& S, const Epi& E) {
    const int tid = threadIdx.x, wid = tid >> 6, lane = tid & 63, wr = wid >> 2, wc = wid & 3, fr = lane & 15, fq = lane >> 4;
    for (int i = 0;; ++i) {
        Unit u; if (!S.next(i, u)) break;
        f32x4 acc[2][2][4][2];
#pragma unroll
        for (int a = 0; a < 2; ++a)
#pragma unroll
            for (int b = 0; b < 2; ++b)
#pragma unroll
                for (int m = 0; m < 4; ++m)
#pragma unroll
                    for (int n = 0; n < 2; ++n) acc[a][b][m][n] = (f32x4){0.f, 0.f, 0.f, 0.f};
        unsigned aoff[2][4], boff[2][2];
#pragma unroll
        for (int a = 0; a < 2; ++a)
#pragma unroll
            for (int m = 0; m < 4; ++m) { const int r = 128 * a + 64 * wr + 16 * m + fr; aoff[a][m] = (GATHER ? S.row_off(u, r) : (unsigned)r * lda_b) + fq * 16; }
#pragma unroll
        for (int b = 0; b < 2; ++b)
#pragma unroll
            for (int n = 0; n < 2; ++n) { const int wrow = 128 * b + 32 * wc + perm32(16 * n + fr); boff[b][n] = (unsigned)wrow * ldb_b + fq * 16; }
#define GS_KLOOP(k0, k1) _Pragma("unroll 1") for (int k = (k0); k < (k1); k += 32) { \
            bf16x8 av[2][4], bv[2][2]; \
            _Pragma("unroll") for (int a = 0; a < 2; ++a) _Pragma("unroll") for (int m = 0; m < 4; ++m) av[a][m] = *(const bf16x8*)(u.A + aoff[a][m] + k * 2); \
            _Pragma("unroll") for (int b = 0; b < 2; ++b) _Pragma("unroll") for (int n = 0; n < 2; ++n) bv[b][n] = *(const bf16x8*)(u.B + boff[b][n] + k * 2); \
            _Pragma("unroll") for (int a = 0; a < 2; ++a) _Pragma("unroll") for (int b = 0; b < 2; ++b) _Pragma("unroll") for (int m = 0; m < 4; ++m) _Pragma("unroll") for (int n = 0; n < 2; ++n) \
                acc[a][b][m][n] = __builtin_amdgcn_mfma_f32_16x16x32_bf16(bv[b][n], av[a][m], acc[a][b][m][n], 0, 0, 0); }
        if (KMID > 0) { GS_KLOOP(0, KMID) E.mid(acc, u, wr, wc, fr, fq); GS_KLOOP(KMID, K) } else { GS_KLOOP(0, K) }
#undef GS_KLOOP
        E(acc, u, wr, wc, fr, fq);
    }
}


constexpr int HTB = 128 * 64 * 2;
__device__ __forceinline__ int lds_byte(int r, int c) { const int st = (r >> 4) * 2 + (c >> 5), rr = r & 15, cc = c & 31, ob = rr * 64 + cc * 2; return st * 1024 + (ob ^ (((ob >> 9) & 1) << 5)); }
__device__ __forceinline__ void stage_rc(int b, int& R, int& C) { const int st = b / 1024, sb = b % 1024, swz = sb ^ (((sb >> 9) & 1) << 5); R = (st >> 1) * 16 + swz / 64; C = (st & 1) * 32 + (swz % 64) / 2; }

typedef int v8i32 __attribute__((ext_vector_type(8)));
typedef int v4i32 __attribute__((ext_vector_type(4)));
template <class Epi, class Sched, bool GATHER, int KMID, bool F8 = false>
__device__ __forceinline__ void gemm_phase(LAS unsigned char* lds, unsigned lda_b, unsigned ldb_b, int K  , const Sched& S, const Epi& E) {
    const int tid = threadIdx.x, wid = __builtin_amdgcn_readfirstlane(tid >> 6), lane = tid & 63, wr = wid >> 2, wc = wid & 3, fr = lane & 15, fq = lane >> 4;
    const int nt = K / 64;
    unsigned voffB[2], vA[2][2];
#pragma unroll
    for (int i = 0; i < 2; ++i) { int R, C; stage_rc(tid * 16 + i * 8192, R, C); const int Rb = (R & ~31) + perm32(R & 31);
        voffB[i] = (unsigned)Rb * ldb_b + (unsigned)C * 2u; vA[0][i] = (unsigned)R * lda_b + (unsigned)C * 2u; vA[1][i] = vA[0][i]; }
    const size_t kstep = 128;
    const size_t hstepA = GATHER ? 0 : (size_t)128 * lda_b, hstepB = (size_t)128 * ldb_b;
    const unsigned ldsw = (unsigned)wid * 1024u;
    const int aoff = lds_byte(wr * 64 + fr, fq * 8), boff = lds_byte(wc * 32 + fr, fq * 8);
#define PG8_SA(b, h) (((b) * 2 + (h)) * HTB)
#define PG8_SB(b, h) ((4 + (b) * 2 + (h)) * HTB)
#define PG8_STAGE(bufoff, gbase, voff) do { _Pragma("unroll") for (int _i = 0; _i < 2; ++_i) \
        __builtin_amdgcn_global_load_lds((const unsigned*)((const char*)(gbase) + (voff)[_i]), (LAS unsigned*)(lds + (bufoff) + ldsw + _i * 8192), 16, 0, 0); } while (0)
#define PG8_STAGE_A(bufoff, gbase, h) PG8_STAGE(bufoff, (gbase) + (h) * hstepA, vA[GATHER ? (h) : 0])
#define PG8_LDA(dst, b, h) do { _Pragma("unroll") for (int m = 0; m < 4; ++m) { if constexpr (F8) { const v4i32 _l = *(const LAS v4i32*)(lds + PG8_SA(b, h) + aoff + m * 2048), _h = *(const LAS v4i32*)(lds + PG8_SA(b, h) + aoff + m * 2048 + 1024); \
            dst##8[m] = __builtin_shufflevector(_l, _h, 0, 1, 2, 3, 4, 5, 6, 7); } else { _Pragma("unroll") for (int k = 0; k < 2; ++k) dst[m][k] = *(const LAS bf16x8*)(lds + PG8_SA(b, h) + aoff + m * 2048 + k * 1024); } } } while (0)
#define PG8_LDB(dst, b, h) do { _Pragma("unroll") for (int n = 0; n < 2; ++n) { if constexpr (F8) { const v4i32 _l = *(const LAS v4i32*)(lds + PG8_SB(b, h) + boff + n * 2048), _h = *(const LAS v4i32*)(lds + PG8_SB(b, h) + boff + n * 2048 + 1024); \
            dst##8[n] = __builtin_shufflevector(_l, _h, 0, 1, 2, 3, 4, 5, 6, 7); } else { _Pragma("unroll") for (int k = 0; k < 2; ++k) dst[n][k] = *(const LAS bf16x8*)(lds + PG8_SB(b, h) + boff + n * 2048 + k * 1024); } } } while (0)
#define PG8_MMA(ai, bj, At, Bt) do { __builtin_amdgcn_s_setprio(1); _Pragma("unroll") for (int m = 0; m < 4; ++m) _Pragma("unroll") for (int n = 0; n < 2; ++n) { \
        if constexpr (F8)   \
            asm volatile("v_mfma_scale_f32_16x16x128_f8f6f4 %0, %1, %2, %0, %3, %3 op_sel_hi:[0,0,0]" : "+v"(acc[ai][bj][m][n]) : "v"(Bt##8[n]), "v"(At##8[m]), "v"(f8_unit_scale));   \
        else { _Pragma("unroll") for (int k = 0; k < 2; ++k) acc[ai][bj][m][n] = __builtin_amdgcn_mfma_f32_16x16x32_bf16(Bt[n][k], At[m][k], acc[ai][bj][m][n], 0, 0, 0); } } \
        __builtin_amdgcn_s_setprio(0); } while (0)
#define PG8_WAIT_V(n) asm volatile("s_waitcnt vmcnt(" #n ")" ::: "memory")
#define PG8_WAIT_L(n) asm volatile("s_waitcnt lgkmcnt(" #n ")" ::: "memory")
#define PG8_BAR __builtin_amdgcn_s_barrier()
#define PG8_SCHED __builtin_amdgcn_sched_barrier(0)
    Unit cur, nxt; int ui = 0;
    if (!S.next(0, cur)) return;
    f32x4 acc[2][2][4][2];
#pragma unroll
    for (int a = 0; a < 2; ++a)
#pragma unroll
        for (int b = 0; b < 2; ++b)
#pragma unroll
            for (int m = 0; m < 4; ++m)
#pragma unroll
                for (int n = 0; n < 2; ++n) acc[a][b][m][n] = (f32x4){0.f, 0.f, 0.f, 0.f};
    const int f8_unit_scale = 0x7f7f7f7f;
    bf16x8 At[4][2], B0[2][2], B1[2][2]; v8i32 At8[4], B08[2], B18[2];
    const char* cA = cur.A; const char* cB = cur.B;
    if constexpr (GATHER) {
#pragma unroll
        for (int h = 0; h < 2; ++h)
#pragma unroll
            for (int i = 0; i < 2; ++i) { int R, C; stage_rc(tid * 16 + i * 8192, R, C); vA[h][i] = S.row_off(cur, h * 128 + R) + (unsigned)C * 2u; }
        cur.slot = 0; S.stage_lists(cur, lds, wid);
    }
    PG8_STAGE(PG8_SB(0, 0), cB, voffB); PG8_STAGE(PG8_SB(0, 1), cB + hstepB, voffB); PG8_STAGE_A(PG8_SA(0, 0), cA, 0); PG8_STAGE_A(PG8_SA(0, 1), cA, 1);
    if (wr == 1) PG8_BAR;
    PG8_WAIT_V(2); PG8_BAR;
    PG8_STAGE(PG8_SB(1, 0), cB + kstep, voffB); PG8_STAGE_A(PG8_SA(1, 0), cA + kstep, 0); PG8_STAGE(PG8_SB(1, 1), cB + hstepB + kstep, voffB);
    PG8_WAIT_V(6); PG8_BAR;
    for (;;) {
        const bool has_next = S.next(ui + 1, nxt);
        const char* nA = has_next ? nxt.A : cA; const char* nB = has_next ? nxt.B : cB;
        if constexpr (GATHER) { nxt.slot = (ui + 1) & 1; if (has_next) S.stage_lists(nxt, lds, wid); }
#pragma unroll 1
        for (int t = 0; t < nt; t += 2) {
            const bool last = (t == nt - 2);
            const char* a1 = cA + (size_t)(t + 1) * kstep;
            const char* a2 = last ? nA : cA + (size_t)(t + 2) * kstep; const char* b2 = last ? nB : cB + (size_t)(t + 2) * kstep;
            const char* a3 = a2 + kstep; const char* b3 = b2 + kstep;
            if (KMID > 0 && t == KMID / 64) E.mid(acc, cur, wr, wc, fr, fq);
            asm volatile("" : "+v"(voffB[0]), "+v"(voffB[1]), "+v"(vA[0][0]), "+v"(vA[0][1]), "+v"(vA[1][0]), "+v"(vA[1][1]));
            PG8_LDB(B0, 0, 0); PG8_LDB(B1, 0, 1); PG8_SCHED; PG8_LDA(At, 0, 0); PG8_STAGE_A(PG8_SA(1, 1), a1, 1);
            if constexpr (GATHER) { if (last && has_next) { int tz = tid; asm volatile("" : "+v"(tz));
#pragma unroll
                for (int h = 0; h < 2; ++h)
#pragma unroll
                    for (int i = 0; i < 2; ++i) { int R, C; stage_rc(tz * 16 + i * 8192, R, C); vA[h][i] = S.row_off_lds(nxt, h * 128 + R, lds) + (unsigned)C * 2u; } } }
            PG8_WAIT_V(8); PG8_WAIT_L(0); PG8_BAR; PG8_MMA(0, 0, At, B0); PG8_MMA(0, 1, At, B1); PG8_BAR; PG8_SCHED;
            PG8_LDA(At, 0, 1); PG8_STAGE(PG8_SB(0, 0), b2, voffB); PG8_STAGE(PG8_SB(0, 1), b2 + hstepB, voffB); PG8_STAGE_A(PG8_SA(0, 0), a2, 0);
            PG8_WAIT_V(8); PG8_WAIT_L(0); PG8_BAR; PG8_MMA(1, 0, At, B0); PG8_MMA(1, 1, At, B1); PG8_BAR; PG8_SCHED;
            PG8_LDB(B0, 1, 0); PG8_LDB(B1, 1, 1); PG8_SCHED; PG8_LDA(At, 1, 0); PG8_STAGE_A(PG8_SA(0, 1), a2, 1);
            PG8_WAIT_V(8); PG8_WAIT_L(0); PG8_BAR; PG8_MMA(0, 0, At, B0); PG8_MMA(0, 1, At, B1); PG8_BAR; PG8_SCHED;
            PG8_LDA(At, 1, 1); PG8_STAGE(PG8_SB(1, 0), b3, voffB); PG8_STAGE(PG8_SB(1, 1), b3 + hstepB, voffB); PG8_STAGE_A(PG8_SA(1, 0), a3, 0);
            PG8_WAIT_V(8); PG8_WAIT_L(0); PG8_BAR; PG8_MMA(1, 0, At, B0); PG8_MMA(1, 1, At, B1); PG8_BAR; PG8_SCHED;
        }
        if (wr == 0) PG8_BAR;
        { int tz = threadIdx.x; asm volatile("" : "+v"(tz));
          E(acc, cur, wr, wc, tz & 15, (tz & 63) >> 4); }
        if (!has_next) break;
#pragma unroll
        for (int a = 0; a < 2; ++a)
#pragma unroll
            for (int b = 0; b < 2; ++b)
#pragma unroll
                for (int m = 0; m < 4; ++m)
#pragma unroll
                    for (int n = 0; n < 2; ++n) acc[a][b][m][n] = (f32x4){0.f, 0.f, 0.f, 0.f};
        cur = nxt; cA = nA; cB = nB; ++ui;
        if (wr == 1) PG8_BAR;
    }
    PG8_WAIT_V(0);
    PG8_BAR;
#undef PG8_SA
#undef PG8_SB
#undef PG8_STAGE
#undef PG8_STAGE_A
#undef PG8_LDA
#undef PG8_LDB
#undef PG8_MMA
#undef PG8_WAIT_V
#undef PG8_WAIT_L
#undef PG8_BAR
#undef PG8_SCHED
}

struct EpiStoreBf16 {
    bf16_t* O; int ldc;
    __device__ __forceinline__ void mid(f32x4 (&)[2][2][4][2], const Unit&, int, int, int, int) const {}
    __device__ __forceinline__ void operator()(const f32x4 (&acc)[2][2][4][2], const Unit& u, int wr, int wc, int fr, int fq) const {
        const int row0 = u.pm * 256 + wr * 64 + fr, col0 = u.pn * 256 + wc * 32 + 8 * fq;
        if (u.pn >= C_GA / 256) {
#pragma unroll
            for (int ai = 0; ai < 2; ++ai)
#pragma unroll
                for (int m = 0; m < 4; ++m) { bf16_t* rowp = O + (size_t)(row0 + ai * 128 + m * 16) * ldc + col0; float rt[8], sb[8];
#pragma unroll
                    for (int j = 0; j < 8; ++j) { const float ea = __builtin_amdgcn_exp2f(fminf(-1.4426950408889634f * acc[ai][0][m][j >> 2][j & 3], 80.f)), eb = __builtin_amdgcn_exp2f(fminf(-1.4426950408889634f * acc[ai][1][m][j >> 2][j & 3], 80.f));
                        rt[j] = (1.0f + eb) * __builtin_amdgcn_rcpf(1.0f + ea); sb[j] = __builtin_amdgcn_rcpf(1.0f + eb); }
                    u32x4 w; w.x = cvt_pk_bf16(rt[0], rt[1]); w.y = cvt_pk_bf16(rt[2], rt[3]); w.z = cvt_pk_bf16(rt[4], rt[5]); w.w = cvt_pk_bf16(rt[6], rt[7]);
                    *(u32x4*)(rowp) = w;
                    w.x = cvt_pk_bf16(sb[0], sb[1]); w.y = cvt_pk_bf16(sb[2], sb[3]); w.z = cvt_pk_bf16(sb[4], sb[5]); w.w = cvt_pk_bf16(sb[6], sb[7]);
                    *(u32x4*)(rowp + 128) = w; }
            return; }
#pragma unroll
        for (int ai = 0; ai < 2; ++ai)
#pragma unroll
            for (int m = 0; m < 4; ++m) { bf16_t* rowp = O + (size_t)(row0 + ai * 128 + m * 16) * ldc + col0;
#pragma unroll
                for (int bj = 0; bj < 2; ++bj) { const f32x4 v0 = acc[ai][bj][m][0], v1 = acc[ai][bj][m][1];
                    u32x4 w; w.x = cvt_pk_bf16(v0[0], v0[1]); w.y = cvt_pk_bf16(v0[2], v0[3]); w.z = cvt_pk_bf16(v1[0], v1[1]); w.w = cvt_pk_bf16(v1[2], v1[3]);
                    *(u32x4*)(rowp + bj * 128) = w; } }
    }
};

__device__ __forceinline__ void unpack8(const u32x4 w, float (&f)[8]) {
    f[0] = __uint_as_float(w.x << 16); f[1] = __uint_as_float(w.x & 0xffff0000u); f[2] = __uint_as_float(w.y << 16); f[3] = __uint_as_float(w.y & 0xffff0000u);
    f[4] = __uint_as_float(w.z << 16); f[5] = __uint_as_float(w.z & 0xffff0000u); f[6] = __uint_as_float(w.w << 16); f[7] = __uint_as_float(w.w & 0xffff0000u);
}

struct EpiMerge {
    bf16_t* O; const bf16_t* proj;
    __device__ __forceinline__ void mid(f32x4 (&acc)[2][2][4][2], const Unit& u, int wr, int wc, int fr, int fq) const {
        const int row0 = u.pm * 256 + wr * 64 + fr, gcol = C_GA + u.pn * 512 + wc * 32 + 8 * fq;
        u32x4 ra[4][2];
#define EM_LOAD(gq) do { int rr = row0 + ((gq) >> 2) * 128 + ((gq) & 3) * 16; asm volatile("" : "+v"(rr)); const bf16_t* rowp = proj + (size_t)rr * DIN + gcol; \
            ra[(gq) & 3][0] = *(const u32x4*)(rowp); ra[(gq) & 3][1] = *(const u32x4*)(rowp + 256); } while (0)
        EM_LOAD(0); EM_LOAD(1); EM_LOAD(2);
#pragma unroll
        for (int grp = 0; grp < 8; ++grp) { const int ai = grp >> 2, m = grp & 3, cb = grp & 3;
            if (grp + 3 < 8) EM_LOAD(grp + 3);
            asm volatile("" ::: "memory");
#pragma unroll
            for (int bj = 0; bj < 2; ++bj) { float rt[8]; unpack8(ra[cb][bj], rt);
#pragma unroll
                for (int j = 0; j < 8; ++j) acc[ai][bj][m][j >> 2][j & 3] *= rt[j]; }
            asm volatile("" ::: "memory"); }
#undef EM_LOAD
    }
    __device__ __forceinline__ void operator()(const f32x4 (&acc)[2][2][4][2], const Unit& u, int wr, int wc, int fr, int fq) const {
        const int row0 = u.pm * 256 + wr * 64 + fr, col0 = u.pn * 256 + wc * 32 + 8 * fq, gcol = C_GA + u.pn * 512 + wc * 32 + 8 * fq + 128;
        u32x4 rb[4][2];
#define EM_LOAD(gq) do { int rr = row0 + ((gq) >> 2) * 128 + ((gq) & 3) * 16; asm volatile("" : "+v"(rr)); const bf16_t* rowp = proj + (size_t)rr * DIN + gcol; \
            rb[(gq) & 3][0] = *(const u32x4*)(rowp); rb[(gq) & 3][1] = *(const u32x4*)(rowp + 256); } while (0)
        EM_LOAD(0); EM_LOAD(1); EM_LOAD(2);
#pragma unroll
        for (int grp = 0; grp < 8; ++grp) { const int ai = grp >> 2, m = grp & 3, cb = grp & 3;
            if (grp + 3 < 8) EM_LOAD(grp + 3);
            asm volatile("" ::: "memory");
            const size_t r = (size_t)(row0 + ai * 128 + m * 16);
#pragma unroll
            for (int bj = 0; bj < 2; ++bj) { float sb[8], v[8]; unpack8(rb[cb][bj], sb);
#pragma unroll
                for (int j = 0; j < 8; ++j) v[j] = acc[ai][bj][m][j >> 2][j & 3] * sb[j];
                u32x4 w; w.x = cvt_pk_bf16(v[0], v[1]); w.y = cvt_pk_bf16(v[2], v[3]); w.z = cvt_pk_bf16(v[4], v[5]); w.w = cvt_pk_bf16(v[6], v[7]);
                *(u32x4*)(O + r * DIN + col0 + bj * 128) = w; }
            asm volatile("" ::: "memory"); }
#undef EM_LOAD
    }
};

struct EpiResid {
    bf16_t* H; const float* rinv; unsigned char* O8;
    __device__ __forceinline__ void mid(f32x4 (&)[2][2][4][2], const Unit&, int, int, int, int) const {}
    __device__ __forceinline__ void operator()(const f32x4 (&acc)[2][2][4][2], const Unit& u, int wr, int wc, int fr, int fq) const {
        const int row0 = u.pm * 256 + wr * 64 + fr, col0 = u.pn * 256 + wc * 32 + 8 * fq;
        u32x4 xr[4][2]; float ri[4];
#define ER_LOAD(gq) do { int rr = row0 + ((gq) >> 2) * 128 + ((gq) & 3) * 16; asm volatile("" : "+v"(rr)); const bf16_t* hp = H + (size_t)rr * D + col0; \
            xr[(gq) & 3][0] = *(const u32x4*)(hp); xr[(gq) & 3][1] = *(const u32x4*)(hp + 128); ri[(gq) & 3] = rinv[rr]; } while (0)
        ER_LOAD(0); ER_LOAD(1); ER_LOAD(2);
#pragma unroll
        for (int grp = 0; grp < 8; ++grp) { const int ai = grp >> 2, m = grp & 3, cb = grp & 3;
            if (grp + 3 < 8) ER_LOAD(grp + 3);
            asm volatile("" ::: "memory");
            const size_t r = (size_t)(row0 + ai * 128 + m * 16);
            const float rv = ri[cb];
#pragma unroll
            for (int bj = 0; bj < 2; ++bj) { float xv[8]; unpack8(xr[cb][bj], xv);
                const f32x4 v0 = acc[ai][bj][m][0] + (f32x4){xv[0], xv[1], xv[2], xv[3]} * rv, v1 = acc[ai][bj][m][1] + (f32x4){xv[4], xv[5], xv[6], xv[7]} * rv;
                u32x4 w; w.x = cvt_pk_bf16(v0[0], v0[1]); w.y = cvt_pk_bf16(v0[2], v0[3]); w.z = cvt_pk_bf16(v1[0], v1[1]); w.w = cvt_pk_bf16(v1[2], v1[3]);
                *(u32x4*)(H + r * D + col0 + bj * 128) = w;
                *(u32x2*)(O8 + r * D + col0 + bj * 128) = (u32x2){pack4_fp8(v0[0], v0[1], v0[2], v0[3]), pack4_fp8(v1[0], v1[1], v1[2], v1[3])}; }
            asm volatile("" ::: "memory"); }
#undef ER_LOAD
    }
};

struct EpiAct {
    bf16_t* act; const volatile LAS int* tpre;
    __device__ __forceinline__ void mid(f32x4 (&)[2][2][4][2], const Unit&, int, int, int, int) const {}
    __device__ __forceinline__ void operator()(const f32x4 (&acc)[2][2][4][2], const Unit& u, int wr, int wc, int fr, int fq) const {
        const int tile = __builtin_amdgcn_readfirstlane(tpre[u.e]) + u.pm; const int col0 = u.pn * 128 + wc * 32 + 8 * fq;
        int frl = fr; asm volatile("" : "+v"(frl));
        float rs[8];
        const volatile LAS float* lp = (const volatile LAS float*)tpre + ((LS_OFF - 140 * 1024) / 4 + u.slot * 512 + 256); const int last = (u.cnt < 256 ? u.cnt : 256) - 1;
#pragma unroll
        for (int i = 0; i < 8; ++i) { const int rr = (i >> 2) * 128 + wr * 64 + (i & 3) * 16 + frl; rs[i] = lp[rr < last ? rr : last]; }
#pragma unroll
        for (int i = 0; i < 8; ++i) { const int ai = i >> 2, m = i & 3, rr = ai * 128 + wr * 64 + m * 16 + frl;
            const float rstd = rs[i];
            float v[8];
#pragma unroll
            for (int j = 0; j < 8; ++j) { const float g = acc[ai][0][m][j >> 2][j & 3] * rstd, up = acc[ai][1][m][j >> 2][j & 3] * rstd; v[j] = g * up * __builtin_amdgcn_rcpf(1.0f + __builtin_amdgcn_exp2f(-1.4426950408889634f * g)); }
            *(u32x2*)((unsigned char*)act + ((size_t)tile * 256 + rr) * DE + col0) = (u32x2){pack4_fp8(v[0] * ACT_SCALE, v[1] * ACT_SCALE, v[2] * ACT_SCALE, v[3] * ACT_SCALE), pack4_fp8(v[4] * ACT_SCALE, v[5] * ACT_SCALE, v[6] * ACT_SCALE, v[7] * ACT_SCALE)}; }
    }
};

struct EpiDown {
    bf16_t* y; const volatile LAS int* tpre;
    __device__ __forceinline__ void mid(f32x4 (&)[2][2][4][2], const Unit&, int, int, int, int) const {}
    __device__ __forceinline__ void operator()(const f32x4 (&acc)[2][2][4][2], const Unit& u, int wr, int wc, int fr, int fq) const {
        const int col0 = u.pn * 256 + wc * 32 + 8 * fq;
        int frl = fr; asm volatile("" : "+v"(frl));
        int tk[8]; float wt[8];
        const volatile LAS int* ltk = tpre + ((LS_OFF - 140 * 1024) / 4 + u.slot * 512); const volatile LAS float* lw = (const volatile LAS float*)ltk + 256; const int last = (u.cnt < 256 ? u.cnt : 256) - 1;
#pragma unroll
        for (int i = 0; i < 8; ++i) { const int rr = (i >> 2) * 128 + wr * 64 + (i & 3) * 16 + frl; const int rc = rr < last ? rr : last; const int t = ltk[rc]; tk[i] = (rr <= last) ? t : Y_DUMMY_ROW;
            wt[i] = lw[rc] * (Y_SCALE / (ACT_SCALE * WD_SCALE)); }
#pragma unroll
        for (int i = 0; i < 8; ++i) { const int ai = i >> 2, m = i & 3;
#pragma unroll
            for (int bj = 0; bj < 2; ++bj) { const f32x4 v0 = acc[ai][bj][m][0] * wt[i], v1 = acc[ai][bj][m][1] * wt[i];
                *(u32x2*)((unsigned char*)y + (size_t)tk[i] * D + col0 + bj * 128) = (u32x2){pack4_fp8(v0[0], v0[1], v0[2], v0[3]), pack4_fp8(v1[0], v1[1], v1[2], v1[3])}; } }
    }
};

__device__ __forceinline__ void tr_tile8(const float* src, int ld_src, unsigned char* dst, int ld_dst, int k0, int n0, int drow0, const float* scale, float mul, LAS float* tile) {
    const int lane = threadIdx.x & 63, kq = lane >> 4, n4 = (lane & 15) * 4;
    f32x4 v[16];
#pragma unroll
    for (int it = 0; it < 16; ++it) v[it] = *(const f32x4*)(src + (size_t)(k0 + it * 4 + kq) * ld_src + n0 + n4);
#pragma unroll
    for (int it = 0; it < 16; ++it) { const int k = it * 4 + kq; const float s = (scale ? scale[k0 + k] : 1.0f) * mul;
        tile[k * 65 + n4 + 0] = v[it][0] * s; tile[k * 65 + n4 + 1] = v[it][1] * s; tile[k * 65 + n4 + 2] = v[it][2] * s; tile[k * 65 + n4 + 3] = v[it][3] * s; }
    __builtin_amdgcn_wave_barrier();
    const int kg = lane & 7;
#pragma unroll
    for (int it = 0; it < 8; ++it) { const int nn = (lane >> 3) + 8 * it; float f[8];
#pragma unroll
        for (int j = 0; j < 8; ++j) f[j] = tile[(kg * 8 + j) * 65 + nn];
        *(u32x2*)(dst + (size_t)(drow0 + nn) * ld_dst + k0 + kg * 8) = (u32x2){pack4_fp8(f[0], f[1], f[2], f[3]), pack4_fp8(f[4], f[5], f[6], f[7])}; }
    __builtin_amdgcn_wave_barrier();
}
__device__ __forceinline__ void tr_tile(const float* src, int ld_src, bf16_t* dst, int ld_dst, int k0, int n0, int drow0, const float* scale, LAS float* tile) {
    const int lane = threadIdx.x & 63, kq = lane >> 4, n4 = (lane & 15) * 4;
    f32x4 v[16];
#pragma unroll
    for (int it = 0; it < 16; ++it) v[it] = *(const f32x4*)(src + (size_t)(k0 + it * 4 + kq) * ld_src + n0 + n4);
#pragma unroll
    for (int it = 0; it < 16; ++it) { const int k = it * 4 + kq; const float s = scale ? scale[k0 + k] : 1.0f;
        tile[k * 65 + n4 + 0] = v[it][0] * s; tile[k * 65 + n4 + 1] = v[it][1] * s; tile[k * 65 + n4 + 2] = v[it][2] * s; tile[k * 65 + n4 + 3] = v[it][3] * s; }
    __builtin_amdgcn_wave_barrier();
    const int kg = lane & 7;
#pragma unroll
    for (int it = 0; it < 8; ++it) { const int nn = (lane >> 3) + 8 * it; float f[8];
#pragma unroll
        for (int j = 0; j < 8; ++j) f[j] = tile[(kg * 8 + j) * 65 + nn];
        u32x4 w; w.x = cvt_pk_bf16(f[0], f[1]); w.y = cvt_pk_bf16(f[2], f[3]); w.z = cvt_pk_bf16(f[4], f[5]); w.w = cvt_pk_bf16(f[6], f[7]);
        *(u32x4*)(dst + (size_t)(drow0 + nn) * ld_dst + k0 + kg * 8) = w; }
    __builtin_amdgcn_wave_barrier();
}

constexpr int T_IN = 16 * 96, T_UPA = 8 * 16, T_UPB = 16 * 16, T_OUT = 16 * 16, T_G = NE * 16 * 8, T_U = NE * 16 * 8, T_D = NE * 8 * 16;
constexpr int T_EARLY = T_IN + T_UPA + T_UPB + T_OUT, T_TOTAL = T_EARLY + T_G + T_U + T_D;
constexpr int CONV_TPT = 32, N_CONV_TASKS = (T_TOTAL - T_EARLY) / CONV_TPT;
__device__ __forceinline__ void conv_tile(const Params& P, LAS float* tile, int t) {
    unsigned char* ws = P.ws;
    int j = t;
    if (j < T_IN) { const int kt = j / 96, ntl = j % 96; const int n0 = ntl * 64;
        const int c = (n0 - C_GA) & 1023, drow = n0 < C_GA ? n0 : C_GA + 256 * (c >> 7) + (c & 127) + (n0 >= C_GB ? 128 : 0);
        tr_tile(P.w_in, DIN, (bf16_t*)(ws + WS_WIN), D, kt * 64, n0, drow, P.norm1_g, tile); return; }
    j -= T_IN;
    if (j < T_UPA) { const int kt = j / 16, ntl = j % 16; tr_tile(P.w_up_a, D, (bf16_t*)(ws + WS_WUP), KUP, kt * 64, ntl * 64, ntl * 64, nullptr, tile); return; }
    j -= T_UPA;
    if (j < T_UPB) { const int kt = j / 16, ntl = j % 16; tr_tile(P.w_up_b, D, (bf16_t*)(ws + WS_WUP) + 512, KUP, kt * 64, ntl * 64, ntl * 64, nullptr, tile); return; }
    j -= T_UPB;
    if (j < T_OUT) { const int kt = j / 16, ntl = j % 16; tr_tile(P.w_out, D, (bf16_t*)(ws + WS_WOUT), D, kt * 64, ntl * 64, ntl * 64, nullptr, tile); return; }
    j -= T_OUT;
    if (j < T_G + T_U) { const bool up = j >= T_G; if (up) j -= T_G; const int e = j / 128, r = j % 128, kt = r % 16, ntl = r / 16; const int c0 = ntl * 64;
        const int drow = (c0 >> 7) * 256 + (c0 & 127) + (up ? 128 : 0);
        tr_tile8((up ? P.w_up : P.w_gate) + (size_t)e * D * DE, DE, (unsigned char*)(ws + WS_WGU) + (size_t)e * 1024 * D, D, kt * 64, c0, drow, P.norm2_g, WGU_SCALE, tile); return; }
    j -= T_G + T_U;
    { const int e = j / 128, r = j % 128, kt = r % 8, ntl = r / 8;
      tr_tile8(P.w_down + (size_t)e * DE * D, D, (unsigned char*)(ws + WS_WD) + (size_t)e * D * DE, DE, kt * 64, ntl * 64, ntl * 64, nullptr, WD_SCALE, tile); }
}

__device__ void p0_prologue(const Params& P, LAS unsigned char* lds, int bid, int nb) {
    const int tid = threadIdx.x, wid = tid >> 6, lane = tid & 63;
    unsigned char* ws = P.ws;
    LAS float* tile = (LAS float*)lds;
    for (int t = bid * 8 + wid; t < T_EARLY; t += nb * 8) conv_tile(P, tile + wid * (64 * 65), t);
    __syncthreads();
    { LAS float* hm = (LAS float*)lds;
      LAS float* red = (LAS float*)(lds + 65536);
      float* projm = (float*)(ws + WS_PROJM); bf16_t* metat = (bf16_t*)(ws + WS_METAT);
      bool have = false;
      for (int cg = nb - 1 - bid; cg < DIN / 64; cg += nb) {
          if (!have) { __syncthreads();
              for (int r = wid; r < NMETA; r += 8) { const float* mr = P.meta + (size_t)r * D; float ss = 0.f;
                  for (int k = lane; k < D; k += 64) { const float v = mr[k]; ss += v * v; }
                  ss = wave_sum(ss); const float rstd = rsqrtf(ss * (1.0f / D) + EPS);
                  for (int k = lane; k < D; k += 64) hm[r * D + k] = mr[k] * rstd * P.norm1_g[k]; }
              have = true; __syncthreads(); }
          const int c = tid & 63, ks = tid >> 6; float a[16];
#pragma unroll
          for (int r = 0; r < 16; ++r) a[r] = 0.f;
#pragma unroll 1
          for (int k0 = ks * 128; k0 < ks * 128 + 128; k0 += 8) { float w[8];
#pragma unroll
              for (int q = 0; q < 8; ++q) w[q] = P.w_in[(size_t)(k0 + q) * DIN + cg * 64 + c];
#pragma unroll
              for (int q = 0; q < 8; ++q)
#pragma unroll
                  for (int r = 0; r < 16; ++r) a[r] += hm[r * D + k0 + q] * w[q]; }
#pragma unroll
          for (int r = 0; r < 16; ++r) red[(ks * 16 + r) * 64 + c] = a[r];
          __syncthreads();
          for (int o = tid; o < 16 * 64; o += NTHREADS) { const int r = o >> 6, cc = o & 63; float s = 0.f;
#pragma unroll
              for (int q = 0; q < 8; ++q) s += red[(q * 16 + r) * 64 + cc];
              projm[(size_t)r * DIN + cg * 64 + cc] = s; metat[(size_t)(48 + r) * DIN + cg * 64 + cc] = f2bf(s); }
          for (int o = tid; o < 48 * 64; o += NTHREADS) { const int r = o >> 6, col = cg * 64 + (o & 63); metat[(size_t)r * DIN + col] = (col >= C_F && col < C_F + DHG) ? (bf16_t)0x42A0 : (bf16_t)0; }
          __syncthreads(); } }
    { bf16_t* hn = (bf16_t*)(ws + WS_HN); float* rinv1 = (float*)(ws + WS_RINV);
      volatile LAS int* shq = (volatile LAS int*)(lds + 141 * 1024 + 64); int* rq = (int*)(ws + WS_CTL + CTL_CNT + 128 + 8);
      for (;;) { __syncthreads(); if (tid == 0) shq[0] = atomicAdd(rq, 1); __syncthreads(); const int grp = __builtin_amdgcn_readfirstlane(shq[0]); if (grp >= NTOK / 32) break;
          const int r0 = grp * 32 + wid * 4;
          f32x4 v[4][4];
#pragma unroll
          for (int rr = 0; rr < 4; ++rr)
#pragma unroll
              for (int q = 0; q < 4; ++q) v[rr][q] = *(const f32x4*)(P.x + (size_t)(r0 + rr) * D + 256 * q + 4 * lane);
          float rinv = 0.f;
#pragma unroll
          for (int rr = 0; rr < 4; ++rr) { float ss = 0.f;
#pragma unroll
              for (int q = 0; q < 4; ++q) ss += v[rr][q][0] * v[rr][q][0] + v[rr][q][1] * v[rr][q][1] + v[rr][q][2] * v[rr][q][2] + v[rr][q][3] * v[rr][q][3];
              ss = wave_sum(ss); const float rstd = rsqrtf(ss * (1.0f / D) + EPS);
              if (lane == rr) rinv = 1.0f / rstd;
#pragma unroll
              for (int q = 0; q < 4; ++q) { const f32x4 o = v[rr][q] * rstd;
                  *(u32x2*)(hn + (size_t)(r0 + rr) * D + 256 * q + 4 * lane) = (u32x2){cvt_pk_bf16(o[0], o[1]), cvt_pk_bf16(o[2], o[3])}; } }
          if (lane < 4) rinv1[r0 + lane] = rinv; } }
    { float* lb = (float*)(ws + WS_LB);
      for (int d = bid * NTHREADS + tid; d < DHG; d += nb * NTHREADS) lb[d] = sigmoidf_(P.hg_lb[d] - P.hg_lb[DHG + d]);
      bf16_t* wrt = (bf16_t*)(ws + WS_WR);
      for (int o = bid * NTHREADS + tid; o < 48 * D; o += nb * NTHREADS) { const int j = o / D, k = o % D; float v = 0.f;
          { const int nt = j >> 4, g = (j >> 2) & 3, jj = j & 3;
            if (nt < 2) v = P.w_router[((size_t)g * D + k) * 8 + nt * 4 + jj] * P.norm2_g[k];
            else if (jj == 0) v = P.w_group[(size_t)k * 4 + g] * P.norm2_g[k]; }
          wrt[o] = f2bf(v); }
    }
}

__device__ __forceinline__ float ldproj(const Params& P, int b, int s, int col) {
    if (s < NMETA) return ((const float*)(P.ws + WS_PROJM))[(size_t)s * DIN + col];
    return bf2f(((const bf16_t*)(P.ws + WS_PROJ))[((size_t)b * SEQ + (s - NMETA)) * DIN + col]);
}

__device__ void hgrn_simple(const Params& P, LAS unsigned char* lds, int unit) {
    constexpr int TC = 32;
    const int tid = threadIdx.x, wid = tid >> 6, lane = tid & 63, b = unit >> 2, h = unit & 3, v = tid & 127, dg = tid >> 7;
    LAS float* fb = (LAS float*)lds; LAS float* kb = fb + TC * 128; LAS float* qb = kb + TC * 128; LAS float* vb = qb + TC * 128; LAS float* op = vb + TC * 128;
    const float* lbp = (const float*)(P.ws + WS_LB);
    bf16_t* oab = (bf16_t*)P.out;
    float S[32];
#pragma unroll
    for (int j = 0; j < 32; ++j) S[j] = 0.f;
    for (int c0 = 0; c0 < TSEQ; c0 += TC) {
        const int len = (TSEQ - c0) < TC ? (TSEQ - c0) : TC;
        __syncthreads();
        for (int idx = tid; idx < len * 128; idx += NTHREADS) { const int t = idx >> 7, d = idx & 127, s = c0 + t;
            const float q = ldproj(P, b, s, C_Q + h * 128 + d), fp = ldproj(P, b, s, C_F + h * 128 + d), iv = ldproj(P, b, s, C_I + h * 128 + d);
            const float lb = lbp[h * 128 + d];
            fb[idx] = lb + (1.0f - lb) * sigmoidf_(fp); kb[idx] = (1.0f - lb) * sigmoidf_(-fp); qb[idx] = q; vb[idx] = iv; }
        __syncthreads();
        for (int t = 0; t < len; ++t) { const float vv = vb[t * 128 + v]; float o = 0.f;
#pragma unroll
            for (int j4 = 0; j4 < 8; ++j4) { const f32x4 f4 = *(const LAS f32x4*)(fb + t * 128 + dg * 32 + j4 * 4), k4 = *(const LAS f32x4*)(kb + t * 128 + dg * 32 + j4 * 4), q4 = *(const LAS f32x4*)(qb + t * 128 + dg * 32 + j4 * 4);
#pragma unroll
                for (int j = 0; j < 4; ++j) { S[j4 * 4 + j] = f4[j] * S[j4 * 4 + j] + k4[j] * vv; o += S[j4 * 4 + j] * q4[j]; } }
            op[(t * 4 + dg) * 128 + v] = o; }
        __syncthreads();
        for (int t = wid; t < len; t += 8) { const int s = c0 + t; if (s < NMETA) continue;
            const float o0 = op[(t * 4 + 0) * 128 + lane] + op[(t * 4 + 1) * 128 + lane] + op[(t * 4 + 2) * 128 + lane] + op[(t * 4 + 3) * 128 + lane];
            const float o1 = op[(t * 4 + 0) * 128 + lane + 64] + op[(t * 4 + 1) * 128 + lane + 64] + op[(t * 4 + 2) * 128 + lane + 64] + op[(t * 4 + 3) * 128 + lane + 64];
            const float ss = wave_sum(o0 * o0 + o1 * o1); const float rstd = rsqrtf(ss * (1.0f / 128.0f) + EPS);
            const size_t row = (size_t)b * SEQ + (s - NMETA);
            const float g0 = P.hg_norm_g[h * 128 + lane], g1 = P.hg_norm_g[h * 128 + lane + 64];
            const float og0 = ldproj(P, b, s, C_OG + h * 128 + lane), og1 = ldproj(P, b, s, C_OG + h * 128 + lane + 64);
            oab[row * KUP + h * 128 + lane] = f2bf(o0 * rstd * g0 * sigmoidf_(og0));
            oab[row * KUP + h * 128 + lane + 64] = f2bf(o1 * rstd * g1 * sigmoidf_(og1)); }
    }
}

__device__ void lru_simple(const Params& P, LAS unsigned char* lds, int unit) {
    constexpr int TC = 64;
    const int tid = threadIdx.x, b = unit >> 3, n = unit & 7, c = tid & 127, tq = tid >> 7, ch = n * 128 + c;
    LAS float* xin = (LAS float*)lds;
    LAS float* xc = xin + (TC + 3) * 128;
    LAS float* ab = xc + TC * 128;
    LAS float* ub = ab + TC * 128;
    bf16_t* oab = (bf16_t*)P.out;
    const float cw0 = P.conv_w[0 * D + ch], cw1 = P.conv_w[1 * D + ch], cw2 = P.conv_w[2 * D + ch], cw3 = P.conv_w[3 * D + ch], cb = P.conv_b[ch];
    const float br = P.b_r[ch], bi = P.b_i[ch];
    const float lamv = P.lam[ch]; const float sp = (lamv > 15.f) ? __expf(-lamv) : log1pf(__expf(-lamv));
    const float* wr = P.w_r + (size_t)n * 128 * 128; const float* wi = P.w_i + (size_t)n * 128 * 128;
    float hcar = 0.f;
    for (int c0 = 0; c0 < TSEQ; c0 += TC) {
        const int len = (TSEQ - c0) < TC ? (TSEQ - c0) : TC;
        __syncthreads();
        for (int idx = tid; idx < (len + 3) * 128; idx += NTHREADS) { const int t = idx >> 7, cc = idx & 127, s = c0 + t - 3;
            xin[idx] = (s >= 0) ? ldproj(P, b, s, C_LX + n * 128 + cc) : 0.f; }
        __syncthreads();
        for (int t = tq; t < len; t += 4) xc[t * 128 + c] = cw0 * xin[t * 128 + c] + cw1 * xin[(t + 1) * 128 + c] + cw2 * xin[(t + 2) * 128 + c] + cw3 * xin[(t + 3) * 128 + c] + cb;
        __syncthreads();
        { float ra[16], ia[16];
#pragma unroll
          for (int j = 0; j < 16; ++j) { ra[j] = 0.f; ia[j] = 0.f; }
          for (int i4 = 0; i4 < 128; i4 += 4) { float w_r4[4], w_i4[4];
#pragma unroll
              for (int q = 0; q < 4; ++q) { w_r4[q] = wr[(size_t)(i4 + q) * 128 + c]; w_i4[q] = wi[(size_t)(i4 + q) * 128 + c]; }
#pragma unroll
              for (int j = 0; j < 16; ++j) { const f32x4 xv = *(const LAS f32x4*)(xc + (tq * 16 + j) * 128 + i4);
#pragma unroll
                  for (int q = 0; q < 4; ++q) { ra[j] += xv[q] * w_r4[q]; ia[j] += xv[q] * w_i4[q]; } } }
#pragma unroll
          for (int j = 0; j < 16; ++j) { const int t = tq * 16 + j; const float r = sigmoidf_(ra[j] + br), ig = sigmoidf_(ia[j] + bi);
              const float log_a = -8.0f * r * sp; const float a = __expf(log_a); const float u = sqrtf(-expm1f(2.0f * log_a)) * (ig * xc[t * 128 + c]);
              ab[t * 128 + c] = a; ub[t * 128 + c] = u; } }
        __syncthreads();
        if (tid < 128) { float hh = hcar; for (int t = 0; t < len; ++t) { hh = ab[t * 128 + c] * hh + ub[t * 128 + c]; ub[t * 128 + c] = hh; } hcar = hh; }
        __syncthreads();
        for (int idx = tid; idx < len * 128; idx += NTHREADS) { const int t = idx >> 7, cc = idx & 127, s = c0 + t; if (s < NMETA) continue;
            const float y = ldproj(P, b, s, C_LY + n * 128 + cc);
            oab[((size_t)b * SEQ + (s - NMETA)) * KUP + 512 + n * 128 + cc] = f2bf(ub[idx] * gelu_tanh(y)); }
    }
}


#define BAR_LDS() do { asm volatile("s_waitcnt lgkmcnt(0)" ::: "memory"); __builtin_amdgcn_s_barrier(); asm volatile("" ::: "memory"); } while (0)

constexpr int LT = 272;
__device__ __forceinline__ const bf16_t* seq_row(const Params& P, int b, int c, int t) {
    return c == 0 ? (const bf16_t*)(P.ws + WS_METAT) + (size_t)t * DIN : (const bf16_t*)(P.ws + WS_PROJ) + ((size_t)b * SEQ + (size_t)(c - 1) * 64 + t) * DIN;
}
__device__ __forceinline__ float bflo(unsigned w) { return __uint_as_float(w << 16); }
__device__ __forceinline__ float bfhi(unsigned w) { return __uint_as_float(w & 0xffff0000u); }

__device__ void lru_fast(const Params& P, LAS unsigned char* lds, int unit) {
    const int tid = threadIdx.x, wid = __builtin_amdgcn_readfirstlane(tid >> 6), lane = tid & 63, b = unit >> 3, n = unit & 7, fr = lane & 15, g = lane >> 4;
    constexpr int TP = 136;
    constexpr int XA_B = 64 * LT, CT_B = 128 * TP, SET_B = XA_B + 3 * CT_B;
    static_assert(2 * SET_B <= 140 * 1024, "LRU tiles exceed the LDS budget");
    bf16_t* oab = (bf16_t*)P.out;
    bf16x8 Br[4], Bi[4];
    { const float* wr = P.w_r + (size_t)n * 128 * 128 + wid * 16 + fr; const float* wi = P.w_i + (size_t)n * 128 * 128 + wid * 16 + fr;
#pragma unroll
      for (int ks = 0; ks < 4; ++ks) { unsigned pr[4], pi[4];
#pragma unroll
          for (int j = 0; j < 4; ++j) { const int i0 = 32 * ks + 8 * g + 2 * j;
              pr[j] = cvt_pk_bf16(wr[(size_t)i0 * 128], wr[(size_t)(i0 + 1) * 128]); pi[j] = cvt_pk_bf16(wi[(size_t)i0 * 128], wi[(size_t)(i0 + 1) * 128]); }
          u32x4 tr = {pr[0], pr[1], pr[2], pr[3]}, ti = {pi[0], pi[1], pi[2], pi[3]};
          Br[ks] = __builtin_bit_cast(bf16x8, tr); Bi[ks] = __builtin_bit_cast(bf16x8, ti); } }
    const int chg = n * 128 + wid * 16 + fr;
    const float LOG2E = 1.4426950408889634f;
    const float nbr = -P.b_r[chg] * LOG2E, nbi = -P.b_i[chg] * LOG2E;
    const float lamv = P.lam[chg]; const float c2 = -8.0f * LOG2E * ((lamv > 15.f) ? __expf(-lamv) : log1pf(__expf(-lamv)));
    const int chc = n * 128 + 2 * lane;
    const f32x2 cw0 = *(const f32x2*)(P.conv_w + 0 * D + chc), cw1 = *(const f32x2*)(P.conv_w + 1 * D + chc), cw2 = *(const f32x2*)(P.conv_w + 2 * D + chc), cw3 = *(const f32x2*)(P.conv_w + 3 * D + chc),
                cbv = *(const f32x2*)(P.conv_b + chc);
    float carry = 0.f;
    unsigned xl[11], yl[8];
    unsigned lxo = (unsigned)(C_LX + n * 128 + 2 * lane) * 2u, lyo = (unsigned)(C_LY + n * 128 + 2 * lane) * 2u;
#define LRU_PREFETCH(c) do { const char* r0 = (const char*)seq_row(P, b, (c), wid * 8);        \
        _Pragma("unroll") for (int q = 0; q < 8; ++q) { xl[3 + q] = *(const unsigned*)(r0 + (lxo + (unsigned)q * (DIN * 2u))); yl[q] = *(const unsigned*)(r0 + (lyo + (unsigned)q * (DIN * 2u))); } \
        if (wid > 0) { const char* rm = r0 - 3 * (DIN * 2); _Pragma("unroll") for (int q = 0; q < 3; ++q) xl[q] = *(const unsigned*)(rm + (lxo + (unsigned)q * (DIN * 2u))); } \
        else if ((c) > 0) { const char* rh = (const char*)seq_row(P, b, (c) - 1, 61); _Pragma("unroll") for (int q = 0; q < 3; ++q) xl[q] = *(const unsigned*)(rh + (lxo + (unsigned)q * (DIN * 2u))); } \
        else { xl[0] = 0u; xl[1] = 0u; xl[2] = 0u; } } while (0)
    BAR_LDS();
    LRU_PREFETCH(0);
    { LAS unsigned char* XAw = lds; LAS unsigned char* XTw = XAw + XA_B; LAS unsigned char* YTw = XTw + CT_B;
        { f32x2 xv[11];
#pragma unroll
          for (int q = 0; q < 11; ++q) xv[q] = (f32x2){bflo(xl[q]), bfhi(xl[q])};
          unsigned xp[8];
#pragma unroll
          for (int q = 0; q < 8; ++q) { const f32x2 v = cw0 * xv[q] + cw1 * xv[q + 1] + cw2 * xv[q + 2] + cw3 * xv[q + 3] + cbv; xp[q] = cvt_pk_bf16(v[0], v[1]);
              *(LAS unsigned*)(XAw + (wid * 8 + q) * LT + lane * 4) = xp[q]; }
          u32x4 x0, x1, y0, y1;
          x0.x = __builtin_amdgcn_perm(xp[1], xp[0], 0x05040100u); x0.y = __builtin_amdgcn_perm(xp[3], xp[2], 0x05040100u); x0.z = __builtin_amdgcn_perm(xp[5], xp[4], 0x05040100u); x0.w = __builtin_amdgcn_perm(xp[7], xp[6], 0x05040100u);
          x1.x = __builtin_amdgcn_perm(xp[1], xp[0], 0x07060302u); x1.y = __builtin_amdgcn_perm(xp[3], xp[2], 0x07060302u); x1.z = __builtin_amdgcn_perm(xp[5], xp[4], 0x07060302u); x1.w = __builtin_amdgcn_perm(xp[7], xp[6], 0x07060302u);
          y0.x = __builtin_amdgcn_perm(yl[1], yl[0], 0x05040100u); y0.y = __builtin_amdgcn_perm(yl[3], yl[2], 0x05040100u); y0.z = __builtin_amdgcn_perm(yl[5], yl[4], 0x05040100u); y0.w = __builtin_amdgcn_perm(yl[7], yl[6], 0x05040100u);
          y1.x = __builtin_amdgcn_perm(yl[1], yl[0], 0x07060302u); y1.y = __builtin_amdgcn_perm(yl[3], yl[2], 0x07060302u); y1.z = __builtin_amdgcn_perm(yl[5], yl[4], 0x07060302u); y1.w = __builtin_amdgcn_perm(yl[7], yl[6], 0x07060302u);
          *(LAS u32x2*)(XTw + (2 * lane) * TP + wid * 16) = (u32x2){x0.x, x0.y}; *(LAS u32x2*)(XTw + (2 * lane) * TP + wid * 16 + 8) = (u32x2){x0.z, x0.w};
          *(LAS u32x2*)(XTw + (2 * lane + 1) * TP + wid * 16) = (u32x2){x1.x, x1.y}; *(LAS u32x2*)(XTw + (2 * lane + 1) * TP + wid * 16 + 8) = (u32x2){x1.z, x1.w};
          *(LAS u32x2*)(YTw + (2 * lane) * TP + wid * 16) = (u32x2){y0.x, y0.y}; *(LAS u32x2*)(YTw + (2 * lane) * TP + wid * 16 + 8) = (u32x2){y0.z, y0.w};
          *(LAS u32x2*)(YTw + (2 * lane + 1) * TP + wid * 16) = (u32x2){y1.x, y1.y}; *(LAS u32x2*)(YTw + (2 * lane + 1) * TP + wid * 16 + 8) = (u32x2){y1.z, y1.w}; }
    }
    LRU_PREFETCH(1);
    BAR_LDS();
    for (int c = 0; c < 33; ++c) {
        asm volatile("" : "+v"(lxo), "+v"(lyo));
        LAS unsigned char* XAr = lds + (c & 1) * SET_B; LAS unsigned char* XTr = XAr + XA_B; LAS unsigned char* YTr = XTr + CT_B; LAS unsigned char* OTr = YTr + CT_B;
        if (c + 1 < 33) { LAS unsigned char* XAw = lds + ((c + 1) & 1) * SET_B; LAS unsigned char* XTw = XAw + XA_B; LAS unsigned char* YTw = XTw + CT_B;
        { f32x2 xv[11];
#pragma unroll
          for (int q = 0; q < 11; ++q) xv[q] = (f32x2){bflo(xl[q]), bfhi(xl[q])};
          unsigned xp[8];
#pragma unroll
          for (int q = 0; q < 8; ++q) { const f32x2 v = cw0 * xv[q] + cw1 * xv[q + 1] + cw2 * xv[q + 2] + cw3 * xv[q + 3] + cbv; xp[q] = cvt_pk_bf16(v[0], v[1]);
              *(LAS unsigned*)(XAw + (wid * 8 + q) * LT + lane * 4) = xp[q]; }
          u32x4 x0, x1, y0, y1;
          x0.x = __builtin_amdgcn_perm(xp[1], xp[0], 0x05040100u); x0.y = __builtin_amdgcn_perm(xp[3], xp[2], 0x05040100u); x0.z = __builtin_amdgcn_perm(xp[5], xp[4], 0x05040100u); x0.w = __builtin_amdgcn_perm(xp[7], xp[6], 0x05040100u);
          x1.x = __builtin_amdgcn_perm(xp[1], xp[0], 0x07060302u); x1.y = __builtin_amdgcn_perm(xp[3], xp[2], 0x07060302u); x1.z = __builtin_amdgcn_perm(xp[5], xp[4], 0x07060302u); x1.w = __builtin_amdgcn_perm(xp[7], xp[6], 0x07060302u);
          y0.x = __builtin_amdgcn_perm(yl[1], yl[0], 0x05040100u); y0.y = __builtin_amdgcn_perm(yl[3], yl[2], 0x05040100u); y0.z = __builtin_amdgcn_perm(yl[5], yl[4], 0x05040100u); y0.w = __builtin_amdgcn_perm(yl[7], yl[6], 0x05040100u);
          y1.x = __builtin_amdgcn_perm(yl[1], yl[0], 0x07060302u); y1.y = __builtin_amdgcn_perm(yl[3], yl[2], 0x07060302u); y1.z = __builtin_amdgcn_perm(yl[5], yl[4], 0x07060302u); y1.w = __builtin_amdgcn_perm(yl[7], yl[6], 0x07060302u);
          *(LAS u32x2*)(XTw + (2 * lane) * TP + wid * 16) = (u32x2){x0.x, x0.y}; *(LAS u32x2*)(XTw + (2 * lane) * TP + wid * 16 + 8) = (u32x2){x0.z, x0.w};
          *(LAS u32x2*)(XTw + (2 * lane + 1) * TP + wid * 16) = (u32x2){x1.x, x1.y}; *(LAS u32x2*)(XTw + (2 * lane + 1) * TP + wid * 16 + 8) = (u32x2){x1.z, x1.w};
          *(LAS u32x2*)(YTw + (2 * lane) * TP + wid * 16) = (u32x2){y0.x, y0.y}; *(LAS u32x2*)(YTw + (2 * lane) * TP + wid * 16 + 8) = (u32x2){y0.z, y0.w};
          *(LAS u32x2*)(YTw + (2 * lane + 1) * TP + wid * 16) = (u32x2){y1.x, y1.y}; *(LAS u32x2*)(YTw + (2 * lane + 1) * TP + wid * 16 + 8) = (u32x2){y1.z, y1.w}; }
            if (c + 2 < 33) LRU_PREFETCH(c + 2); }
        {
            f32x4 ar[4], ai[4];
#pragma unroll
            for (int m = 0; m < 4; ++m) { ar[m] = (f32x4){0.f, 0.f, 0.f, 0.f}; ai[m] = (f32x4){0.f, 0.f, 0.f, 0.f}; }
#pragma unroll
            for (int ks = 0; ks < 4; ++ks)
#pragma unroll
                for (int m = 0; m < 4; ++m) { const bf16x8 af = *(const LAS bf16x8*)(XAr + (16 * (fr >> 2) + 4 * m + (fr & 3)) * LT + ks * 64 + g * 16);
                    ar[m] = __builtin_amdgcn_mfma_f32_16x16x32_bf16(af, Br[ks], ar[m], 0, 0, 0); ai[m] = __builtin_amdgcn_mfma_f32_16x16x32_bf16(af, Bi[ks], ai[m], 0, 0, 0); }
            f32x2 a2[4][2], u2[4][2], yg2[4][2];
#pragma unroll
            for (int m = 0; m < 4; ++m) {
                const u32x2 xw = *(const LAS u32x2*)(XTr + (wid * 16 + fr) * TP + (16 * g + 4 * m) * 2), yw = *(const LAS u32x2*)(YTr + (wid * 16 + fr) * TP + (16 * g + 4 * m) * 2);
#pragma unroll
                for (int p = 0; p < 2; ++p) {
                    const unsigned xwp = p ? xw.y : xw.x, ywp = p ? yw.y : yw.x;
                    const f32x2 xc = {bflo(xwp), bfhi(xwp)}, y = {bflo(ywp), bfhi(ywp)};
                    const f32x2 tr = (f32x2){ar[m][2 * p], ar[m][2 * p + 1]} * (-LOG2E) + nbr, ti = (f32x2){ai[m][2 * p], ai[m][2 * p + 1]} * (-LOG2E) + nbi;
                    f32x2 z = y * y; z = z * 0.044715f + 1.0f; z = z * y; z = z * (-2.0f * 0.7978845608028654f * LOG2E);
                    f32x2 er, ei, eg;
                    er[0] = __builtin_amdgcn_exp2f(fminf(tr[0], 40.f)); er[1] = __builtin_amdgcn_exp2f(fminf(tr[1], 40.f));
                    ei[0] = __builtin_amdgcn_exp2f(fminf(ti[0], 40.f)); ei[1] = __builtin_amdgcn_exp2f(fminf(ti[1], 40.f));
                    eg[0] = __builtin_amdgcn_exp2f(fminf(z[0], 40.f)); eg[1] = __builtin_amdgcn_exp2f(fminf(z[1], 40.f));
                    const f32x2 dr = er + 1.0f, di = ei + 1.0f, dg = eg + 1.0f;
                    const f32x2 pd = dr * di, pr = pd * dg;
                    f32x2 inv; inv[0] = __builtin_amdgcn_rcpf(pr[0]); inv[1] = __builtin_amdgcn_rcpf(pr[1]);
                    const f32x2 t1 = inv * dg, r = t1 * di, ig = t1 * dr, sg = inv * pd;
                    const f32x2 ea = r * c2;
                    f32x2 av; av[0] = __builtin_amdgcn_exp2f(ea[0]); av[1] = __builtin_amdgcn_exp2f(ea[1]);
                    const f32x2 om = 1.0f - av * av;
                    f32x2 sq; sq[0] = __builtin_amdgcn_sqrtf(fmaxf(om[0], 0.f)); sq[1] = __builtin_amdgcn_sqrtf(fmaxf(om[1], 0.f));
                    a2[m][p] = av; u2[m][p] = sq * (ig * xc); yg2[m][p] = y * sg; } }
            if (c == 0 && g < 3) {
#pragma unroll
                for (int m = 0; m < 4; ++m)
#pragma unroll
                    for (int p = 0; p < 2; ++p) { a2[m][p] = (f32x2){1.0f, 1.0f}; u2[m][p] = (f32x2){0.f, 0.f}; } }
            float A16 = 1.0f, U16 = 0.f;
#pragma unroll
            for (int m = 0; m < 4; ++m)
#pragma unroll
                for (int p = 0; p < 2; ++p) { U16 = a2[m][p][0] * U16 + u2[m][p][0]; A16 *= a2[m][p][0]; U16 = a2[m][p][1] * U16 + u2[m][p][1]; A16 *= a2[m][p][1]; }
            float H = carry, Hm = carry;
#pragma unroll
            for (int gg = 0; gg < 4; ++gg) { const float Ag = __shfl(A16, fr + 16 * gg), Ug = __shfl(U16, fr + 16 * gg); if (gg == g) Hm = H; H = Ag * H + Ug; }
            carry = H;
            float h = Hm;
#pragma unroll
            for (int m = 0; m < 4; ++m) {
                const float h0 = a2[m][0][0] * h + u2[m][0][0], h1 = a2[m][0][1] * h0 + u2[m][0][1], h2 = a2[m][1][0] * h1 + u2[m][1][0], h3 = a2[m][1][1] * h2 + u2[m][1][1]; h = h3;
                *(LAS u32x2*)(OTr + (wid * 16 + fr) * TP + (16 * g + 4 * m) * 2) = (u32x2){cvt_pk_bf16(h0 * yg2[m][0][0], h1 * yg2[m][0][1]), cvt_pk_bf16(h2 * yg2[m][1][0], h3 * yg2[m][1][1])}; }
        }
        BAR_LDS();
        if (c > 0) {
            const u32x2 o0a = *(const LAS u32x2*)(OTr + (2 * lane) * TP + wid * 16), o0b = *(const LAS u32x2*)(OTr + (2 * lane) * TP + wid * 16 + 8);
            const u32x2 o1a = *(const LAS u32x2*)(OTr + (2 * lane + 1) * TP + wid * 16), o1b = *(const LAS u32x2*)(OTr + (2 * lane + 1) * TP + wid * 16 + 8);
            const u32x4 o0 = {o0a.x, o0a.y, o0b.x, o0b.y}, o1 = {o1a.x, o1a.y, o1b.x, o1b.y};
            bf16_t* op = oab + ((size_t)b * SEQ + (size_t)(c - 1) * 64 + wid * 8) * KUP + 512 + n * 128 + 2 * lane;
            *(unsigned*)(op + 0 * KUP) = __builtin_amdgcn_perm(o1.x, o0.x, 0x05040100u); *(unsigned*)(op + 1 * KUP) = __builtin_amdgcn_perm(o1.x, o0.x, 0x07060302u);
            *(unsigned*)(op + 2 * KUP) = __builtin_amdgcn_perm(o1.y, o0.y, 0x05040100u); *(unsigned*)(op + 3 * KUP) = __builtin_amdgcn_perm(o1.y, o0.y, 0x07060302u);
            *(unsigned*)(op + 4 * KUP) = __builtin_amdgcn_perm(o1.z, o0.z, 0x05040100u); *(unsigned*)(op + 5 * KUP) = __builtin_amdgcn_perm(o1.z, o0.z, 0x07060302u);
            *(unsigned*)(op + 6 * KUP) = __builtin_amdgcn_perm(o1.w, o0.w, 0x05040100u); *(unsigned*)(op + 7 * KUP) = __builtin_amdgcn_perm(o1.w, o0.w, 0x07060302u); }
    }
#undef LRU_PREFETCH
}

constexpr int KEP = 144;
__device__ void hgrn_fast(const Params& P, LAS unsigned char* lds, int unit) {
    const int tid = threadIdx.x, wid = __builtin_amdgcn_readfirstlane(tid >> 6), lane = tid & 63, b = unit >> 2, h = unit & 3, fr = lane & 15, g = lane >> 4;
    LAS unsigned char* QG = lds;
    LAS unsigned char* KG = QG + 64 * LT;
    LAS unsigned char* VT = KG + 64 * LT;
    LAS unsigned char* KE = VT + 64 * LT;
    LAS unsigned char* PT = KE + 128 * KEP;
    LAS float* DEC = (LAS float*)(PT + 64 * KEP);
    LAS float* SEG = DEC + 128;
    LAS float* PART = SEG + 8 * 128;
    LAS unsigned char* OGT = (LAS unsigned char*)(PART + 64 * 8);
    LAS unsigned char* OUT = OGT + 64 * LT;
    bf16_t* oab = (bf16_t*)P.out;
    const float LOG2E = 1.4426950408889634f;
    const float* lbp = (const float*)(P.ws + WS_LB) + h * 128 + 2 * lane;
    const float lb0 = lbp[0], lb1 = lbp[1], om0 = 1.0f - lb0, om1 = 1.0f - lb1;
    int pos; { const int d = 2 * lane, kd = d >> 5, r = d & 31; pos = 32 * kd + 8 * ((r >> 2) & 3) + 4 * (r >> 4) + (r & 3); }
    const f32x4 ng = *(const f32x4*)(P.hg_norm_g + h * 128 + wid * 16 + 4 * g);
    f32x4 S[8];
#pragma unroll
    for (int db = 0; db < 8; ++db) S[db] = (f32x4){0.f, 0.f, 0.f, 0.f};
    unsigned qv[8], fv[8]; u32x4 vv[2], gv[2];
    unsigned hqo = (unsigned)(C_Q + h * 128 + 2 * lane) * 2u, hfo = (unsigned)(C_F + h * 128 + 2 * lane) * 2u;
    unsigned hvo = (unsigned)(C_I + h * 128 + (lane & 15) * 8) * 2u, hoo = (unsigned)(C_OG + h * 128 + (lane & 15) * 8) * 2u;
#define HG_PREFETCH(c) do { const char* r0 = (const char*)seq_row(P, b, (c), wid * 8); \
        _Pragma("unroll") for (int q = 0; q < 8; ++q) { qv[q] = *(const unsigned*)(r0 + (hqo + (unsigned)q * (DIN * 2u))); fv[q] = *(const unsigned*)(r0 + (hfo + (unsigned)q * (DIN * 2u))); } \
        const char* rv = (const char*)seq_row(P, b, (c), wid * 4); \
        _Pragma("unroll") for (int i = 0; i < 2; ++i) { vv[i] = *(const u32x4*)(rv + (hvo + (unsigned)(32 * i + (lane >> 4)) * (DIN * 2u))); gv[i] = *(const u32x4*)(rv + (hoo + (unsigned)(32 * i + (lane >> 4)) * (DIN * 2u))); } } while (0)
    BAR_LDS();
    HG_PREFETCH(0);
    for (int c = 0; c < 33; ++c) {
        asm volatile("" : "+v"(hqo), "+v"(hfo), "+v"(hvo), "+v"(hoo));
        float k0[8], k1[8], c0[8], c1[8];
        { float p0 = 1.0f, p1 = 1.0f;
#pragma unroll
          for (int q = 0; q < 8; ++q) { const float x0 = bflo(fv[q]), x1 = bfhi(fv[q]);
              const float e0 = __builtin_amdgcn_exp2f(fminf(-LOG2E * x0, 80.f)), e1 = __builtin_amdgcn_exp2f(fminf(-LOG2E * x1, 80.f));
              const float r0 = __builtin_amdgcn_rcpf(1.0f + e0), r1 = __builtin_amdgcn_rcpf(1.0f + e1);
              const float f0 = lb0 + om0 * r0, f1 = lb1 + om1 * r1;
              k0[q] = om0 * e0 * r0; k1[q] = om1 * e1 * r1;
              p0 *= f0; p1 *= f1; c0[q] = p0; c1[q] = p1; }
          *(LAS f32x2*)(SEG + wid * 128 + 2 * lane) = (f32x2){p0, p1}; }
        BAR_LDS();
        { float pre0 = 1.0f, pre1 = 1.0f, tot0 = 1.0f, tot1 = 1.0f;
#pragma unroll
          for (int w2 = 0; w2 < 8; ++w2) { const f32x2 sv = *(const LAS f32x2*)(SEG + w2 * 128 + 2 * lane); if (w2 < wid) { pre0 *= sv[0]; pre1 *= sv[1]; } tot0 *= sv[0]; tot1 *= sv[1]; }
          unsigned ke0[4], ke1[4]; float keb0 = 0.f, keb1 = 0.f;
#pragma unroll
          for (int q = 0; q < 8; ++q) { const float G0 = pre0 * c0[q], G1 = pre1 * c1[q];
              const float rg0 = __builtin_amdgcn_rcpf(G0), rg1 = __builtin_amdgcn_rcpf(G1);
              const float kg0 = k0[q] * rg0, kg1 = k1[q] * rg1;
              const int t = wid * 8 + q;
              *(LAS unsigned*)(QG + t * LT + pos * 2) = cvt_pk_bf16(bflo(qv[q]) * G0, bfhi(qv[q]) * G1);
              *(LAS unsigned*)(KG + t * LT + pos * 2) = cvt_pk_bf16(kg0, kg1);
              const float e0 = kg0 * tot0, e1 = kg1 * tot1;
              if (q & 1) { ke0[q >> 1] = cvt_pk_bf16(keb0, e0); ke1[q >> 1] = cvt_pk_bf16(keb1, e1); } else { keb0 = e0; keb1 = e1; } }
          *(LAS u32x4*)(KE + (2 * lane) * KEP + wid * 16) = (u32x4){ke0[0], ke0[1], ke0[2], ke0[3]};
          *(LAS u32x4*)(KE + (2 * lane + 1) * KEP + wid * 16) = (u32x4){ke1[0], ke1[1], ke1[2], ke1[3]};
          if (wid == 0) *(LAS f32x2*)(DEC + 2 * lane) = (f32x2){tot0, tot1};
#pragma unroll
          for (int i = 0; i < 2; ++i) { const int p = tid + NTHREADS * i; *(LAS u32x4*)(VT + (p >> 4) * LT + (p & 15) * 16) = vv[i]; *(LAS u32x4*)(OGT + (p >> 4) * LT + (p & 15) * 16) = gv[i];
              if (c >= 2) { const u32x4 ov4 = *(const LAS u32x4*)(OUT + (p >> 4) * LT + (p & 15) * 16);
                  *(u32x4*)(oab + ((size_t)b * SEQ + (size_t)(c - 2) * 64 + (p >> 4)) * KUP + h * 128 + (p & 15) * 8) = ov4; } } }
        BAR_LDS();
        if (c + 1 < 33) HG_PREFETCH(c + 1);
        if (c > 0) {
            const int tb = wid >> 1;
#pragma unroll
            for (int s2 = 0; s2 < 2; ++s2) { const int sb = 2 * (wid & 1) + s2; f32x4 pt = {0.f, 0.f, 0.f, 0.f};
#pragma unroll
                for (int kd = 0; kd < 4; ++kd) { const bf16x8 kf = *(const LAS bf16x8*)(KG + (16 * sb + fr) * LT + kd * 64 + g * 16), qf = *(const LAS bf16x8*)(QG + (16 * tb + fr) * LT + kd * 64 + g * 16);
                    pt = __builtin_amdgcn_mfma_f32_16x16x32_bf16(kf, qf, pt, 0, 0, 0); }
                const int tg = 16 * tb + fr, sg0 = 16 * sb + 4 * g;
                const float m0 = (sg0 + 0 <= tg) ? pt[0] : 0.f, m1 = (sg0 + 1 <= tg) ? pt[1] : 0.f, m2 = (sg0 + 2 <= tg) ? pt[2] : 0.f, m3 = (sg0 + 3 <= tg) ? pt[3] : 0.f;
                *(LAS u32x2*)(PT + tg * KEP + sg0 * 2) = (u32x2){cvt_pk_bf16(m0, m1), cvt_pk_bf16(m2, m3)}; } }
        BAR_LDS();
        bf16x8 Vf[2];
#pragma unroll
        for (int ks = 0; ks < 2; ++ks) { unsigned w4[4];
#pragma unroll
            for (int j = 0; j < 4; ++j) { const int s0 = 32 * ks + 8 * g + 2 * j;
                const unsigned lo = *(const LAS bf16_t*)(VT + s0 * LT + (wid * 16 + fr) * 2), hi = *(const LAS bf16_t*)(VT + (s0 + 1) * LT + (wid * 16 + fr) * 2);
                w4[j] = lo | (hi << 16); }
            u32x4 tv = {w4[0], w4[1], w4[2], w4[3]}; Vf[ks] = __builtin_bit_cast(bf16x8, tv); }
        f32x4 ov[4];
        if (c > 0) {
            bf16x8 Sf[4];
#pragma unroll
            for (int kd = 0; kd < 4; ++kd) { u32x4 tv = {cvt_pk_bf16(S[2 * kd][0], S[2 * kd][1]), cvt_pk_bf16(S[2 * kd][2], S[2 * kd][3]), cvt_pk_bf16(S[2 * kd + 1][0], S[2 * kd + 1][1]), cvt_pk_bf16(S[2 * kd + 1][2], S[2 * kd + 1][3])};
                Sf[kd] = __builtin_bit_cast(bf16x8, tv); }
#pragma unroll
            for (int m = 0; m < 4; ++m) { f32x4 o = {0.f, 0.f, 0.f, 0.f};
#pragma unroll
                for (int ks = 0; ks < 2; ++ks) { const bf16x8 pf = *(const LAS bf16x8*)(PT + (16 * m + fr) * KEP + ks * 64 + g * 16); o = __builtin_amdgcn_mfma_f32_16x16x32_bf16(Vf[ks], pf, o, 0, 0, 0); }
#pragma unroll
                for (int kd = 0; kd < 4; ++kd) { const bf16x8 qf = *(const LAS bf16x8*)(QG + (16 * m + fr) * LT + kd * 64 + g * 16); o = __builtin_amdgcn_mfma_f32_16x16x32_bf16(Sf[kd], qf, o, 0, 0, 0); }
                ov[m] = o; } }
#pragma unroll
        for (int db = 0; db < 8; ++db) { const f32x4 dc = *(const LAS f32x4*)(DEC + 16 * db + 4 * g); f32x4 sa = S[db] * dc;
#pragma unroll
            for (int ks = 0; ks < 2; ++ks) { const bf16x8 kf = *(const LAS bf16x8*)(KE + (16 * db + fr) * KEP + ks * 64 + g * 16); sa = __builtin_amdgcn_mfma_f32_16x16x32_bf16(kf, Vf[ks], sa, 0, 0, 0); }
            S[db] = sa; }
        if (c > 0) {
#pragma unroll
            for (int m = 0; m < 4; ++m) { float pq = ov[m][0] * ov[m][0] + ov[m][1] * ov[m][1] + ov[m][2] * ov[m][2] + ov[m][3] * ov[m][3];
                pq += __shfl_xor(pq, 16); pq += __shfl_xor(pq, 32);
                if (g == 0) PART[(16 * m + fr) * 8 + wid] = pq; } }
        BAR_LDS();
        if (c > 0) {
#pragma unroll
            for (int m = 0; m < 4; ++m) { const f32x4 pa = *(const LAS f32x4*)(PART + (16 * m + fr) * 8), pb = *(const LAS f32x4*)(PART + (16 * m + fr) * 8 + 4);
                const float ss = ((pa[0] + pa[1]) + (pa[2] + pa[3])) + ((pb[0] + pb[1]) + (pb[2] + pb[3]));
                const float rstd = rsqrtf(ss * (1.0f / 128.0f) + EPS);
                const u32x2 ogw = *(const LAS u32x2*)(OGT + (16 * m + fr) * LT + (wid * 16 + 4 * g) * 2);
                const float g0 = bflo(ogw.x), g1 = bfhi(ogw.x), g2 = bflo(ogw.y), g3 = bfhi(ogw.y);
                const float o0 = ov[m][0] * rstd * ng[0] * __builtin_amdgcn_rcpf(1.0f + __builtin_amdgcn_exp2f(-LOG2E * g0));
                const float o1 = ov[m][1] * rstd * ng[1] * __builtin_amdgcn_rcpf(1.0f + __builtin_amdgcn_exp2f(-LOG2E * g1));
                const float o2 = ov[m][2] * rstd * ng[2] * __builtin_amdgcn_rcpf(1.0f + __builtin_amdgcn_exp2f(-LOG2E * g2));
                const float o3 = ov[m][3] * rstd * ng[3] * __builtin_amdgcn_rcpf(1.0f + __builtin_amdgcn_exp2f(-LOG2E * g3));
                *(LAS u32x2*)(OUT + (16 * m + fr) * LT + (wid * 16 + 4 * g) * 2) = (u32x2){cvt_pk_bf16(o0, o1), cvt_pk_bf16(o2, o3)}; } }
    }
    BAR_LDS();
#pragma unroll
    for (int i = 0; i < 2; ++i) { const int p = tid + NTHREADS * i; const u32x4 ov4 = *(const LAS u32x4*)(OUT + (p >> 4) * LT + (p & 15) * 16);
        *(u32x4*)(oab + ((size_t)b * SEQ + (size_t)31 * 64 + (p >> 4)) * KUP + h * 128 + (p & 15) * 8) = ov4; }
#undef HG_PREFETCH
}

__device__ void p5_router_fast(const Params& P, LAS unsigned char* lds, int bid, int nb) {
    const int tid = threadIdx.x, wid = __builtin_amdgcn_readfirstlane(tid >> 6), lane = tid & 63, fr = lane & 15, g = lane >> 4;
    unsigned char* ws = P.ws;
    const bf16_t* h2 = (const bf16_t*)(ws + WS_H2); const bf16_t* wrt = (const bf16_t*)(ws + WS_WR);
    int* counts = (int*)(ws + WS_CTL + CTL_CNT); int* ltk = (int*)(ws + WS_LTK); float* lw = (float*)(ws + WS_LW);
    LAS int* lcnt = (LAS int*)lds; LAS int* lbase = lcnt + 32; LAS int* ae = lbase + 32; LAS int* al = ae + 512; LAS float* aw = (LAS float*)(al + 512); LAS float* ars = aw + 512;
    float* lrs = (float*)(ws + WS_LRS);
    const float bg = P.b_group[g];
    float br8[8];
#pragma unroll
    for (int e = 0; e < 8; ++e) br8[e] = P.b_router[g * 8 + e];
    __syncthreads();
    for (int p = tid; p < 48 * 128; p += NTHREADS) { const int row = p >> 7, c16 = p & 127;
        *(LAS u32x4*)(lds + 12288 + row * 2064 + c16 * 16) = *(const u32x4*)(wrt + (size_t)row * D + c16 * 8); }
    for (int t0 = bid * 256; t0 < NTOK; t0 += nb * 256) {
        __syncthreads();
        if (tid < 32) lcnt[tid] = 0;
        __syncthreads();
        f32x4 acc[2][3];
#pragma unroll
        for (int tt = 0; tt < 2; ++tt)
#pragma unroll
            for (int nt = 0; nt < 3; ++nt) acc[tt][nt] = (f32x4){0.f, 0.f, 0.f, 0.f};
        const bf16_t* ap = h2 + (size_t)(t0 + wid * 32 + fr) * D + g * 8;
        LAS unsigned char* WL = lds + 12288;
        const LAS unsigned char* bl = WL + fr * 2064 + g * 16;
        float sq0 = 0.f, sq1 = 0.f;
#pragma unroll 1
        for (int k8 = 0; k8 < 32; k8 += 8) {
            bf16x8 a0[8], a1[8];
#pragma unroll
            for (int q = 0; q < 8; ++q) { a0[q] = *(const bf16x8*)(ap + (k8 + q) * 32); a1[q] = *(const bf16x8*)(ap + 16 * D + (k8 + q) * 32); }
#pragma unroll
            for (int q = 0; q < 8; ++q) { const int ks = k8 + q;
                const bf16x8 b0 = *(const LAS bf16x8*)(bl + ks * 64), b1 = *(const LAS bf16x8*)(bl + 16 * 2064 + ks * 64), b2 = *(const LAS bf16x8*)(bl + 32 * 2064 + ks * 64);
                acc[0][0] = __builtin_amdgcn_mfma_f32_16x16x32_bf16(b0, a0[q], acc[0][0], 0, 0, 0); acc[0][1] = __builtin_amdgcn_mfma_f32_16x16x32_bf16(b1, a0[q], acc[0][1], 0, 0, 0);
                acc[0][2] = __builtin_amdgcn_mfma_f32_16x16x32_bf16(b2, a0[q], acc[0][2], 0, 0, 0); acc[1][0] = __builtin_amdgcn_mfma_f32_16x16x32_bf16(b0, a1[q], acc[1][0], 0, 0, 0);
                acc[1][1] = __builtin_amdgcn_mfma_f32_16x16x32_bf16(b1, a1[q], acc[1][1], 0, 0, 0); acc[1][2] = __builtin_amdgcn_mfma_f32_16x16x32_bf16(b2, a1[q], acc[1][2], 0, 0, 0);
                { const u32x4 w0 = __builtin_bit_cast(u32x4, a0[q]), w1 = __builtin_bit_cast(u32x4, a1[q]);
#define SQ_ACC(sq, w) asm volatile("v_dot2c_f32_bf16 %0, %1, %1" : "+v"(sq) : "v"(w))
                  SQ_ACC(sq0, w0.x); SQ_ACC(sq0, w0.y); SQ_ACC(sq0, w0.z); SQ_ACC(sq0, w0.w); SQ_ACC(sq1, w1.x); SQ_ACC(sq1, w1.y); SQ_ACC(sq1, w1.z); SQ_ACC(sq1, w1.w);
#undef SQ_ACC
                } }
        }
        sq0 += __shfl_xor(sq0, 16); sq0 += __shfl_xor(sq0, 32); sq1 += __shfl_xor(sq1, 16); sq1 += __shfl_xor(sq1, 32);
#pragma unroll
        for (int tt = 0; tt < 2; ++tt) {
            const int tl = wid * 32 + tt * 16 + fr;
            const float rstd = rsqrtf((tt ? sq1 : sq0) * (1.0f / D) + EPS);
            const float mygl = acc[tt][2][0] * rstd + bg;
            float gl[4];
#pragma unroll
            for (int gg = 0; gg < 4; ++gg) gl[gg] = __shfl(mygl, fr + 16 * gg);
            int gs = 0; float gm = gl[0];
#pragma unroll
            for (int j = 1; j < 4; ++j) if (gl[j] > gm) { gm = gl[j]; gs = j; }
            float den = 0.f;
#pragma unroll
            for (int j = 0; j < 4; ++j) den += __expf(gl[j] - gm);
            const float psel = 1.0f / den;
            if (g == gs) {
                float el[8];
#pragma unroll
                for (int e = 0; e < 8; ++e) el[e] = acc[tt][e >> 2][e & 3] * rstd + br8[e];
                int i0 = 0; float v0 = el[0];
#pragma unroll
                for (int e = 1; e < 8; ++e) if (el[e] > v0) { v0 = el[e]; i0 = e; }
                int i1 = -1; float v1 = -3.0e38f;
#pragma unroll
                for (int e = 0; e < 8; ++e) if (e != i0 && el[e] > v1) { v1 = el[e]; i1 = e; }
                const float e1 = __expf(v1 - v0); const float w0 = psel / (1.0f + e1), w1 = psel * e1 / (1.0f + e1);
                const int ex0 = gs * 8 + i0, ex1 = gs * 8 + i1;
                ae[tl * 2] = ex0; al[tl * 2] = __hip_atomic_fetch_add(lcnt + ex0, 1, __ATOMIC_RELAXED, __HIP_MEMORY_SCOPE_WORKGROUP); aw[tl * 2] = w0; ars[tl * 2] = rstd * (1.0f / WGU_SCALE);
                ae[tl * 2 + 1] = ex1; al[tl * 2 + 1] = __hip_atomic_fetch_add(lcnt + ex1, 1, __ATOMIC_RELAXED, __HIP_MEMORY_SCOPE_WORKGROUP); aw[tl * 2 + 1] = w1; ars[tl * 2 + 1] = rstd * (1.0f / WGU_SCALE);
            }
        }
        __syncthreads();
        if (tid < 32) lbase[tid] = atomicAdd(counts + tid, lcnt[tid]);
        __syncthreads();
        { const int a = tid; const int e = ae[a]; const int pos = lbase[e] + al[a];
          ltk[(size_t)e * LCAP + pos] = (t0 + (a >> 1)) * 2 + (a & 1); lw[(size_t)e * LCAP + pos] = aw[a]; lrs[(size_t)e * LCAP + pos] = ars[a]; }
    }
}

__device__ void p8_final(const Params& P, int bid, int nb) {
    const int tid = threadIdx.x, wid = tid >> 6, lane = tid & 63;
    const bf16_t* h2 = (const bf16_t*)(P.ws + WS_H2); const unsigned char* yb = (const unsigned char*)(P.ws + WS_Y);
    f32x4 gq[4];
#pragma unroll
    for (int q = 0; q < 4; ++q) gq[q] = *(const f32x4*)(P.final_g + 256 * q + 4 * lane);
    for (int r0 = (bid * 8 + wid) * 4; r0 < NTOK; r0 += nb * 8 * 4) {
        u32x2 hv[4][4]; unsigned y0[4][4], y1[4][4];
#pragma unroll
        for (int rr = 0; rr < 4; ++rr) { const size_t r = (size_t)(r0 + rr);
#pragma unroll
            for (int q = 0; q < 4; ++q) { hv[rr][q] = *(const u32x2*)(h2 + r * D + 256 * q + 4 * lane);
                y0[rr][q] = *(const unsigned*)(yb + (r * 2) * D + 256 * q + 4 * lane); y1[rr][q] = *(const unsigned*)(yb + (r * 2 + 1) * D + 256 * q + 4 * lane); } }
#pragma unroll
        for (int rr = 0; rr < 4; ++rr) { f32x4 v[4]; float ss = 0.f;
#pragma unroll
            for (int q = 0; q < 4; ++q) {
                const f32x2 a01 = __builtin_amdgcn_cvt_pk_f32_fp8((int)y0[rr][q], false), a23 = __builtin_amdgcn_cvt_pk_f32_fp8((int)y0[rr][q], true), b01 = __builtin_amdgcn_cvt_pk_f32_fp8((int)y1[rr][q], false), b23 = __builtin_amdgcn_cvt_pk_f32_fp8((int)y1[rr][q], true);
                v[q][0] = bflo(hv[rr][q].x) + (a01[0] + b01[0]) * (1.0f / Y_SCALE); v[q][1] = bfhi(hv[rr][q].x) + (a01[1] + b01[1]) * (1.0f / Y_SCALE);
                v[q][2] = bflo(hv[rr][q].y) + (a23[0] + b23[0]) * (1.0f / Y_SCALE); v[q][3] = bfhi(hv[rr][q].y) + (a23[1] + b23[1]) * (1.0f / Y_SCALE);
                ss += v[q][0] * v[q][0] + v[q][1] * v[q][1] + v[q][2] * v[q][2] + v[q][3] * v[q][3]; }
            ss = wave_sum(ss); const float rstd = rsqrtf(ss * (1.0f / D) + EPS);
#pragma unroll
            for (int q = 0; q < 4; ++q) *(f32x4*)(P.out + (size_t)(r0 + rr) * D + 256 * q + 4 * lane) = v[q] * rstd * gq[q]; }
    }
}

__device__ __forceinline__ void moe_table(const Params& P, volatile LAS int* tpre) {
    if (threadIdx.x < 64) { const int lane = threadIdx.x; const int* counts = (const int*)(P.ws + WS_CTL + CTL_CNT);
        const int cnt = (lane < NE) ? counts[lane] : 0; const int nt = (cnt + 255) >> 8;
        int inc = nt;
#pragma unroll
        for (int o = 1; o < 32; o <<= 1) { const int v = __shfl_up(inc, o); if (lane >= o) inc += v; }
        if (lane < NE) { tpre[lane] = inc - nt; tpre[40 + lane] = cnt;
#pragma unroll 1
            for (int t = inc - nt; t < inc; ++t) tpre[T2E + t] = lane; }
        if (lane == NE - 1) tpre[NE] = inc; }
    __syncthreads();
}
}

__global__ void __launch_bounds__(NTHREADS, 2) fwd_kernel(Params P) {
    extern __shared__ __attribute__((aligned(16))) unsigned char lds_raw[];
    LAS unsigned char* lds = (LAS unsigned char*)lds_raw;
    const int bid = blockIdx.x, nb = gridDim.x;
    unsigned char* ws = P.ws;
    const int lo = P.ph_lo, hi = P.ph_hi;
    volatile LAS unsigned* xbw = (volatile LAS unsigned*)(lds + LDS_BYTES - 16);
    if (threadIdx.x == 0) { xbw[0] = 0u; xbw[1] = 0u; xbw[2] = 0u; xbw[3] = 0u; }
    __syncthreads();
    XcdBarrier bar; bar.bar = (unsigned*)(ws + WS_CTL + CTL_BAR); bar.x = 0; bar.st = xbw;
    if (hi - lo > 1) bar = xcd_barrier_post((unsigned*)(ws + WS_CTL + CTL_BAR), xbw);
#ifdef PROBE_MASK
    unsigned long long pr_t0 = __builtin_amdgcn_s_memrealtime();
#define SEAM(k) do { if ((PROBE_MASK >> (k)) & 1) { const unsigned long long t1 = __builtin_amdgcn_s_memrealtime(); const unsigned long long dt = t1 - pr_t0; \
        while (__builtin_amdgcn_s_memrealtime() - t1 < dt) __builtin_amdgcn_s_sleep(8); } \
        if (IN(k) && IN((k) + 1)) xcd_barrier(bar); pr_t0 = __builtin_amdgcn_s_memrealtime(); } while (0)
#else
#define SEAM(k) do { if (IN(k) && IN((k) + 1)) xcd_barrier(bar); } while (0)
#endif
#ifdef ONLY_PHASE
#define IN(k) ((k) == ONLY_PHASE && lo <= (k) && (k) < hi)
#else
#define IN(k) (lo <= (k) && (k) < hi)
#endif
    if (IN(0)) p0_prologue(P, lds, bid, nb);
    SEAM(0);
    if (IN(1)) { typedef DenseOrder<DIN / 256> DO1; DO1 S; S.init(ws + WS_HN, D * 2, ws + WS_WIN, D * 2, NTOK, DIN, nb, bid);
        EpiStoreBf16 E{(bf16_t*)(ws + WS_PROJ), DIN};
        if constexpr ((FAST_MASK >> 1) & 1) gemm_phase<EpiStoreBf16, DO1, false, 0>(lds, D * 2, D * 2, D, S, E); else gemm_simple<EpiStoreBf16, DO1, false, 0>(D * 2, D * 2, D, S, E); }
    SEAM(1);
    if (IN(2)) {
        if constexpr (((FAST_MASK >> 9) & 3) == 3) {
            volatile LAS int* shu = (volatile LAS int*)(lds + 141 * 1024);
            int* qhead = (int*)(ws + WS_CTL + CTL_CNT + 128);
            for (int u = bid;;) {
                if (u >= 128 + 256) break;
#if defined(P2_REPEAT_H)
                if (u < 128) { hgrn_fast(P, lds, u); hgrn_fast(P, lds, u); } else lru_fast(P, lds, u - 128);
#elif defined(P2_REPEAT_L)
                if (u < 128) hgrn_fast(P, lds, u); else { lru_fast(P, lds, u - 128); lru_fast(P, lds, u - 128); }
#else
                if (u < 128) hgrn_fast(P, lds, u); else lru_fast(P, lds, u - 128);
#endif
                __syncthreads();
                if (threadIdx.x == 0) shu[0] = nb + atomicAdd(qhead, 1);
                __syncthreads();
                u = __builtin_amdgcn_readfirstlane(shu[0]); }
            for (;;) {
                __syncthreads();
                if (threadIdx.x == 0) shu[0] = atomicAdd(qhead + 1, 1);
                __syncthreads();
                const int task = __builtin_amdgcn_readfirstlane(shu[0]);
                if (task >= N_CONV_TASKS) break;
                const int wv = __builtin_amdgcn_readfirstlane(threadIdx.x >> 6);
#pragma unroll 1
                for (int q = wv * (CONV_TPT / 8); q < (wv + 1) * (CONV_TPT / 8); ++q) conv_tile(P, (LAS float*)lds + wv * (64 * 65), T_EARLY + task * CONV_TPT + q); }
        } else {
            for (int u = bid; u < 128 + 256; u += nb) {
                if (u < 128) { if constexpr ((FAST_MASK >> 10) & 1) hgrn_fast(P, lds, u); else hgrn_simple(P, lds, u); }
                else { if constexpr ((FAST_MASK >> 9) & 1) lru_fast(P, lds, u - 128); else lru_simple(P, lds, u - 128); } } } }
    SEAM(2);
    if (IN(3)) { typedef DenseOrder<D / 256> DO4; DO4 S; S.init(P.out, KUP * 2, ws + WS_WUP, KUP * 2, NTOK, D, nb, bid);
        EpiMerge E{(bf16_t*)(ws + WS_PROJ), (const bf16_t*)(ws + WS_PROJ)};
        if constexpr ((FAST_MASK >> 3) & 1) gemm_phase<EpiMerge, DO4, false, 512>(lds, KUP * 2, KUP * 2, KUP, S, E); else gemm_simple<EpiMerge, DO4, false, 512>(KUP * 2, KUP * 2, KUP, S, E); }
    SEAM(3);
    if (IN(4)) { typedef DenseOrder<D / 256> DO4; DO4 S; S.init(ws + WS_PROJ, DIN * 2, ws + WS_WOUT, D * 2, NTOK, D, nb, bid);
        EpiResid E{(bf16_t*)(ws + WS_H2), (const float*)(ws + WS_RINV), (unsigned char*)P.out};
        if constexpr ((FAST_MASK >> 4) & 1) gemm_phase<EpiResid, DO4, false, 0>(lds, DIN * 2, D * 2, D, S, E); else gemm_simple<EpiResid, DO4, false, 0>(DIN * 2, D * 2, D, S, E); }
    SEAM(4);
    if (IN(5)) p5_router_fast(P, lds, bid, nb);
    SEAM(5);
    if (IN(6)) { volatile LAS int* tpre = (volatile LAS int*)(lds + 140 * 1024); __syncthreads(); moe_table(P, tpre);
        MoeOrder S; S.A = (const char*)P.out; S.B = (const char*)(ws + WS_WGU); S.ltk = (const int*)(ws + WS_LTK); S.lf = (const float*)(ws + WS_LRS); S.tpre = tpre; S.nN = 4; S.nunits = __builtin_amdgcn_readfirstlane(tpre[NE]) * 4; S.G = nb; S.c = bid;
        S.b_exp = (size_t)1024 * D; S.b_tile = (size_t)256 * D; S.a_row = D; S.gather = true;
        EpiAct E{(bf16_t*)(ws + WS_ACT), tpre};
        gemm_phase<EpiAct, MoeOrder, true, 0, true>(lds, D, D, D / 2, S, E); }
    SEAM(6);
    if (IN(7)) { volatile LAS int* tpre = (volatile LAS int*)(lds + 140 * 1024); __syncthreads(); moe_table(P, tpre);
        MoeOrder S; S.A = (const char*)(ws + WS_ACT); S.B = (const char*)(ws + WS_WD); S.ltk = (const int*)(ws + WS_LTK); S.lf = (const float*)(ws + WS_LW); S.tpre = tpre; S.nN = 4; S.nunits = __builtin_amdgcn_readfirstlane(tpre[NE]) * 4; S.G = nb; S.c = bid;
        S.b_exp = (size_t)D * DE; S.b_tile = (size_t)256 * DE; S.a_row = DE; S.gather = false;
        EpiDown E{(bf16_t*)(ws + WS_Y), tpre};
        gemm_phase<EpiDown, MoeOrder, true, 0, true>(lds, DE, DE, DE / 2, S, E); }
    SEAM(7);
    if (IN(8)) p8_final(P, bid, nb);
#ifdef PROBE_MASK
    SEAM(8);
#endif
#undef IN
#undef SEAM
}

extern "C" void kernel_launch(void* const* d_in, const int* in_sizes, int n_in, void* d_out, int out_size, void* d_ws, size_t ws_size, hipStream_t stream) {
    static int grid = 0;
    if (grid == 0) {
        if (n_in != 25 || in_sizes[0] != NTOK * D || out_size != NTOK * D || ws_size < WS_END) {
            fprintf(stderr, "kernel_launch: unexpected shapes (n_in %d, in0 %d, out %d, ws %zu < %zu); nothing launched\n", n_in, n_in > 0 ? in_sizes[0] : -1, out_size, ws_size, (size_t)WS_END); grid = -1; return; }
        int dev = 0, cus = 0;
        if (hipGetDevice(&dev) != hipSuccess || hipDeviceGetAttribute(&cus, hipDeviceAttributeMultiprocessorCount, dev) != hipSuccess) { grid = -1; return; }
        if (hipFuncSetAttribute((const void*)fwd_kernel, hipFuncAttributeMaxDynamicSharedMemorySize, LDS_BYTES) != hipSuccess) { fprintf(stderr, "kernel_launch: hipFuncSetAttribute failed\n"); grid = -1; return; }
        grid = cus;
    }
    if (grid < 0) return;
    (void)hipMemsetAsync((char*)d_ws + WS_CTL, 0, CTL_ZERO_BYTES, stream);
    Params p{};
    const float** f = (const float**)&p;
    for (int i = 0; i < 25; ++i) f[i] = (const float*)d_in[i];
    p.out = (float*)d_out; p.ws = (unsigned char*)d_ws;
#if NLAUNCH == 1
    p.ph_lo = 0; p.ph_hi = 9;
    hipLaunchKernelGGL(fwd_kernel, dim3(grid), dim3(NTHREADS), LDS_BYTES, stream, p);
#else
    for (int ph = 0; ph < 9; ++ph) { p.ph_lo = ph; p.ph_hi = ph + 1;
        hipLaunchKernelGGL(fwd_kernel, dim3(grid), dim3(NTHREADS), LDS_BYTES, stream, p); }
#endif
}
```

```cpp
#include <hip/hip_runtime.h>
#include <cstdio>
#include <cstdint>

#ifndef FAST_MASK
#define FAST_MASK 0x7ff
#endif
#ifndef NLAUNCH
#define NLAUNCH 1
#endif

#define LAS __attribute__((address_space(3)))
typedef unsigned short bf16_t;
typedef short bf16x8 __attribute__((ext_vector_type(8)));
typedef float f32x4 __attribute__((ext_vector_type(4)));
typedef float f32x2 __attribute__((ext_vector_type(2)));
typedef unsigned u32x4 __attribute__((ext_vector_type(4)));
typedef unsigned u32x2 __attribute__((ext_vector_type(2)));
typedef __bf16 bf2_t __attribute__((ext_vector_type(2)));

#define XB_TMO      128
#define XB_XCNT(j)  (256  + 64 * (j))
#define XB_XSUB(j)  (1280 + 64 * (j))
#define XB_XGEN(j)  (2304 + 64 * (j))
#define XB_TOP      3328
#define XB_TOPGEN   3392
#define XCD_BAR_WORDS 3456
#define XB_SPIN_CAP (1u << 18)

__device__ __forceinline__ unsigned xb_ld(unsigned* p)              { return __hip_atomic_load(p, __ATOMIC_RELAXED, __HIP_MEMORY_SCOPE_AGENT); }
__device__ __forceinline__ unsigned xb_add(unsigned* p, unsigned v) { return __hip_atomic_fetch_add(p, v, __ATOMIC_RELAXED, __HIP_MEMORY_SCOPE_AGENT); }
__device__ __forceinline__ unsigned xb_xcc_id() { return (unsigned)__builtin_amdgcn_s_getreg((3 << 11) | 20) & 0xFu; }
#define XB_SPIN(cond, bar) do { unsigned _sp = 0; while (cond) { __builtin_amdgcn_s_sleep(1); \
    if ((++_sp & 255u) == 0u) { if (xb_ld(&(bar)[XB_TMO])) break; if (_sp > XB_SPIN_CAP) { atomicAdd(&(bar)[XB_TMO], 1u); break; } } } } while (0)

struct XcdBarrier {
    unsigned* bar; unsigned x;
    volatile LAS unsigned* st;
};

__device__ __forceinline__ XcdBarrier xcd_barrier_post(unsigned* bar, volatile LAS unsigned* st) {
    XcdBarrier b; b.bar = bar; b.x = xb_xcc_id(); b.st = st;
    if (threadIdx.x == 0) (void)xb_add(&bar[XB_XCNT(b.x)], 1u);
    return b;
}
__device__ __forceinline__ void xcd_barrier_complete(unsigned* bar, unsigned x, unsigned& nloc, unsigned& nx) {
    const unsigned G = gridDim.x * gridDim.y * gridDim.z;
    unsigned sum, cnt, mine, sp = 0u;
    for (;;) {
        sum = 0u; cnt = 0u; mine = 0u;
#pragma unroll
        for (unsigned j = 0; j < 16; ++j) { const unsigned c = xb_ld(&bar[XB_XCNT(j)]); sum += c; cnt += (c > 0u) ? 1u : 0u; mine = (j == x) ? c : mine; }
        if (sum == G) break;
        __builtin_amdgcn_s_sleep(1);
        if ((++sp & 255u) == 0u) { if (xb_ld(&bar[XB_TMO])) break; if (sp > XB_SPIN_CAP) { atomicAdd(&bar[XB_TMO], 1u); break; } }
    }
    nloc = mine > 0u ? mine : 1u; nx = cnt > 0u ? cnt : 1u;
}

__device__ __forceinline__ void xcd_barrier(const XcdBarrier& b) {
    asm volatile("s_waitcnt vmcnt(0)" ::: "memory");
    __syncthreads();
    if (threadIdx.x == 0) {
        unsigned* bar = b.bar;
        __builtin_amdgcn_s_waitcnt(0);
        unsigned nloc = b.st[0], nx = b.st[1];
        if (nloc == 0u) { xcd_barrier_complete(bar, b.x, nloc, nx); b.st[0] = nloc; b.st[1] = nx; }
        const unsigned old = xb_add(&bar[XB_XSUB(b.x)], 1u);
        const unsigned gen = old / nloc;
        if (old + 1u == (gen + 1u) * nloc) {
            __builtin_amdgcn_fence(__ATOMIC_RELEASE, "agent");
            asm volatile("s_waitcnt vmcnt(0)" ::: "memory");
            const unsigned og = xb_add(&bar[XB_TOP], 1u);
            const unsigned tg = og / nx;
            if (og + 1u == (tg + 1u) * nx) xb_add(&bar[XB_TOPGEN], 1u);
            else XB_SPIN(xb_ld(&bar[XB_TOPGEN]) == tg, bar);
            __builtin_amdgcn_fence(__ATOMIC_ACQUIRE, "agent");
            xb_add(&bar[XB_XGEN(b.x)], 1u);
            asm volatile("s_waitcnt vmcnt(0)" ::: "memory");
        } else {
            XB_SPIN(xb_ld(&bar[XB_XGEN(b.x)]) == gen, bar);
            __builtin_amdgcn_fence(__ATOMIC_ACQUIRE, "agent");
            asm volatile("s_waitcnt vmcnt(0)" ::: "memory");
        }
    }
    __syncthreads();
}


namespace {
constexpr int NB = 32, SEQ = 2048, NMETA = 16, D = 1024, NTOK = NB * SEQ;
constexpr int TSEQ = SEQ + NMETA;
constexpr int DIN = 6144, DHG = 512, NE = 32, DE = 512;
constexpr int C_Q = 0, C_F = 512, C_I = 1024, C_OG = 1536, C_LX = 2048, C_LY = 3072, C_GA = 4096, C_GB = 5120;
constexpr int KUP = 1536;
constexpr float EPS = 1e-6f;
constexpr int NTHREADS = 512;
constexpr int LDS_BYTES = 144 * 1024;
constexpr int ACT_ROWS = 139264;
constexpr int LCAP = 65536;
constexpr float WD_SCALE = 32.0f, WGU_SCALE = 64.0f, ACT_SCALE = 8.0f, Y_SCALE = 16.0f;

constexpr size_t MiB = 1024ull * 1024ull;
constexpr size_t WS_PROJ = 0;
constexpr size_t WS_H2   = 0;
constexpr size_t WS_Y    = 128 * MiB;
constexpr size_t WS_ACT  = 384 * MiB;
constexpr size_t WS_LTK  = 520 * MiB;
constexpr size_t WS_LW   = 528 * MiB;
constexpr size_t WS_LRS  = 608 * MiB;
constexpr size_t WS_YDUMMY = 600 * MiB;
constexpr int Y_DUMMY_ROW = (int)((600 * MiB - 128 * MiB) / 1024);
constexpr size_t WS_H2Q  = 536 * MiB;
constexpr size_t WS_HN   = 768 * MiB;
constexpr size_t WS_W    = 896 * MiB;
constexpr size_t WS_WIN  = WS_W;
constexpr size_t WS_WUP  = WS_WIN + (size_t)DIN * D * 2;
constexpr size_t WS_WOUT = WS_WUP + (size_t)D * KUP * 2;
constexpr size_t WS_WGU  = WS_WOUT + (size_t)D * D * 2;
constexpr size_t WS_WD   = WS_WGU + (size_t)NE * 1024 * D * 2;
constexpr size_t WS_WR   = WS_WD + (size_t)NE * D * DE * 2;
constexpr size_t WS_CTL  = WS_WR + 128 * 1024;
constexpr size_t CTL_BAR = 0, CTL_CNT = 16384;
constexpr size_t CTL_ZERO_BYTES = 16384 + 256;
constexpr size_t WS_SSQ  = WS_CTL + 32768;
constexpr size_t WS_PROJM = WS_SSQ + (size_t)NTOK * 4;
constexpr size_t WS_LB   = WS_PROJM + (size_t)NMETA * DIN * 4;
constexpr size_t WS_METAT = WS_LB + 4096;
constexpr size_t WS_END  = WS_METAT + (size_t)64 * DIN * 2;

struct Params {
    const float *x, *meta, *norm1_g, *w_in, *hg_lb, *hg_norm_g, *conv_w, *conv_b, *w_r, *b_r, *w_i, *b_i, *lam, *w_up_a, *w_up_b, *w_out,
                *norm2_g, *w_group, *b_group, *w_router, *b_router, *w_gate, *w_up, *w_down, *final_g;
    float* out; unsigned char* ws;
    int ph_lo, ph_hi;
};

__device__ __forceinline__ float bf2f(bf16_t b) { return __uint_as_float(((unsigned)b) << 16); }
__device__ __forceinline__ unsigned cvt_pk_bf16(float lo, float hi) { unsigned r; asm volatile("v_cvt_pk_bf16_f32 %0, %1, %2" : "=v"(r) : "v"(lo), "v"(hi)); return r; }
__device__ __forceinline__ bf16_t f2bf(float f) { return (bf16_t)(cvt_pk_bf16(f, 0.f) & 0xffffu); }
__device__ __forceinline__ float sigmoidf_(float x) { return 1.0f / (1.0f + __expf(-x)); }
__device__ __forceinline__ float gelu_tanh(float y) { const float z = 0.7978845608028654f * (y + 0.044715f * y * y * y); const float t = 1.0f - 2.0f / (1.0f + __expf(2.0f * z)); return 0.5f * y * (1.0f + t); }
__device__ __forceinline__ float wave_sum(float v) {
#pragma unroll
    for (int o = 32; o > 0; o >>= 1) v += __shfl_xor(v, o);
    return v;
}
__device__ __forceinline__ unsigned pack4_fp8(float a, float b, float c, float d) {
    a = __builtin_amdgcn_fmed3f(a, -448.f, 448.f); b = __builtin_amdgcn_fmed3f(b, -448.f, 448.f); c = __builtin_amdgcn_fmed3f(c, -448.f, 448.f); d = __builtin_amdgcn_fmed3f(d, -448.f, 448.f);
    int v = __builtin_amdgcn_cvt_pk_fp8_f32(a, b, 0, false); v = __builtin_amdgcn_cvt_pk_fp8_f32(c, d, v, true); return (unsigned)v; }
__device__ __forceinline__ int perm32(int rho) { const int n = rho >> 4, i = rho & 15; return 8 * (i >> 2) + 4 * n + (i & 3); }

struct Unit { const char* A; const char* B; int pm, pn, e, cnt, tile, slot; };

__device__ __forceinline__ int xcd_remap(int L, int nwg) {
    const int q = nwg / 8, r = nwg % 8, xcd = L % 8, off = L / 8; return (xcd < r ? xcd * (q + 1) : r * (q + 1) + (xcd - r) * q) + off; }
template <int NN>
struct DenseOrder {
    const char* A; const char* B; int nunits, G, c; size_t a_tile, b_tile;
    __device__ void init(const void* A_, size_t lda_b, const void* B_, size_t ldb_b, int M, int N, int G_, int c_) {
        A = (const char*)A_; B = (const char*)B_; nunits = (M / 256) * NN; G = G_; c = c_; a_tile = 256 * lda_b; b_tile = 256 * ldb_b; }
    __device__ __forceinline__ bool next(int i, Unit& u) const {
        const int L = i * G + c; if (L >= nunits) return false;
        const int W = xcd_remap(L, nunits);
        constexpr int nig = 8 * NN; const int gid = W / nig, w = W - gid * nig;
        u.pm = gid * 8 + (w & 7); u.pn = w >> 3; u.e = 0; u.cnt = 256; u.tile = 0; u.A = A + (size_t)u.pm * a_tile; u.B = B + (size_t)u.pn * b_tile; return true; }
    __device__ __forceinline__ unsigned row_off(const Unit&, int) const { return 0u; }
};

constexpr int T2E = 128;
constexpr int LS_OFF = 136 * 1024;
struct MoeOrder {
    const char* A; const char* B; const int* ltk; const float* lf; const volatile LAS int* tpre; int nN, nunits, G, c; size_t b_exp, b_tile, a_row; bool gather;
    __device__ __forceinline__ void stage_lists(const Unit& u, LAS unsigned char* lds, int wid) const {
        const size_t base = (size_t)u.e * LCAP + (size_t)u.pm * 256; LAS unsigned char* slot = lds + LS_OFF + u.slot * 2048; const int lane = threadIdx.x & 63;
        if (wid == 4) __builtin_amdgcn_global_load_lds((const unsigned*)(ltk + base) + lane * 4, (LAS unsigned*)slot, 16, 0, 0);
        else if (wid == 5) __builtin_amdgcn_global_load_lds((const unsigned*)(lf + base) + lane * 4, (LAS unsigned*)(slot + 1024), 16, 0, 0); }
    __device__ __forceinline__ unsigned row_off_lds(const Unit& u, int r, LAS unsigned char* lds) const {
        if (!gather) return (unsigned)(u.tile * 256 + r) * (unsigned)a_row;
        const volatile LAS int* ls = (const volatile LAS int*)(lds + LS_OFF + u.slot * 2048); const int tk = (r < u.cnt) ? ls[r] : 0; return (unsigned)(tk >> 1) * (unsigned)a_row; }
    __device__ __forceinline__ bool next(int i, Unit& u) const {
        const int L0 = i * G + c; if (L0 >= nunits) return false;
        const int L = xcd_remap(L0, nunits);
        const int tile = L / nN; u.pn = L % nN;
        const int e = __builtin_amdgcn_readfirstlane(tpre[T2E + tile]);
        u.e = e; u.pm = tile - __builtin_amdgcn_readfirstlane(tpre[e]); u.cnt = __builtin_amdgcn_readfirstlane(tpre[40 + e]) - u.pm * 256;
        u.B = B + (size_t)e * b_exp + (size_t)u.pn * b_tile; u.tile = tile;
        u.A = A; return true; }
    __device__ __forceinline__ unsigned row_off(const Unit& u, int r) const {
        if (!gather) return (unsigned)(u.tile * 256 + r) * (unsigned)a_row;
        const int idx = u.pm * 256 + r; const int tk = (r < u.cnt) ? ltk[(size_t)u.e * LCAP + idx] : 0; return (unsigned)(tk >> 1) * (unsigned)a_row; }
};

template <class Epi, class Sched, bool GATHER, int KMID>
__device__ __forceinline__ void gemm_simple(unsigned lda_b, unsigned ldb_b, int K, const Sched& S, const Epi& E) {
    const int tid = threadIdx.x, wid = tid >> 6, lane = tid & 63, wr = wid >> 2, wc = wid & 3, fr = lane & 15, fq = lane >> 4;
    for (int i = 0;; ++i) {
        Unit u; if (!S.next(i, u)) break;
        f32x4 acc[2][2][4][2];
#pragma unroll
        for (int a = 0; a < 2; ++a)
#pragma unroll
            for (int b = 0; b < 2; ++b)
#pragma unroll
                for (int m = 0; m < 4; ++m)
#pragma unroll
                    for (int n = 0; n < 2; ++n) acc[a][b][m][n] = (f32x4){0.f, 0.f, 0.f, 0.f};
        unsigned aoff[2][4], boff[2][2];
#pragma unroll
        for (int a = 0; a < 2; ++a)
#pragma unroll
            for (int m = 0; m < 4; ++m) { const int r = 128 * a + 64 * wr + 16 * m + fr; aoff[a][m] = (GATHER ? S.row_off(u, r) : (unsigned)r * lda_b) + fq * 16; }
#pragma unroll
        for (int b = 0; b < 2; ++b)
#pragma unroll
            for (int n = 0; n < 2; ++n) { const int wrow = 128 * b + 32 * wc + perm32(16 * n + fr); boff[b][n] = (unsigned)wrow * ldb_b + fq * 16; }
#define GS_KLOOP(k0, k1) _Pragma("unroll 1") for (int k = (k0); k < (k1); k += 32) { \
            bf16x8 av[2][4], bv[2][2]; \
            _Pragma("unroll") for (int a = 0; a < 2; ++a) _Pragma("unroll") for (int m = 0; m < 4; ++m) av[a][m] = *(const bf16x8*)(u.A + aoff[a][m] + k * 2); \
            _Pragma("unroll") for (int b = 0; b < 2; ++b) _Pragma("unroll") for (int n = 0; n < 2; ++n) bv[b][n] = *(const bf16x8*)(u.B + boff[b][n] + k * 2); \
            _Pragma("unroll") for (int a = 0; a < 2; ++a) _Pragma("unroll") for (int b = 0; b < 2; ++b) _Pragma("unroll") for (int m = 0; m < 4; ++m) _Pragma("unroll") for (int n = 0; n < 2; ++n) \
                acc[a][b][m][n] = __builtin_amdgcn_mfma_f32_16x16x32_bf16(bv[b][n], av[a][m], acc[a][b][m][n], 0, 0, 0); }
        if (KMID > 0) { GS_KLOOP(0, KMID) E.mid(acc, u, wr, wc, fr, fq); GS_KLOOP(KMID, K) } else { GS_KLOOP(0, K) }
#undef GS_KLOOP
        E(acc, u, wr, wc, fr, fq);
    }
}


constexpr int HTB = 128 * 64 * 2;
__device__ __forceinline__ int lds_byte(int r, int c) { const int st = (r >> 4) * 2 + (c >> 5), rr = r & 15, cc = c & 31, ob = rr * 64 + cc * 2; return st * 1024 + (ob ^ (((ob >> 9) & 1) << 5)); }
__device__ __forceinline__ void stage_rc(int b, int& R, int& C) { const int st = b / 1024, sb = b % 1024, swz = sb ^ (((sb >> 9) & 1) << 5); R = (st >> 1) * 16 + swz / 64; C = (st & 1) * 32 + (swz % 64) / 2; }

typedef int v8i32 __attribute__((ext_vector_type(8)));
typedef int v4i32 __attribute__((ext_vector_type(4)));
template <class Epi, class Sched, bool GATHER, int KMID, bool F8 = false>
__device__ __forceinline__ void gemm_phase(LAS unsigned char* lds, unsigned lda_b, unsigned ldb_b, int K  , const Sched& S, const Epi& E) {
    const int tid = threadIdx.x, wid = __builtin_amdgcn_readfirstlane(tid >> 6), lane = tid & 63, wr = wid >> 2, wc = wid & 3, fr = lane & 15, fq = lane >> 4;
    const int nt = K / 64;
    unsigned voffB[2], vA[2][2];
#pragma unroll
    for (int i = 0; i < 2; ++i) { int R, C; stage_rc(tid * 16 + i * 8192, R, C); const int Rb = (R & ~31) + perm32(R & 31);
        voffB[i] = (unsigned)Rb * ldb_b + (unsigned)C * 2u; vA[0][i] = (unsigned)R * lda_b + (unsigned)C * 2u; vA[1][i] = vA[0][i]; }
    const size_t kstep = 128;
    const size_t hstepA = GATHER ? 0 : (size_t)128 * lda_b, hstepB = (size_t)128 * ldb_b;
    const unsigned ldsw = (unsigned)wid * 1024u;
    const int aoff = lds_byte(wr * 64 + fr, fq * 8), boff = lds_byte(wc * 32 + fr, fq * 8);
#define PG8_SA(b, h) (((b) * 2 + (h)) * HTB)
#define PG8_SB(b, h) ((4 + (b) * 2 + (h)) * HTB)
#define PG8_STAGE(bufoff, gbase, voff) do { _Pragma("unroll") for (int _i = 0; _i < 2; ++_i) \
        __builtin_amdgcn_global_load_lds((const unsigned*)((const char*)(gbase) + (voff)[_i]), (LAS unsigned*)(lds + (bufoff) + ldsw + _i * 8192), 16, 0, 0); } while (0)
#define PG8_STAGE_A(bufoff, gbase, h) PG8_STAGE(bufoff, (gbase) + (h) * hstepA, vA[GATHER ? (h) : 0])
#define PG8_LDA(dst, b, h) do { _Pragma("unroll") for (int m = 0; m < 4; ++m) { if constexpr (F8) { const v4i32 _l = *(const LAS v4i32*)(lds + PG8_SA(b, h) + aoff + m * 2048), _h = *(const LAS v4i32*)(lds + PG8_SA(b, h) + aoff + m * 2048 + 1024); \
            dst##8[m] = __builtin_shufflevector(_l, _h, 0, 1, 2, 3, 4, 5, 6, 7); } else { _Pragma("unroll") for (int k = 0; k < 2; ++k) dst[m][k] = *(const LAS bf16x8*)(lds + PG8_SA(b, h) + aoff + m * 2048 + k * 1024); } } } while (0)
#define PG8_LDB(dst, b, h) do { _Pragma("unroll") for (int n = 0; n < 2; ++n) { if constexpr (F8) { const v4i32 _l = *(const LAS v4i32*)(lds + PG8_SB(b, h) + boff + n * 2048), _h = *(const LAS v4i32*)(lds + PG8_SB(b, h) + boff + n * 2048 + 1024); \
            dst##8[n] = __builtin_shufflevector(_l, _h, 0, 1, 2, 3, 4, 5, 6, 7); } else { _Pragma("unroll") for (int k = 0; k < 2; ++k) dst[n][k] = *(const LAS bf16x8*)(lds + PG8_SB(b, h) + boff + n * 2048 + k * 1024); } } } while (0)
#define PG8_MMA(ai, bj, At, Bt) do { __builtin_amdgcn_s_setprio(1); _Pragma("unroll") for (int m = 0; m < 4; ++m) _Pragma("unroll") for (int n = 0; n < 2; ++n) { \
        if constexpr (F8)   \
            asm volatile("v_mfma_scale_f32_16x16x128_f8f6f4 %0, %1, %2, %0, %3, %3 op_sel_hi:[0,0,0]" : "+v"(acc[ai][bj][m][n]) : "v"(Bt##8[n]), "v"(At##8[m]), "v"(f8_unit_scale));   \
        else { _Pragma("unroll") for (int k = 0; k < 2; ++k) acc[ai][bj][m][n] = __builtin_amdgcn_mfma_f32_16x16x32_bf16(Bt[n][k], At[m][k], acc[ai][bj][m][n], 0, 0, 0); } } \
        __builtin_amdgcn_s_setprio(0); } while (0)
#define PG8_WAIT_V(n) asm volatile("s_waitcnt vmcnt(" #n ")" ::: "memory")
#define PG8_WAIT_L(n) asm volatile("s_waitcnt lgkmcnt(" #n ")" ::: "memory")
#define PG8_BAR __builtin_amdgcn_s_barrier()
#define PG8_SCHED __builtin_amdgcn_sched_barrier(0)
    Unit cur, nxt; int ui = 0;
    if (!S.next(0, cur)) return;
    f32x4 acc[2][2][4][2];
#pragma unroll
    for (int a = 0; a < 2; ++a)
#pragma unroll
        for (int b = 0; b < 2; ++b)
#pragma unroll
            for (int m = 0; m < 4; ++m)
#pragma unroll
                for (int n = 0; n < 2; ++n) acc[a][b][m][n] = (f32x4){0.f, 0.f, 0.f, 0.f};
    const int f8_unit_scale = 0x7f7f7f7f;
    bf16x8 At[4][2], B0[2][2], B1[2][2]; v8i32 At8[4], B08[2], B18[2];
    const char* cA = cur.A; const char* cB = cur.B;
    if constexpr (GATHER) {
#pragma unroll
        for (int h = 0; h < 2; ++h)
#pragma unroll
            for (int i = 0; i < 2; ++i) { int R, C; stage_rc(tid * 16 + i * 8192, R, C); vA[h][i] = S.row_off(cur, h * 128 + R) + (unsigned)C * 2u; }
        cur.slot = 0; S.stage_lists(cur, lds, wid);
    }
    PG8_STAGE(PG8_SB(0, 0), cB, voffB); PG8_STAGE(PG8_SB(0, 1), cB + hstepB, voffB); PG8_STAGE_A(PG8_SA(0, 0), cA, 0); PG8_STAGE_A(PG8_SA(0, 1), cA, 1);
    if (wr == 1) PG8_BAR;
    PG8_WAIT_V(2); PG8_BAR;
    PG8_STAGE(PG8_SB(1, 0), cB + kstep, voffB); PG8_STAGE_A(PG8_SA(1, 0), cA + kstep, 0); PG8_STAGE(PG8_SB(1, 1), cB + hstepB + kstep, voffB);
    PG8_WAIT_V(6); PG8_BAR;
    for (;;) {
        const bool has_next = S.next(ui + 1, nxt);
        const char* nA = has_next ? nxt.A : cA; const char* nB = has_next ? nxt.B : cB;
        if constexpr (GATHER) { nxt.slot = (ui + 1) & 1; if (has_next) S.stage_lists(nxt, lds, wid); }
#pragma unroll 1
        for (int t = 0; t < nt; t += 2) {
            const bool last = (t == nt - 2);
            const char* a1 = cA + (size_t)(t + 1) * kstep;
            const char* a2 = last ? nA : cA + (size_t)(t + 2) * kstep; const char* b2 = last ? nB : cB + (size_t)(t + 2) * kstep;
            const char* a3 = a2 + kstep; const char* b3 = b2 + kstep;
            if (KMID > 0 && t == KMID / 64) E.mid(acc, cur, wr, wc, fr, fq);
            asm volatile("" : "+v"(voffB[0]), "+v"(voffB[1]), "+v"(vA[0][0]), "+v"(vA[0][1]), "+v"(vA[1][0]), "+v"(vA[1][1]));
            PG8_LDB(B0, 0, 0); PG8_LDB(B1, 0, 1); PG8_SCHED; PG8_LDA(At, 0, 0); PG8_STAGE_A(PG8_SA(1, 1), a1, 1);
            if constexpr (GATHER) { if (last && has_next) { int tz = tid; asm volatile("" : "+v"(tz));
#pragma unroll
                for (int h = 0; h < 2; ++h)
#pragma unroll
                    for (int i = 0; i < 2; ++i) { int R, C; stage_rc(tz * 16 + i * 8192, R, C); vA[h][i] = S.row_off_lds(nxt, h * 128 + R, lds) + (unsigned)C * 2u; } } }
            PG8_WAIT_V(8); PG8_WAIT_L(0); PG8_BAR; PG8_MMA(0, 0, At, B0); PG8_MMA(0, 1, At, B1); PG8_BAR; PG8_SCHED;
            PG8_LDA(At, 0, 1); PG8_STAGE(PG8_SB(0, 0), b2, voffB); PG8_STAGE(PG8_SB(0, 1), b2 + hstepB, voffB); PG8_STAGE_A(PG8_SA(0, 0), a2, 0);
            PG8_WAIT_V(8); PG8_WAIT_L(0); PG8_BAR; PG8_MMA(1, 0, At, B0); PG8_MMA(1, 1, At, B1); PG8_BAR; PG8_SCHED;
            PG8_LDB(B0, 1, 0); PG8_LDB(B1, 1, 1); PG8_SCHED; PG8_LDA(At, 1, 0); PG8_STAGE_A(PG8_SA(0, 1), a2, 1);
            PG8_WAIT_V(8); PG8_WAIT_L(0); PG8_BAR; PG8_MMA(0, 0, At, B0); PG8_MMA(0, 1, At, B1); PG8_BAR; PG8_SCHED;
            PG8_LDA(At, 1, 1); PG8_STAGE(PG8_SB(1, 0), b3, voffB); PG8_STAGE(PG8_SB(1, 1), b3 + hstepB, voffB); PG8_STAGE_A(PG8_SA(1, 0), a3, 0);
            PG8_WAIT_V(8); PG8_WAIT_L(0); PG8_BAR; PG8_MMA(1, 0, At, B0); PG8_MMA(1, 1, At, B1); PG8_BAR; PG8_SCHED;
        }
        if (wr == 0) PG8_BAR;
        { int tz = threadIdx.x; asm volatile("" : "+v"(tz));
          E(acc, cur, wr, wc, tz & 15, (tz & 63) >> 4); }
        if (!has_next) break;
#pragma unroll
        for (int a = 0; a < 2; ++a)
#pragma unroll
            for (int b = 0; b < 2; ++b)
#pragma unroll
                for (int m = 0; m < 4; ++m)
#pragma unroll
                    for (int n = 0; n < 2; ++n) acc[a][b][m][n] = (f32x4){0.f, 0.f, 0.f, 0.f};
        cur = nxt; cA = nA; cB = nB; ++ui;
        if (wr == 1) PG8_BAR;
    }
    PG8_WAIT_V(0);
    PG8_BAR;
#undef PG8_SA
#undef PG8_SB
#undef PG8_STAGE
#undef PG8_STAGE_A
#undef PG8_LDA
#undef PG8_LDB
#undef PG8_MMA
#undef PG8_WAIT_V
#undef PG8_WAIT_L
#undef PG8_BAR
#undef PG8_SCHED
}

struct EpiStoreBf16 {
    bf16_t* O; int ldc;
    __device__ __forceinline__ void mid(f32x4 (&)[2][2][4][2], const Unit&, int, int, int, int) const {}
    __device__ __forceinline__ void operator()(const f32x4 (&acc)[2][2][4][2], const Unit& u, int wr, int wc, int fr, int fq) const {
        const int row0 = u.pm * 256 + wr * 64 + fr, col0 = u.pn * 256 + wc * 32 + 8 * fq;
        if (u.pn >= C_GA / 256) {
#pragma unroll
            for (int ai = 0; ai < 2; ++ai)
#pragma unroll
                for (int m = 0; m < 4; ++m) { bf16_t* rowp = O + (size_t)(row0 + ai * 128 + m * 16) * ldc + col0; float rt[8], sb[8];
#pragma unroll
                    for (int j = 0; j < 8; ++j) { const float ea = __builtin_amdgcn_exp2f(fminf(-1.4426950408889634f * acc[ai][0][m][j >> 2][j & 3], 80.f)), eb = __builtin_amdgcn_exp2f(fminf(-1.4426950408889634f * acc[ai][1][m][j >> 2][j & 3], 80.f));
                        rt[j] = (1.0f + eb) * __builtin_amdgcn_rcpf(1.0f + ea); sb[j] = __builtin_amdgcn_rcpf(1.0f + eb); }
                    u32x4 w; w.x = cvt_pk_bf16(rt[0], rt[1]); w.y = cvt_pk_bf16(rt[2], rt[3]); w.z = cvt_pk_bf16(rt[4], rt[5]); w.w = cvt_pk_bf16(rt[6], rt[7]);
                    *(u32x4*)(rowp) = w;
                    w.x = cvt_pk_bf16(sb[0], sb[1]); w.y = cvt_pk_bf16(sb[2], sb[3]); w.z = cvt_pk_bf16(sb[4], sb[5]); w.w = cvt_pk_bf16(sb[6], sb[7]);
                    *(u32x4*)(rowp + 128) = w; }
            return; }
#pragma unroll
        for (int ai = 0; ai < 2; ++ai)
#pragma unroll
            for (int m = 0; m < 4; ++m) { bf16_t* rowp = O + (size_t)(row0 + ai * 128 + m * 16) * ldc + col0;
#pragma unroll
                for (int bj = 0; bj < 2; ++bj) { const f32x4 v0 = acc[ai][bj][m][0], v1 = acc[ai][bj][m][1];
                    u32x4 w; w.x = cvt_pk_bf16(v0[0], v0[1]); w.y = cvt_pk_bf16(v0[2], v0[3]); w.z = cvt_pk_bf16(v1[0], v1[1]); w.w = cvt_pk_bf16(v1[2], v1[3]);
                    *(u32x4*)(rowp + bj * 128) = w; } }
    }
};

__device__ __forceinline__ void unpack8(const u32x4 w, float (&f)[8]) {
    f[0] = __uint_as_float(w.x << 16); f[1] = __uint_as_float(w.x & 0xffff0000u); f[2] = __uint_as_float(w.y << 16); f[3] = __uint_as_float(w.y & 0xffff0000u);
    f[4] = __uint_as_float(w.z << 16); f[5] = __uint_as_float(w.z & 0xffff0000u); f[6] = __uint_as_float(w.w << 16); f[7] = __uint_as_float(w.w & 0xffff0000u);
}

struct EpiMerge {
    bf16_t* O; const bf16_t* proj;
    __device__ __forceinline__ void mid(f32x4 (&acc)[2][2][4][2], const Unit& u, int wr, int wc, int fr, int fq) const {
        const int row0 = u.pm * 256 + wr * 64 + fr, gcol = C_GA + u.pn * 512 + wc * 32 + 8 * fq;
        u32x4 ra[4][2];
#define EM_LOAD(gq) do { int rr = row0 + ((gq) >> 2) * 128 + ((gq) & 3) * 16; asm volatile("" : "+v"(rr)); const bf16_t* rowp = proj + (size_t)rr * DIN + gcol; \
            ra[(gq) & 3][0] = *(const u32x4*)(rowp); ra[(gq) & 3][1] = *(const u32x4*)(rowp + 256); } while (0)
        EM_LOAD(0); EM_LOAD(1); EM_LOAD(2);
#pragma unroll
        for (int grp = 0; grp < 8; ++grp) { const int ai = grp >> 2, m = grp & 3, cb = grp & 3;
            if (grp + 3 < 8) EM_LOAD(grp + 3);
            asm volatile("" ::: "memory");
#pragma unroll
            for (int bj = 0; bj < 2; ++bj) { float rt[8]; unpack8(ra[cb][bj], rt);
#pragma unroll
                for (int j = 0; j < 8; ++j) acc[ai][bj][m][j >> 2][j & 3] *= rt[j]; }
            asm volatile("" ::: "memory"); }
#undef EM_LOAD
    }
    __device__ __forceinline__ void operator()(const f32x4 (&acc)[2][2][4][2], const Unit& u, int wr, int wc, int fr, int fq) const {
        const int row0 = u.pm * 256 + wr * 64 + fr, col0 = u.pn * 256 + wc * 32 + 8 * fq, gcol = C_GA + u.pn * 512 + wc * 32 + 8 * fq + 128;
        u32x4 rb[4][2];
#define EM_LOAD(gq) do { int rr = row0 + ((gq) >> 2) * 128 + ((gq) & 3) * 16; asm volatile("" : "+v"(rr)); const bf16_t* rowp = proj + (size_t)rr * DIN + gcol; \
            rb[(gq) & 3][0] = *(const u32x4*)(rowp); rb[(gq) & 3][1] = *(const u32x4*)(rowp + 256); } while (0)
        EM_LOAD(0); EM_LOAD(1); EM_LOAD(2);
#pragma unroll
        for (int grp = 0; grp < 8; ++grp) { const int ai = grp >> 2, m = grp & 3, cb = grp & 3;
            if (grp + 3 < 8) EM_LOAD(grp + 3);
            asm volatile("" ::: "memory");
            const size_t r = (size_t)(row0 + ai * 128 + m * 16);
#pragma unroll
            for (int bj = 0; bj < 2; ++bj) { float sb[8], v[8]; unpack8(rb[cb][bj], sb);
#pragma unroll
                for (int j = 0; j < 8; ++j) v[j] = acc[ai][bj][m][j >> 2][j & 3] * sb[j];
                u32x4 w; w.x = cvt_pk_bf16(v[0], v[1]); w.y = cvt_pk_bf16(v[2], v[3]); w.z = cvt_pk_bf16(v[4], v[5]); w.w = cvt_pk_bf16(v[6], v[7]);
                *(u32x4*)(O + r * D + col0 + bj * 128) = w; }
            asm volatile("" ::: "memory"); }
#undef EM_LOAD
    }
};

struct EpiResid {
    bf16_t* O; const float* x; unsigned char* O8;
    __device__ __forceinline__ void mid(f32x4 (&)[2][2][4][2], const Unit&, int, int, int, int) const {}
    __device__ __forceinline__ void operator()(const f32x4 (&acc)[2][2][4][2], const Unit& u, int wr, int wc, int fr, int fq) const {
        const int row0 = u.pm * 256 + wr * 64 + fr, col0 = u.pn * 256 + wc * 32 + 8 * fq;
        f32x4 xr[4][4];
#define ER_LOAD(gq) do { int rr = row0 + ((gq) >> 2) * 128 + ((gq) & 3) * 16; asm volatile("" : "+v"(rr)); const float* xp = x + (size_t)rr * D + col0; \
            xr[(gq) & 3][0] = *(const f32x4*)(xp); xr[(gq) & 3][1] = *(const f32x4*)(xp + 4); xr[(gq) & 3][2] = *(const f32x4*)(xp + 128); xr[(gq) & 3][3] = *(const f32x4*)(xp + 132); } while (0)
        ER_LOAD(0); ER_LOAD(1); ER_LOAD(2);
#pragma unroll
        for (int grp = 0; grp < 8; ++grp) { const int ai = grp >> 2, m = grp & 3, cb = grp & 3;
            if (grp + 3 < 8) ER_LOAD(grp + 3);
            asm volatile("" ::: "memory");
            const size_t r = (size_t)(row0 + ai * 128 + m * 16);
#pragma unroll
            for (int bj = 0; bj < 2; ++bj) { const f32x4 v0 = acc[ai][bj][m][0] + xr[cb][2 * bj], v1 = acc[ai][bj][m][1] + xr[cb][2 * bj + 1];
                u32x4 w; w.x = cvt_pk_bf16(v0[0], v0[1]); w.y = cvt_pk_bf16(v0[2], v0[3]); w.z = cvt_pk_bf16(v1[0], v1[1]); w.w = cvt_pk_bf16(v1[2], v1[3]);
                *(u32x4*)(O + r * D + col0 + bj * 128) = w;
                *(u32x2*)(O8 + r * D + col0 + bj * 128) = (u32x2){pack4_fp8(v0[0], v0[1], v0[2], v0[3]), pack4_fp8(v1[0], v1[1], v1[2], v1[3])}; }
            asm volatile("" ::: "memory"); }
#undef ER_LOAD
    }
};

struct EpiAct {
    bf16_t* act; const volatile LAS int* tpre;
    __device__ __forceinline__ void mid(f32x4 (&)[2][2][4][2], const Unit&, int, int, int, int) const {}
    __device__ __forceinline__ void operator()(const f32x4 (&acc)[2][2][4][2], const Unit& u, int wr, int wc, int fr, int fq) const {
        const int tile = __builtin_amdgcn_readfirstlane(tpre[u.e]) + u.pm; const int col0 = u.pn * 128 + wc * 32 + 8 * fq;
        int frl = fr; asm volatile("" : "+v"(frl));
        float rs[8];
        const volatile LAS float* lp = (const volatile LAS float*)tpre + ((LS_OFF - 140 * 1024) / 4 + u.slot * 512 + 256); const int last = (u.cnt < 256 ? u.cnt : 256) - 1;
#pragma unroll
        for (int i = 0; i < 8; ++i) { const int rr = (i >> 2) * 128 + wr * 64 + (i & 3) * 16 + frl; rs[i] = lp[rr < last ? rr : last]; }
#pragma unroll
        for (int i = 0; i < 8; ++i) { const int ai = i >> 2, m = i & 3, rr = ai * 128 + wr * 64 + m * 16 + frl;
            const float rstd = rs[i];
            float v[8];
#pragma unroll
            for (int j = 0; j < 8; ++j) { const float g = acc[ai][0][m][j >> 2][j & 3] * rstd, up = acc[ai][1][m][j >> 2][j & 3] * rstd; v[j] = g * up * __builtin_amdgcn_rcpf(1.0f + __builtin_amdgcn_exp2f(-1.4426950408889634f * g)); }
            *(u32x2*)((unsigned char*)act + ((size_t)tile * 256 + rr) * DE + col0) = (u32x2){pack4_fp8(v[0] * ACT_SCALE, v[1] * ACT_SCALE, v[2] * ACT_SCALE, v[3] * ACT_SCALE), pack4_fp8(v[4] * ACT_SCALE, v[5] * ACT_SCALE, v[6] * ACT_SCALE, v[7] * ACT_SCALE)}; }
    }
};

struct EpiDown {
    bf16_t* y; const volatile LAS int* tpre;
    __device__ __forceinline__ void mid(f32x4 (&)[2][2][4][2], const Unit&, int, int, int, int) const {}
    __device__ __forceinline__ void operator()(const f32x4 (&acc)[2][2][4][2], const Unit& u, int wr, int wc, int fr, int fq) const {
        const int col0 = u.pn * 256 + wc * 32 + 8 * fq;
        int frl = fr; asm volatile("" : "+v"(frl));
        int tk[8]; float wt[8];
        const volatile LAS int* ltk = tpre + ((LS_OFF - 140 * 1024) / 4 + u.slot * 512); const volatile LAS float* lw = (const volatile LAS float*)ltk + 256; const int last = (u.cnt < 256 ? u.cnt : 256) - 1;
#pragma unroll
        for (int i = 0; i < 8; ++i) { const int rr = (i >> 2) * 128 + wr * 64 + (i & 3) * 16 + frl; const int rc = rr < last ? rr : last; const int t = ltk[rc]; tk[i] = (rr <= last) ? t : Y_DUMMY_ROW;
            wt[i] = lw[rc] * (Y_SCALE / (ACT_SCALE * WD_SCALE)); }
#pragma unroll
        for (int i = 0; i < 8; ++i) { const int ai = i >> 2, m = i & 3;
#pragma unroll
            for (int bj = 0; bj < 2; ++bj) { const f32x4 v0 = acc[ai][bj][m][0] * wt[i], v1 = acc[ai][bj][m][1] * wt[i];
                *(u32x2*)((unsigned char*)y + (size_t)tk[i] * D + col0 + bj * 128) = (u32x2){pack4_fp8(v0[0], v0[1], v0[2], v0[3]), pack4_fp8(v1[0], v1[1], v1[2], v1[3])}; } }
    }
};

__device__ __forceinline__ void tr_tile8(const float* src, int ld_src, unsigned char* dst, int ld_dst, int k0, int n0, int drow0, const float* scale, float mul, LAS float* tile) {
    const int lane = threadIdx.x & 63, kq = lane >> 4, n4 = (lane & 15) * 4;
    f32x4 v[16];
#pragma unroll
    for (int it = 0; it < 16; ++it) v[it] = *(const f32x4*)(src + (size_t)(k0 + it * 4 + kq) * ld_src + n0 + n4);
#pragma unroll
    for (int it = 0; it < 16; ++it) { const int k = it * 4 + kq; const float s = (scale ? scale[k0 + k] : 1.0f) * mul;
        tile[k * 65 + n4 + 0] = v[it][0] * s; tile[k * 65 + n4 + 1] = v[it][1] * s; tile[k * 65 + n4 + 2] = v[it][2] * s; tile[k * 65 + n4 + 3] = v[it][3] * s; }
    __builtin_amdgcn_wave_barrier();
    const int kg = lane & 7;
#pragma unroll
    for (int it = 0; it < 8; ++it) { const int nn = (lane >> 3) + 8 * it; float f[8];
#pragma unroll
        for (int j = 0; j < 8; ++j) f[j] = tile[(kg * 8 + j) * 65 + nn];
        *(u32x2*)(dst + (size_t)(drow0 + nn) * ld_dst + k0 + kg * 8) = (u32x2){pack4_fp8(f[0], f[1], f[2], f[3]), pack4_fp8(f[4], f[5], f[6], f[7])}; }
    __builtin_amdgcn_wave_barrier();
}
__device__ __forceinline__ void tr_tile(const float* src, int ld_src, bf16_t* dst, int ld_dst, int k0, int n0, int drow0, const float* scale, LAS float* tile) {
    const int lane = threadIdx.x & 63, kq = lane >> 4, n4 = (lane & 15) * 4;
    f32x4 v[16];
#pragma unroll
    for (int it = 0; it < 16; ++it) v[it] = *(const f32x4*)(src + (size_t)(k0 + it * 4 + kq) * ld_src + n0 + n4);
#pragma unroll
    for (int it = 0; it < 16; ++it) { const int k = it * 4 + kq; const float s = scale ? scale[k0 + k] : 1.0f;
        tile[k * 65 + n4 + 0] = v[it][0] * s; tile[k * 65 + n4 + 1] = v[it][1] * s; tile[k * 65 + n4 + 2] = v[it][2] * s; tile[k * 65 + n4 + 3] = v[it][3] * s; }
    __builtin_amdgcn_wave_barrier();
    const int kg = lane & 7;
#pragma unroll
    for (int it = 0; it < 8; ++it) { const int nn = (lane >> 3) + 8 * it; float f[8];
#pragma unroll
        for (int j = 0; j < 8; ++j) f[j] = tile[(kg * 8 + j) * 65 + nn];
        u32x4 w; w.x = cvt_pk_bf16(f[0], f[1]); w.y = cvt_pk_bf16(f[2], f[3]); w.z = cvt_pk_bf16(f[4], f[5]); w.w = cvt_pk_bf16(f[6], f[7]);
        *(u32x4*)(dst + (size_t)(drow0 + nn) * ld_dst + k0 + kg * 8) = w; }
    __builtin_amdgcn_wave_barrier();
}

constexpr int T_IN = 16 * 96, T_UPA = 8 * 16, T_UPB = 16 * 16, T_OUT = 16 * 16, T_G = NE * 16 * 8, T_U = NE * 16 * 8, T_D = NE * 8 * 16;
constexpr int T_EARLY = T_IN + T_UPA + T_UPB + T_OUT, T_TOTAL = T_EARLY + T_G + T_U + T_D;
constexpr int CONV_TPT = 32, N_CONV_TASKS = (T_TOTAL - T_EARLY) / CONV_TPT;
__device__ __forceinline__ void conv_tile(const Params& P, LAS float* tile, int t) {
    unsigned char* ws = P.ws;
    int j = t;
    if (j < T_IN) { const int kt = j / 96, ntl = j % 96; const int n0 = ntl * 64;
        const int c = (n0 - C_GA) & 1023, drow = n0 < C_GA ? n0 : C_GA + 256 * (c >> 7) + (c & 127) + (n0 >= C_GB ? 128 : 0);
        tr_tile(P.w_in, DIN, (bf16_t*)(ws + WS_WIN), D, kt * 64, n0, drow, nullptr, tile); return; }
    j -= T_IN;
    if (j < T_UPA) { const int kt = j / 16, ntl = j % 16; tr_tile(P.w_up_a, D, (bf16_t*)(ws + WS_WUP), KUP, kt * 64, ntl * 64, ntl * 64, nullptr, tile); return; }
    j -= T_UPA;
    if (j < T_UPB) { const int kt = j / 16, ntl = j % 16; tr_tile(P.w_up_b, D, (bf16_t*)(ws + WS_WUP) + 512, KUP, kt * 64, ntl * 64, ntl * 64, nullptr, tile); return; }
    j -= T_UPB;
    if (j < T_OUT) { const int kt = j / 16, ntl = j % 16; tr_tile(P.w_out, D, (bf16_t*)(ws + WS_WOUT), D, kt * 64, ntl * 64, ntl * 64, nullptr, tile); return; }
    j -= T_OUT;
    if (j < T_G + T_U) { const bool up = j >= T_G; if (up) j -= T_G; const int e = j / 128, r = j % 128, kt = r % 16, ntl = r / 16; const int c0 = ntl * 64;
        const int drow = (c0 >> 7) * 256 + (c0 & 127) + (up ? 128 : 0);
        tr_tile8((up ? P.w_up : P.w_gate) + (size_t)e * D * DE, DE, (unsigned char*)(ws + WS_WGU) + (size_t)e * 1024 * D, D, kt * 64, c0, drow, P.norm2_g, WGU_SCALE, tile); return; }
    j -= T_G + T_U;
    { const int e = j / 128, r = j % 128, kt = r % 8, ntl = r / 8;
      tr_tile8(P.w_down + (size_t)e * DE * D, D, (unsigned char*)(ws + WS_WD) + (size_t)e * D * DE, DE, kt * 64, ntl * 64, ntl * 64, nullptr, WD_SCALE, tile); }
}

__device__ void p0_prologue(const Params& P, LAS unsigned char* lds, int bid, int nb) {
    const int tid = threadIdx.x, wid = tid >> 6, lane = tid & 63;
    unsigned char* ws = P.ws;
    LAS float* tile = (LAS float*)lds;
    for (int t = bid * 8 + wid; t < T_EARLY; t += nb * 8) conv_tile(P, tile + wid * (64 * 65), t);
    __syncthreads();
    { LAS float* hm = (LAS float*)lds;
      LAS float* red = (LAS float*)(lds + 65536);
      float* projm = (float*)(ws + WS_PROJM); bf16_t* metat = (bf16_t*)(ws + WS_METAT);
      bool have = false;
      for (int cg = nb - 1 - bid; cg < DIN / 64; cg += nb) {
          if (!have) { __syncthreads();
              for (int r = wid; r < NMETA; r += 8) { const float* mr = P.meta + (size_t)r * D; float ss = 0.f;
                  for (int k = lane; k < D; k += 64) { const float v = mr[k]; ss += v * v; }
                  ss = wave_sum(ss); const float rstd = rsqrtf(ss * (1.0f / D) + EPS);
                  for (int k = lane; k < D; k += 64) hm[r * D + k] = mr[k] * rstd * P.norm1_g[k]; }
              have = true; __syncthreads(); }
          const int c = tid & 63, ks = tid >> 6; float a[16];
#pragma unroll
          for (int r = 0; r < 16; ++r) a[r] = 0.f;
#pragma unroll 1
          for (int k0 = ks * 128; k0 < ks * 128 + 128; k0 += 8) { float w[8];
#pragma unroll
              for (int q = 0; q < 8; ++q) w[q] = P.w_in[(size_t)(k0 + q) * DIN + cg * 64 + c];
#pragma unroll
              for (int q = 0; q < 8; ++q)
#pragma unroll
                  for (int r = 0; r < 16; ++r) a[r] += hm[r * D + k0 + q] * w[q]; }
#pragma unroll
          for (int r = 0; r < 16; ++r) red[(ks * 16 + r) * 64 + c] = a[r];
          __syncthreads();
          for (int o = tid; o < 16 * 64; o += NTHREADS) { const int r = o >> 6, cc = o & 63; float s = 0.f;
#pragma unroll
              for (int q = 0; q < 8; ++q) s += red[(q * 16 + r) * 64 + cc];
              projm[(size_t)r * DIN + cg * 64 + cc] = s; metat[(size_t)(48 + r) * DIN + cg * 64 + cc] = f2bf(s); }
          for (int o = tid; o < 48 * 64; o += NTHREADS) { const int r = o >> 6, col = cg * 64 + (o & 63); metat[(size_t)r * DIN + col] = (col >= C_F && col < C_F + DHG) ? (bf16_t)0x42A0 : (bf16_t)0; }
          __syncthreads(); } }
    { bf16_t* hn = (bf16_t*)(ws + WS_HN);
      f32x4 gq[4];
#pragma unroll
      for (int q = 0; q < 4; ++q) gq[q] = *(const f32x4*)(P.norm1_g + 256 * q + 4 * lane);
      volatile LAS int* shq = (volatile LAS int*)(lds + 141 * 1024 + 64); int* rq = (int*)(ws + WS_CTL + CTL_CNT + 128 + 8);
      for (;;) { __syncthreads(); if (tid == 0) shq[0] = atomicAdd(rq, 1); __syncthreads(); const int grp = __builtin_amdgcn_readfirstlane(shq[0]); if (grp >= NTOK / 32) break;
          const int r0 = grp * 32 + wid * 4;
          f32x4 v[4][4];
#pragma unroll
          for (int rr = 0; rr < 4; ++rr)
#pragma unroll
              for (int q = 0; q < 4; ++q) v[rr][q] = *(const f32x4*)(P.x + (size_t)(r0 + rr) * D + 256 * q + 4 * lane);
#pragma unroll
          for (int rr = 0; rr < 4; ++rr) { float ss = 0.f;
#pragma unroll
              for (int q = 0; q < 4; ++q) ss += v[rr][q][0] * v[rr][q][0] + v[rr][q][1] * v[rr][q][1] + v[rr][q][2] * v[rr][q][2] + v[rr][q][3] * v[rr][q][3];
              ss = wave_sum(ss); const float rstd = rsqrtf(ss * (1.0f / D) + EPS);
#pragma unroll
              for (int q = 0; q < 4; ++q) { const f32x4 o = v[rr][q] * rstd * gq[q];
                  *(u32x2*)(hn + (size_t)(r0 + rr) * D + 256 * q + 4 * lane) = (u32x2){cvt_pk_bf16(o[0], o[1]), cvt_pk_bf16(o[2], o[3])}; } } } }
    { float* lb = (float*)(ws + WS_LB);
      for (int d = bid * NTHREADS + tid; d < DHG; d += nb * NTHREADS) lb[d] = sigmoidf_(P.hg_lb[d] - P.hg_lb[DHG + d]);
      bf16_t* wrt = (bf16_t*)(ws + WS_WR);
      for (int o = bid * NTHREADS + tid; o < 48 * D; o += nb * NTHREADS) { const int j = o / D, k = o % D; float v = 0.f;
          { const int nt = j >> 4, g = (j >> 2) & 3, jj = j & 3;
            if (nt < 2) v = P.w_router[((size_t)g * D + k) * 8 + nt * 4 + jj] * P.norm2_g[k];
            else if (jj == 0) v = P.w_group[(size_t)k * 4 + g] * P.norm2_g[k]; }
          wrt[o] = f2bf(v); }
    }
}

__device__ __forceinline__ float ldproj(const Params& P, int b, int s, int col) {
    if (s < NMETA) return ((const float*)(P.ws + WS_PROJM))[(size_t)s * DIN + col];
    return bf2f(((const bf16_t*)(P.ws + WS_PROJ))[((size_t)b * SEQ + (s - NMETA)) * DIN + col]);
}

__device__ void hgrn_simple(const Params& P, LAS unsigned char* lds, int unit) {
    constexpr int TC = 32;
    const int tid = threadIdx.x, wid = tid >> 6, lane = tid & 63, b = unit >> 2, h = unit & 3, v = tid & 127, dg = tid >> 7;
    LAS float* fb = (LAS float*)lds; LAS float* kb = fb + TC * 128; LAS float* qb = kb + TC * 128; LAS float* vb = qb + TC * 128; LAS float* op = vb + TC * 128;
    const float* lbp = (const float*)(P.ws + WS_LB);
    bf16_t* oab = (bf16_t*)P.out;
    float S[32];
#pragma unroll
    for (int j = 0; j < 32; ++j) S[j] = 0.f;
    for (int c0 = 0; c0 < TSEQ; c0 += TC) {
        const int len = (TSEQ - c0) < TC ? (TSEQ - c0) : TC;
        __syncthreads();
        for (int idx = tid; idx < len * 128; idx += NTHREADS) { const int t = idx >> 7, d = idx & 127, s = c0 + t;
            const float q = ldproj(P, b, s, C_Q + h * 128 + d), fp = ldproj(P, b, s, C_F + h * 128 + d), iv = ldproj(P, b, s, C_I + h * 128 + d);
            const float lb = lbp[h * 128 + d];
            fb[idx] = lb + (1.0f - lb) * sigmoidf_(fp); kb[idx] = (1.0f - lb) * sigmoidf_(-fp); qb[idx] = q; vb[idx] = iv; }
        __syncthreads();
        for (int t = 0; t < len; ++t) { const float vv = vb[t * 128 + v]; float o = 0.f;
#pragma unroll
            for (int j4 = 0; j4 < 8; ++j4) { const f32x4 f4 = *(const LAS f32x4*)(fb + t * 128 + dg * 32 + j4 * 4), k4 = *(const LAS f32x4*)(kb + t * 128 + dg * 32 + j4 * 4), q4 = *(const LAS f32x4*)(qb + t * 128 + dg * 32 + j4 * 4);
#pragma unroll
                for (int j = 0; j < 4; ++j) { S[j4 * 4 + j] = f4[j] * S[j4 * 4 + j] + k4[j] * vv; o += S[j4 * 4 + j] * q4[j]; } }
            op[(t * 4 + dg) * 128 + v] = o; }
        __syncthreads();
        for (int t = wid; t < len; t += 8) { const int s = c0 + t; if (s < NMETA) continue;
            const float o0 = op[(t * 4 + 0) * 128 + lane] + op[(t * 4 + 1) * 128 + lane] + op[(t * 4 + 2) * 128 + lane] + op[(t * 4 + 3) * 128 + lane];
            const float o1 = op[(t * 4 + 0) * 128 + lane + 64] + op[(t * 4 + 1) * 128 + lane + 64] + op[(t * 4 + 2) * 128 + lane + 64] + op[(t * 4 + 3) * 128 + lane + 64];
            const float ss = wave_sum(o0 * o0 + o1 * o1); const float rstd = rsqrtf(ss * (1.0f / 128.0f) + EPS);
            const size_t row = (size_t)b * SEQ + (s - NMETA);
            const float g0 = P.hg_norm_g[h * 128 + lane], g1 = P.hg_norm_g[h * 128 + lane + 64];
            const float og0 = ldproj(P, b, s, C_OG + h * 128 + lane), og1 = ldproj(P, b, s, C_OG + h * 128 + lane + 64);
            oab[row * KUP + h * 128 + lane] = f2bf(o0 * rstd * g0 * sigmoidf_(og0));
            oab[row * KUP + h * 128 + lane + 64] = f2bf(o1 * rstd * g1 * sigmoidf_(og1)); }
    }
}

__device__ void lru_simple(const Params& P, LAS unsigned char* lds, int unit) {
    constexpr int TC = 64;
    const int tid = threadIdx.x, b = unit >> 3, n = unit & 7, c = tid & 127, tq = tid >> 7, ch = n * 128 + c;
    LAS float* xin = (LAS float*)lds;
    LAS float* xc = xin + (TC + 3) * 128;
    LAS float* ab = xc + TC * 128;
    LAS float* ub = ab + TC * 128;
    bf16_t* oab = (bf16_t*)P.out;
    const float cw0 = P.conv_w[0 * D + ch], cw1 = P.conv_w[1 * D + ch], cw2 = P.conv_w[2 * D + ch], cw3 = P.conv_w[3 * D + ch], cb = P.conv_b[ch];
    const float br = P.b_r[ch], bi = P.b_i[ch];
    const float lamv = P.lam[ch]; const float sp = (lamv > 15.f) ? __expf(-lamv) : log1pf(__expf(-lamv));
    const float* wr = P.w_r + (size_t)n * 128 * 128; const float* wi = P.w_i + (size_t)n * 128 * 128;
    float hcar = 0.f;
    for (int c0 = 0; c0 < TSEQ; c0 += TC) {
        const int len = (TSEQ - c0) < TC ? (TSEQ - c0) : TC;
        __syncthreads();
        for (int idx = tid; idx < (len + 3) * 128; idx += NTHREADS) { const int t = idx >> 7, cc = idx & 127, s = c0 + t - 3;
            xin[idx] = (s >= 0) ? ldproj(P, b, s, C_LX + n * 128 + cc) : 0.f; }
        __syncthreads();
        for (int t = tq; t < len; t += 4) xc[t * 128 + c] = cw0 * xin[t * 128 + c] + cw1 * xin[(t + 1) * 128 + c] + cw2 * xin[(t + 2) * 128 + c] + cw3 * xin[(t + 3) * 128 + c] + cb;
        __syncthreads();
        { float ra[16], ia[16];
#pragma unroll
          for (int j = 0; j < 16; ++j) { ra[j] = 0.f; ia[j] = 0.f; }
          for (int i4 = 0; i4 < 128; i4 += 4) { float w_r4[4], w_i4[4];
#pragma unroll
              for (int q = 0; q < 4; ++q) { w_r4[q] = wr[(size_t)(i4 + q) * 128 + c]; w_i4[q] = wi[(size_t)(i4 + q) * 128 + c]; }
#pragma unroll
              for (int j = 0; j < 16; ++j) { const f32x4 xv = *(const LAS f32x4*)(xc + (tq * 16 + j) * 128 + i4);
#pragma unroll
                  for (int q = 0; q < 4; ++q) { ra[j] += xv[q] * w_r4[q]; ia[j] += xv[q] * w_i4[q]; } } }
#pragma unroll
          for (int j = 0; j < 16; ++j) { const int t = tq * 16 + j; const float r = sigmoidf_(ra[j] + br), ig = sigmoidf_(ia[j] + bi);
              const float log_a = -8.0f * r * sp; const float a = __expf(log_a); const float u = sqrtf(-expm1f(2.0f * log_a)) * (ig * xc[t * 128 + c]);
              ab[t * 128 + c] = a; ub[t * 128 + c] = u; } }
        __syncthreads();
        if (tid < 128) { float hh = hcar; for (int t = 0; t < len; ++t) { hh = ab[t * 128 + c] * hh + ub[t * 128 + c]; ub[t * 128 + c] = hh; } hcar = hh; }
        __syncthreads();
        for (int idx = tid; idx < len * 128; idx += NTHREADS) { const int t = idx >> 7, cc = idx & 127, s = c0 + t; if (s < NMETA) continue;
            const float y = ldproj(P, b, s, C_LY + n * 128 + cc);
            oab[((size_t)b * SEQ + (s - NMETA)) * KUP + 512 + n * 128 + cc] = f2bf(ub[idx] * gelu_tanh(y)); }
    }
}


#define BAR_LDS() do { asm volatile("s_waitcnt lgkmcnt(0)" ::: "memory"); __builtin_amdgcn_s_barrier(); asm volatile("" ::: "memory"); } while (0)

constexpr int LT = 272;
__device__ __forceinline__ const bf16_t* seq_row(const Params& P, int b, int c, int t) {
    return c == 0 ? (const bf16_t*)(P.ws + WS_METAT) + (size_t)t * DIN : (const bf16_t*)(P.ws + WS_PROJ) + ((size_t)b * SEQ + (size_t)(c - 1) * 64 + t) * DIN;
}
__device__ __forceinline__ float bflo(unsigned w) { return __uint_as_float(w << 16); }
__device__ __forceinline__ float bfhi(unsigned w) { return __uint_as_float(w & 0xffff0000u); }

__device__ void lru_fast(const Params& P, LAS unsigned char* lds, int unit) {
    const int tid = threadIdx.x, wid = __builtin_amdgcn_readfirstlane(tid >> 6), lane = tid & 63, b = unit >> 3, n = unit & 7, fr = lane & 15, g = lane >> 4;
    constexpr int TP = 136;
    constexpr int XA_B = 64 * LT, CT_B = 128 * TP, SET_B = XA_B + 3 * CT_B;
    static_assert(2 * SET_B <= 140 * 1024, "LRU tiles exceed the LDS budget");
    bf16_t* oab = (bf16_t*)P.out;
    const int chg = n * 128 + wid * 16 + fr;
    const float LOG2E = 1.4426950408889634f;
    const float nbr = -P.b_r[chg] * LOG2E, nbi = -P.b_i[chg] * LOG2E;
    const float lamv = P.lam[chg]; const float c2 = -8.0f * LOG2E * ((lamv > 15.f) ? __expf(-lamv) : log1pf(__expf(-lamv)));
    const int chc = n * 128 + 2 * lane;
    const f32x2 cw0 = *(const f32x2*)(P.conv_w + 0 * D + chc), cw1 = *(const f32x2*)(P.conv_w + 1 * D + chc), cw2 = *(const f32x2*)(P.conv_w + 2 * D + chc), cw3 = *(const f32x2*)(P.conv_w + 3 * D + chc),
                cbv = *(const f32x2*)(P.conv_b + chc);
    float carry = 0.f;
    unsigned xl[11], yl[8];
    unsigned lxo = (unsigned)(C_LX + n * 128 + 2 * lane) * 2u, lyo = (unsigned)(C_LY + n * 128 + 2 * lane) * 2u;
#define LRU_PREFETCH(c) do { const char* r0 = (const char*)seq_row(P, b, (c), wid * 8);        \
        _Pragma("unroll") for (int q = 0; q < 8; ++q) { xl[3 + q] = *(const unsigned*)(r0 + (lxo + (unsigned)q * (DIN * 2u))); yl[q] = *(const unsigned*)(r0 + (lyo + (unsigned)q * (DIN * 2u))); } \
        if (wid > 0) { const char* rm = r0 - 3 * (DIN * 2); _Pragma("unroll") for (int q = 0; q < 3; ++q) xl[q] = *(const unsigned*)(rm + (lxo + (unsigned)q * (DIN * 2u))); } \
        else if ((c) > 0) { const char* rh = (const char*)seq_row(P, b, (c) - 1, 61); _Pragma("unroll") for (int q = 0; q < 3; ++q) xl[q] = *(const unsigned*)(rh + (lxo + (unsigned)q * (DIN * 2u))); } \
        else { xl[0] = 0u; xl[1] = 0u; xl[2] = 0u; } } while (0)
    BAR_LDS();
    LRU_PREFETCH(0);
    bf16x8 Br[4], Bi[4];
    { const float* wr = P.w_r + (size_t)n * 128 * 128 + wid * 16 + fr; const float* wi = P.w_i + (size_t)n * 128 * 128 + wid * 16 + fr;
#pragma unroll
      for (int ks = 0; ks < 4; ++ks) { unsigned pr[4], pi[4];
#pragma unroll
          for (int j = 0; j < 4; ++j) { const int i0 = 32 * ks + 8 * g + 2 * j;
              pr[j] = cvt_pk_bf16(wr[(size_t)i0 * 128], wr[(size_t)(i0 + 1) * 128]); pi[j] = cvt_pk_bf16(wi[(size_t)i0 * 128], wi[(size_t)(i0 + 1) * 128]); }
          u32x4 tr = {pr[0], pr[1], pr[2], pr[3]}, ti = {pi[0], pi[1], pi[2], pi[3]};
          Br[ks] = __builtin_bit_cast(bf16x8, tr); Bi[ks] = __builtin_bit_cast(bf16x8, ti); } }
    { LAS unsigned char* XAw = lds; LAS unsigned char* XTw = XAw + XA_B; LAS unsigned char* YTw = XTw + CT_B;
        { f32x2 xv[11];
#pragma unroll
          for (int q = 0; q < 11; ++q) xv[q] = (f32x2){bflo(xl[q]), bfhi(xl[q])};
          unsigned xp[8];
#pragma unroll
          for (int q = 0; q < 8; ++q) { const f32x2 v = cw0 * xv[q] + cw1 * xv[q + 1] + cw2 * xv[q + 2] + cw3 * xv[q + 3] + cbv; xp[q] = cvt_pk_bf16(v[0], v[1]);
              *(LAS unsigned*)(XAw + (wid * 8 + q) * LT + lane * 4) = xp[q]; }
          u32x4 x0, x1, y0, y1;
          x0.x = __builtin_amdgcn_perm(xp[1], xp[0], 0x05040100u); x0.y = __builtin_amdgcn_perm(xp[3], xp[2], 0x05040100u); x0.z = __builtin_amdgcn_perm(xp[5], xp[4], 0x05040100u); x0.w = __builtin_amdgcn_perm(xp[7], xp[6], 0x05040100u);
          x1.x = __builtin_amdgcn_perm(xp[1], xp[0], 0x07060302u); x1.y = __builtin_amdgcn_perm(xp[3], xp[2], 0x07060302u); x1.z = __builtin_amdgcn_perm(xp[5], xp[4], 0x07060302u); x1.w = __builtin_amdgcn_perm(xp[7], xp[6], 0x07060302u);
          y0.x = __builtin_amdgcn_perm(yl[1], yl[0], 0x05040100u); y0.y = __builtin_amdgcn_perm(yl[3], yl[2], 0x05040100u); y0.z = __builtin_amdgcn_perm(yl[5], yl[4], 0x05040100u); y0.w = __builtin_amdgcn_perm(yl[7], yl[6], 0x05040100u);
          y1.x = __builtin_amdgcn_perm(yl[1], yl[0], 0x07060302u); y1.y = __builtin_amdgcn_perm(yl[3], yl[2], 0x07060302u); y1.z = __builtin_amdgcn_perm(yl[5], yl[4], 0x07060302u); y1.w = __builtin_amdgcn_perm(yl[7], yl[6], 0x07060302u);
          *(LAS u32x2*)(XTw + (2 * lane) * TP + wid * 16) = (u32x2){x0.x, x0.y}; *(LAS u32x2*)(XTw + (2 * lane) * TP + wid * 16 + 8) = (u32x2){x0.z, x0.w};
          *(LAS u32x2*)(XTw + (2 * lane + 1) * TP + wid * 16) = (u32x2){x1.x, x1.y}; *(LAS u32x2*)(XTw + (2 * lane + 1) * TP + wid * 16 + 8) = (u32x2){x1.z, x1.w};
          *(LAS u32x2*)(YTw + (2 * lane) * TP + wid * 16) = (u32x2){y0.x, y0.y}; *(LAS u32x2*)(YTw + (2 * lane) * TP + wid * 16 + 8) = (u32x2){y0.z, y0.w};
          *(LAS u32x2*)(YTw + (2 * lane + 1) * TP + wid * 16) = (u32x2){y1.x, y1.y}; *(LAS u32x2*)(YTw + (2 * lane + 1) * TP + wid * 16 + 8) = (u32x2){y1.z, y1.w}; }
    }
    LRU_PREFETCH(1);
    BAR_LDS();
    for (int c = 0; c < 33; ++c) {
        asm volatile("" : "+v"(lxo), "+v"(lyo));
        LAS unsigned char* XAr = lds + (c & 1) * SET_B; LAS unsigned char* XTr = XAr + XA_B; LAS unsigned char* YTr = XTr + CT_B; LAS unsigned char* OTr = YTr + CT_B;
        if (c + 1 < 33) { LAS unsigned char* XAw = lds + ((c + 1) & 1) * SET_B; LAS unsigned char* XTw = XAw + XA_B; LAS unsigned char* YTw = XTw + CT_B;
        { f32x2 xv[11];
#pragma unroll
          for (int q = 0; q < 11; ++q) xv[q] = (f32x2){bflo(xl[q]), bfhi(xl[q])};
          unsigned xp[8];
#pragma unroll
          for (int q = 0; q < 8; ++q) { const f32x2 v = cw0 * xv[q] + cw1 * xv[q + 1] + cw2 * xv[q + 2] + cw3 * xv[q + 3] + cbv; xp[q] = cvt_pk_bf16(v[0], v[1]);
              *(LAS unsigned*)(XAw + (wid * 8 + q) * LT + lane * 4) = xp[q]; }
          u32x4 x0, x1, y0, y1;
          x0.x = __builtin_amdgcn_perm(xp[1], xp[0], 0x05040100u); x0.y = __builtin_amdgcn_perm(xp[3], xp[2], 0x05040100u); x0.z = __builtin_amdgcn_perm(xp[5], xp[4], 0x05040100u); x0.w = __builtin_amdgcn_perm(xp[7], xp[6], 0x05040100u);
          x1.x = __builtin_amdgcn_perm(xp[1], xp[0], 0x07060302u); x1.y = __builtin_amdgcn_perm(xp[3], xp[2], 0x07060302u); x1.z = __builtin_amdgcn_perm(xp[5], xp[4], 0x07060302u); x1.w = __builtin_amdgcn_perm(xp[7], xp[6], 0x07060302u);
          y0.x = __builtin_amdgcn_perm(yl[1], yl[0], 0x05040100u); y0.y = __builtin_amdgcn_perm(yl[3], yl[2], 0x05040100u); y0.z = __builtin_amdgcn_perm(yl[5], yl[4], 0x05040100u); y0.w = __builtin_amdgcn_perm(yl[7], yl[6], 0x05040100u);
          y1.x = __builtin_amdgcn_perm(yl[1], yl[0], 0x07060302u); y1.y = __builtin_amdgcn_perm(yl[3], yl[2], 0x07060302u); y1.z = __builtin_amdgcn_perm(yl[5], yl[4], 0x07060302u); y1.w = __builtin_amdgcn_perm(yl[7], yl[6], 0x07060302u);
          *(LAS u32x2*)(XTw + (2 * lane) * TP + wid * 16) = (u32x2){x0.x, x0.y}; *(LAS u32x2*)(XTw + (2 * lane) * TP + wid * 16 + 8) = (u32x2){x0.z, x0.w};
          *(LAS u32x2*)(XTw + (2 * lane + 1) * TP + wid * 16) = (u32x2){x1.x, x1.y}; *(LAS u32x2*)(XTw + (2 * lane + 1) * TP + wid * 16 + 8) = (u32x2){x1.z, x1.w};
          *(LAS u32x2*)(YTw + (2 * lane) * TP + wid * 16) = (u32x2){y0.x, y0.y}; *(LAS u32x2*)(YTw + (2 * lane) * TP + wid * 16 + 8) = (u32x2){y0.z, y0.w};
          *(LAS u32x2*)(YTw + (2 * lane + 1) * TP + wid * 16) = (u32x2){y1.x, y1.y}; *(LAS u32x2*)(YTw + (2 * lane + 1) * TP + wid * 16 + 8) = (u32x2){y1.z, y1.w}; }
            if (c + 2 < 33) LRU_PREFETCH(c + 2); }
        {
            f32x4 ar[4], ai[4];
#pragma unroll
            for (int m = 0; m < 4; ++m) { ar[m] = (f32x4){0.f, 0.f, 0.f, 0.f}; ai[m] = (f32x4){0.f, 0.f, 0.f, 0.f}; }
#pragma unroll
            for (int ks = 0; ks < 4; ++ks)
#pragma unroll
                for (int m = 0; m < 4; ++m) { const bf16x8 af = *(const LAS bf16x8*)(XAr + (16 * (fr >> 2) + 4 * m + (fr & 3)) * LT + ks * 64 + g * 16);
                    ar[m] = __builtin_amdgcn_mfma_f32_16x16x32_bf16(af, Br[ks], ar[m], 0, 0, 0); ai[m] = __builtin_amdgcn_mfma_f32_16x16x32_bf16(af, Bi[ks], ai[m], 0, 0, 0); }
            f32x2 a2[4][2], u2[4][2], yg2[4][2];
#pragma unroll
            for (int m = 0; m < 4; ++m) {
                const u32x2 xw = *(const LAS u32x2*)(XTr + (wid * 16 + fr) * TP + (16 * g + 4 * m) * 2), yw = *(const LAS u32x2*)(YTr + (wid * 16 + fr) * TP + (16 * g + 4 * m) * 2);
#pragma unroll
                for (int p = 0; p < 2; ++p) {
                    const unsigned xwp = p ? xw.y : xw.x, ywp = p ? yw.y : yw.x;
                    const f32x2 xc = {bflo(xwp), bfhi(xwp)}, y = {bflo(ywp), bfhi(ywp)};
                    const f32x2 tr = (f32x2){ar[m][2 * p], ar[m][2 * p + 1]} * (-LOG2E) + nbr, ti = (f32x2){ai[m][2 * p], ai[m][2 * p + 1]} * (-LOG2E) + nbi;
                    f32x2 z = y * y; z = z * 0.044715f + 1.0f; z = z * y; z = z * (-2.0f * 0.7978845608028654f * LOG2E);
                    f32x2 er, ei, eg;
                    er[0] = __builtin_amdgcn_exp2f(fminf(tr[0], 40.f)); er[1] = __builtin_amdgcn_exp2f(fminf(tr[1], 40.f));
                    ei[0] = __builtin_amdgcn_exp2f(fminf(ti[0], 40.f)); ei[1] = __builtin_amdgcn_exp2f(fminf(ti[1], 40.f));
                    eg[0] = __builtin_amdgcn_exp2f(fminf(z[0], 40.f)); eg[1] = __builtin_amdgcn_exp2f(fminf(z[1], 40.f));
                    const f32x2 dr = er + 1.0f, di = ei + 1.0f, dg = eg + 1.0f;
                    const f32x2 pd = dr * di, pr = pd * dg;
                    f32x2 inv; inv[0] = __builtin_amdgcn_rcpf(pr[0]); inv[1] = __builtin_amdgcn_rcpf(pr[1]);
                    const f32x2 t1 = inv * dg, r = t1 * di, ig = t1 * dr, sg = inv * pd;
                    const f32x2 ea = r * c2;
                    f32x2 av; av[0] = __builtin_amdgcn_exp2f(ea[0]); av[1] = __builtin_amdgcn_exp2f(ea[1]);
                    const f32x2 om = 1.0f - av * av;
                    f32x2 sq; sq[0] = __builtin_amdgcn_sqrtf(fmaxf(om[0], 0.f)); sq[1] = __builtin_amdgcn_sqrtf(fmaxf(om[1], 0.f));
                    a2[m][p] = av; u2[m][p] = sq * (ig * xc); yg2[m][p] = y * sg; } }
            if (c == 0 && g < 3) {
#pragma unroll
                for (int m = 0; m < 4; ++m)
#pragma unroll
                    for (int p = 0; p < 2; ++p) { a2[m][p] = (f32x2){1.0f, 1.0f}; u2[m][p] = (f32x2){0.f, 0.f}; } }
            float A16 = 1.0f, U16 = 0.f;
#pragma unroll
            for (int m = 0; m < 4; ++m)
#pragma unroll
                for (int p = 0; p < 2; ++p) { U16 = a2[m][p][0] * U16 + u2[m][p][0]; A16 *= a2[m][p][0]; U16 = a2[m][p][1] * U16 + u2[m][p][1]; A16 *= a2[m][p][1]; }
            float H = carry, Hm = carry;
#pragma unroll
            for (int gg = 0; gg < 4; ++gg) { const float Ag = __shfl(A16, fr + 16 * gg), Ug = __shfl(U16, fr + 16 * gg); if (gg == g) Hm = H; H = Ag * H + Ug; }
            carry = H;
            float h = Hm;
#pragma unroll
            for (int m = 0; m < 4; ++m) {
                const float h0 = a2[m][0][0] * h + u2[m][0][0], h1 = a2[m][0][1] * h0 + u2[m][0][1], h2 = a2[m][1][0] * h1 + u2[m][1][0], h3 = a2[m][1][1] * h2 + u2[m][1][1]; h = h3;
                *(LAS u32x2*)(OTr + (wid * 16 + fr) * TP + (16 * g + 4 * m) * 2) = (u32x2){cvt_pk_bf16(h0 * yg2[m][0][0], h1 * yg2[m][0][1]), cvt_pk_bf16(h2 * yg2[m][1][0], h3 * yg2[m][1][1])}; }
        }
        BAR_LDS();
        if (c > 0) {
            const u32x2 o0a = *(const LAS u32x2*)(OTr + (2 * lane) * TP + wid * 16), o0b = *(const LAS u32x2*)(OTr + (2 * lane) * TP + wid * 16 + 8);
            const u32x2 o1a = *(const LAS u32x2*)(OTr + (2 * lane + 1) * TP + wid * 16), o1b = *(const LAS u32x2*)(OTr + (2 * lane + 1) * TP + wid * 16 + 8);
            const u32x4 o0 = {o0a.x, o0a.y, o0b.x, o0b.y}, o1 = {o1a.x, o1a.y, o1b.x, o1b.y};
            bf16_t* op = oab + ((size_t)b * SEQ + (size_t)(c - 1) * 64 + wid * 8) * KUP + 512 + n * 128 + 2 * lane;
            *(unsigned*)(op + 0 * KUP) = __builtin_amdgcn_perm(o1.x, o0.x, 0x05040100u); *(unsigned*)(op + 1 * KUP) = __builtin_amdgcn_perm(o1.x, o0.x, 0x07060302u);
            *(unsigned*)(op + 2 * KUP) = __builtin_amdgcn_perm(o1.y, o0.y, 0x05040100u); *(unsigned*)(op + 3 * KUP) = __builtin_amdgcn_perm(o1.y, o0.y, 0x07060302u);
            *(unsigned*)(op + 4 * KUP) = __builtin_amdgcn_perm(o1.z, o0.z, 0x05040100u); *(unsigned*)(op + 5 * KUP) = __builtin_amdgcn_perm(o1.z, o0.z, 0x07060302u);
            *(unsigned*)(op + 6 * KUP) = __builtin_amdgcn_perm(o1.w, o0.w, 0x05040100u); *(unsigned*)(op + 7 * KUP) = __builtin_amdgcn_perm(o1.w, o0.w, 0x07060302u); }
    }
#undef LRU_PREFETCH
}

constexpr int KEP = 144;
__device__ void hgrn_fast(const Params& P, LAS unsigned char* lds, int unit) {
    const int tid = threadIdx.x, wid = __builtin_amdgcn_readfirstlane(tid >> 6), lane = tid & 63, b = unit >> 2, h = unit & 3, fr = lane & 15, g = lane >> 4;
    LAS unsigned char* QG = lds;
    LAS unsigned char* KG = QG + 64 * LT;
    LAS unsigned char* VT = KG + 64 * LT;
    LAS unsigned char* KE = VT + 64 * LT;
    LAS unsigned char* PT = KE + 128 * KEP;
    LAS float* DEC = (LAS float*)(PT + 64 * KEP);
    LAS float* SEG = DEC + 128;
    LAS float* PART = SEG + 8 * 128;
    LAS unsigned char* OGT = (LAS unsigned char*)(PART + 64 * 8);
    LAS unsigned char* OUT = OGT + 64 * LT;
    bf16_t* oab = (bf16_t*)P.out;
    const float LOG2E = 1.4426950408889634f;
    const float* lbp = (const float*)(P.ws + WS_LB) + h * 128 + 2 * lane;
    const float lb0 = lbp[0], lb1 = lbp[1], om0 = 1.0f - lb0, om1 = 1.0f - lb1;
    int pos; { const int d = 2 * lane, kd = d >> 5, r = d & 31; pos = 32 * kd + 8 * ((r >> 2) & 3) + 4 * (r >> 4) + (r & 3); }
    const f32x4 ng = *(const f32x4*)(P.hg_norm_g + h * 128 + wid * 16 + 4 * g);
    f32x4 S[8];
#pragma unroll
    for (int db = 0; db < 8; ++db) S[db] = (f32x4){0.f, 0.f, 0.f, 0.f};
    unsigned qv[8], fv[8]; u32x4 vv[2], gv[2];
    unsigned hqo = (unsigned)(C_Q + h * 128 + 2 * lane) * 2u, hfo = (unsigned)(C_F + h * 128 + 2 * lane) * 2u;
    unsigned hvo = (unsigned)(C_I + h * 128 + (lane & 15) * 8) * 2u, hoo = (unsigned)(C_OG + h * 128 + (lane & 15) * 8) * 2u;
#define HG_PREFETCH(c) do { const char* r0 = (const char*)seq_row(P, b, (c), wid * 8); \
        _Pragma("unroll") for (int q = 0; q < 8; ++q) { qv[q] = *(const unsigned*)(r0 + (hqo + (unsigned)q * (DIN * 2u))); fv[q] = *(const unsigned*)(r0 + (hfo + (unsigned)q * (DIN * 2u))); } \
        const char* rv = (const char*)seq_row(P, b, (c), wid * 4); \
        _Pragma("unroll") for (int i = 0; i < 2; ++i) { vv[i] = *(const u32x4*)(rv + (hvo + (unsigned)(32 * i + (lane >> 4)) * (DIN * 2u))); gv[i] = *(const u32x4*)(rv + (hoo + (unsigned)(32 * i + (lane >> 4)) * (DIN * 2u))); } } while (0)
    BAR_LDS();
    HG_PREFETCH(0);
    for (int c = 0; c < 33; ++c) {
        asm volatile("" : "+v"(hqo), "+v"(hfo), "+v"(hvo), "+v"(hoo));
        float k0[8], k1[8], c0[8], c1[8];
        { float p0 = 1.0f, p1 = 1.0f;
#pragma unroll
          for (int q = 0; q < 8; ++q) { const float x0 = bflo(fv[q]), x1 = bfhi(fv[q]);
              const float e0 = __builtin_amdgcn_exp2f(fminf(-LOG2E * x0, 80.f)), e1 = __builtin_amdgcn_exp2f(fminf(-LOG2E * x1, 80.f));
              const float r0 = __builtin_amdgcn_rcpf(1.0f + e0), r1 = __builtin_amdgcn_rcpf(1.0f + e1);
              const float f0 = lb0 + om0 * r0, f1 = lb1 + om1 * r1;
              k0[q] = om0 * e0 * r0; k1[q] = om1 * e1 * r1;
              p0 *= f0; p1 *= f1; c0[q] = p0; c1[q] = p1; }
          *(LAS f32x2*)(SEG + wid * 128 + 2 * lane) = (f32x2){p0, p1}; }
        BAR_LDS();
        { float pre0 = 1.0f, pre1 = 1.0f, tot0 = 1.0f, tot1 = 1.0f;
#pragma unroll
          for (int w2 = 0; w2 < 8; ++w2) { const f32x2 sv = *(const LAS f32x2*)(SEG + w2 * 128 + 2 * lane); if (w2 < wid) { pre0 *= sv[0]; pre1 *= sv[1]; } tot0 *= sv[0]; tot1 *= sv[1]; }
          unsigned ke0[4], ke1[4]; float keb0 = 0.f, keb1 = 0.f;
#pragma unroll
          for (int q = 0; q < 8; ++q) { const float G0 = pre0 * c0[q], G1 = pre1 * c1[q];
              const float rg0 = __builtin_amdgcn_rcpf(G0), rg1 = __builtin_amdgcn_rcpf(G1);
              const float kg0 = k0[q] * rg0, kg1 = k1[q] * rg1;
              const int t = wid * 8 + q;
              *(LAS unsigned*)(QG + t * LT + pos * 2) = cvt_pk_bf16(bflo(qv[q]) * G0, bfhi(qv[q]) * G1);
              *(LAS unsigned*)(KG + t * LT + pos * 2) = cvt_pk_bf16(kg0, kg1);
              const float e0 = kg0 * tot0, e1 = kg1 * tot1;
              if (q & 1) { ke0[q >> 1] = cvt_pk_bf16(keb0, e0); ke1[q >> 1] = cvt_pk_bf16(keb1, e1); } else { keb0 = e0; keb1 = e1; } }
          *(LAS u32x4*)(KE + (2 * lane) * KEP + wid * 16) = (u32x4){ke0[0], ke0[1], ke0[2], ke0[3]};
          *(LAS u32x4*)(KE + (2 * lane + 1) * KEP + wid * 16) = (u32x4){ke1[0], ke1[1], ke1[2], ke1[3]};
          if (wid == 0) *(LAS f32x2*)(DEC + 2 * lane) = (f32x2){tot0, tot1};
#pragma unroll
          for (int i = 0; i < 2; ++i) { const int p = tid + NTHREADS * i; *(LAS u32x4*)(VT + (p >> 4) * LT + (p & 15) * 16) = vv[i]; *(LAS u32x4*)(OGT + (p >> 4) * LT + (p & 15) * 16) = gv[i];
              if (c >= 2) { const u32x4 ov4 = *(const LAS u32x4*)(OUT + (p >> 4) * LT + (p & 15) * 16);
                  *(u32x4*)(oab + ((size_t)b * SEQ + (size_t)(c - 2) * 64 + (p >> 4)) * KUP + h * 128 + (p & 15) * 8) = ov4; } } }
        BAR_LDS();
        if (c + 1 < 33) HG_PREFETCH(c + 1);
        if (c > 0) {
            const int tb = wid >> 1;
#pragma unroll
            for (int s2 = 0; s2 < 2; ++s2) { const int sb = 2 * (wid & 1) + s2; f32x4 pt = {0.f, 0.f, 0.f, 0.f};
#pragma unroll
                for (int kd = 0; kd < 4; ++kd) { const bf16x8 kf = *(const LAS bf16x8*)(KG + (16 * sb + fr) * LT + kd * 64 + g * 16), qf = *(const LAS bf16x8*)(QG + (16 * tb + fr) * LT + kd * 64 + g * 16);
                    pt = __builtin_amdgcn_mfma_f32_16x16x32_bf16(kf, qf, pt, 0, 0, 0); }
                const int tg = 16 * tb + fr, sg0 = 16 * sb + 4 * g;
                const float m0 = (sg0 + 0 <= tg) ? pt[0] : 0.f, m1 = (sg0 + 1 <= tg) ? pt[1] : 0.f, m2 = (sg0 + 2 <= tg) ? pt[2] : 0.f, m3 = (sg0 + 3 <= tg) ? pt[3] : 0.f;
                *(LAS u32x2*)(PT + tg * KEP + sg0 * 2) = (u32x2){cvt_pk_bf16(m0, m1), cvt_pk_bf16(m2, m3)}; } }
        BAR_LDS();
        bf16x8 Vf[2];
#pragma unroll
        for (int ks = 0; ks < 2; ++ks) { unsigned w4[4];
#pragma unroll
            for (int j = 0; j < 4; ++j) { const int s0 = 32 * ks + 8 * g + 2 * j;
                const unsigned lo = *(const LAS bf16_t*)(VT + s0 * LT + (wid * 16 + fr) * 2), hi = *(const LAS bf16_t*)(VT + (s0 + 1) * LT + (wid * 16 + fr) * 2);
                w4[j] = lo | (hi << 16); }
            u32x4 tv = {w4[0], w4[1], w4[2], w4[3]}; Vf[ks] = __builtin_bit_cast(bf16x8, tv); }
        f32x4 ov[4];
        if (c > 0) {
            bf16x8 Sf[4];
#pragma unroll
            for (int kd = 0; kd < 4; ++kd) { u32x4 tv = {cvt_pk_bf16(S[2 * kd][0], S[2 * kd][1]), cvt_pk_bf16(S[2 * kd][2], S[2 * kd][3]), cvt_pk_bf16(S[2 * kd + 1][0], S[2 * kd + 1][1]), cvt_pk_bf16(S[2 * kd + 1][2], S[2 * kd + 1][3])};
                Sf[kd] = __builtin_bit_cast(bf16x8, tv); }
#pragma unroll
            for (int m = 0; m < 4; ++m) { f32x4 o = {0.f, 0.f, 0.f, 0.f};
#pragma unroll
                for (int ks = 0; ks < 2; ++ks) { const bf16x8 pf = *(const LAS bf16x8*)(PT + (16 * m + fr) * KEP + ks * 64 + g * 16); o = __builtin_amdgcn_mfma_f32_16x16x32_bf16(Vf[ks], pf, o, 0, 0, 0); }
#pragma unroll
                for (int kd = 0; kd < 4; ++kd) { const bf16x8 qf = *(const LAS bf16x8*)(QG + (16 * m + fr) * LT + kd * 64 + g * 16); o = __builtin_amdgcn_mfma_f32_16x16x32_bf16(Sf[kd], qf, o, 0, 0, 0); }
                ov[m] = o; } }
#pragma unroll
        for (int db = 0; db < 8; ++db) { const f32x4 dc = *(const LAS f32x4*)(DEC + 16 * db + 4 * g); f32x4 sa = S[db] * dc;
#pragma unroll
            for (int ks = 0; ks < 2; ++ks) { const bf16x8 kf = *(const LAS bf16x8*)(KE + (16 * db + fr) * KEP + ks * 64 + g * 16); sa = __builtin_amdgcn_mfma_f32_16x16x32_bf16(kf, Vf[ks], sa, 0, 0, 0); }
            S[db] = sa; }
        if (c > 0) {
#pragma unroll
            for (int m = 0; m < 4; ++m) { float pq = ov[m][0] * ov[m][0] + ov[m][1] * ov[m][1] + ov[m][2] * ov[m][2] + ov[m][3] * ov[m][3];
                pq += __shfl_xor(pq, 16); pq += __shfl_xor(pq, 32);
                if (g == 0) PART[(16 * m + fr) * 8 + wid] = pq; } }
        BAR_LDS();
        if (c > 0) {
#pragma unroll
            for (int m = 0; m < 4; ++m) { const f32x4 pa = *(const LAS f32x4*)(PART + (16 * m + fr) * 8), pb = *(const LAS f32x4*)(PART + (16 * m + fr) * 8 + 4);
                const float ss = ((pa[0] + pa[1]) + (pa[2] + pa[3])) + ((pb[0] + pb[1]) + (pb[2] + pb[3]));
                const float rstd = rsqrtf(ss * (1.0f / 128.0f) + EPS);
                const u32x2 ogw = *(const LAS u32x2*)(OGT + (16 * m + fr) * LT + (wid * 16 + 4 * g) * 2);
                const float g0 = bflo(ogw.x), g1 = bfhi(ogw.x), g2 = bflo(ogw.y), g3 = bfhi(ogw.y);
                const float o0 = ov[m][0] * rstd * ng[0] * __builtin_amdgcn_rcpf(1.0f + __builtin_amdgcn_exp2f(-LOG2E * g0));
                const float o1 = ov[m][1] * rstd * ng[1] * __builtin_amdgcn_rcpf(1.0f + __builtin_amdgcn_exp2f(-LOG2E * g1));
                const float o2 = ov[m][2] * rstd * ng[2] * __builtin_amdgcn_rcpf(1.0f + __builtin_amdgcn_exp2f(-LOG2E * g2));
                const float o3 = ov[m][3] * rstd * ng[3] * __builtin_amdgcn_rcpf(1.0f + __builtin_amdgcn_exp2f(-LOG2E * g3));
                *(LAS u32x2*)(OUT + (16 * m + fr) * LT + (wid * 16 + 4 * g) * 2) = (u32x2){cvt_pk_bf16(o0, o1), cvt_pk_bf16(o2, o3)}; } }
    }
    BAR_LDS();
#pragma unroll
    for (int i = 0; i < 2; ++i) { const int p = tid + NTHREADS * i; const u32x4 ov4 = *(const LAS u32x4*)(OUT + (p >> 4) * LT + (p & 15) * 16);
        *(u32x4*)(oab + ((size_t)b * SEQ + (size_t)31 * 64 + (p >> 4)) * KUP + h * 128 + (p & 15) * 8) = ov4; }
#undef HG_PREFETCH
}

__device__ void p5_router_fast(const Params& P, LAS unsigned char* lds, int bid, int nb) {
    const int tid = threadIdx.x, wid = __builtin_amdgcn_readfirstlane(tid >> 6), lane = tid & 63, fr = lane & 15, g = lane >> 4;
    unsigned char* ws = P.ws;
    const bf16_t* h2 = (const bf16_t*)(ws + WS_H2); const bf16_t* wrt = (const bf16_t*)(ws + WS_WR);
    int* counts = (int*)(ws + WS_CTL + CTL_CNT); int* ltk = (int*)(ws + WS_LTK); float* lw = (float*)(ws + WS_LW);
    LAS int* lcnt = (LAS int*)lds; LAS int* lbase = lcnt + 32; LAS int* ae = lbase + 32; LAS int* al = ae + 512; LAS float* aw = (LAS float*)(al + 512); LAS float* ars = aw + 512;
    float* lrs = (float*)(ws + WS_LRS);
    const float bg = P.b_group[g];
    float br8[8];
#pragma unroll
    for (int e = 0; e < 8; ++e) br8[e] = P.b_router[g * 8 + e];
    __syncthreads();
    bool staged = false;
    for (int t0 = bid * 256; t0 < NTOK; t0 += nb * 256) {
        const bf16_t* ap = h2 + (size_t)(t0 + wid * 32 + fr) * D + g * 8;
        bf16x8 a0[8], a1[8], c0[8], c1[8];
#define RT_LOAD(A0, A1, k8) do { _Pragma("unroll") for (int q = 0; q < 8; ++q) { A0[q] = *(const bf16x8*)(ap + ((k8) + q) * 32); A1[q] = *(const bf16x8*)(ap + 16 * D + ((k8) + q) * 32); } } while (0)
        RT_LOAD(a0, a1, 0);
        if (!staged) { staged = true;
            for (int p = tid; p < 48 * 128; p += NTHREADS) { const int row = p >> 7, c16 = p & 127;
                *(LAS u32x4*)(lds + 12288 + row * 2064 + c16 * 16) = *(const u32x4*)(wrt + (size_t)row * D + c16 * 8); } }
        __syncthreads();
        if (tid < 32) lcnt[tid] = 0;
        __syncthreads();
        f32x4 acc[2][3];
#pragma unroll
        for (int tt = 0; tt < 2; ++tt)
#pragma unroll
            for (int nt = 0; nt < 3; ++nt) acc[tt][nt] = (f32x4){0.f, 0.f, 0.f, 0.f};
        LAS unsigned char* WL = lds + 12288;
        const LAS unsigned char* bl = WL + fr * 2064 + g * 16;
        float sq0 = 0.f, sq1 = 0.f;
#define SQ_ACC(sq, w) asm volatile("v_dot2c_f32_bf16 %0, %1, %1" : "+v"(sq) : "v"(w))
#define RT_COMP(A0, A1, k8) do { _Pragma("unroll") for (int q = 0; q < 8; ++q) { const int ks = (k8) + q; \
                const bf16x8 b0 = *(const LAS bf16x8*)(bl + ks * 64), b1 = *(const LAS bf16x8*)(bl + 16 * 2064 + ks * 64), b2 = *(const LAS bf16x8*)(bl + 32 * 2064 + ks * 64); \
                acc[0][0] = __builtin_amdgcn_mfma_f32_16x16x32_bf16(b0, A0[q], acc[0][0], 0, 0, 0); acc[0][1] = __builtin_amdgcn_mfma_f32_16x16x32_bf16(b1, A0[q], acc[0][1], 0, 0, 0); \
                acc[0][2] = __builtin_amdgcn_mfma_f32_16x16x32_bf16(b2, A0[q], acc[0][2], 0, 0, 0); acc[1][0] = __builtin_amdgcn_mfma_f32_16x16x32_bf16(b0, A1[q], acc[1][0], 0, 0, 0); \
                acc[1][1] = __builtin_amdgcn_mfma_f32_16x16x32_bf16(b1, A1[q], acc[1][1], 0, 0, 0); acc[1][2] = __builtin_amdgcn_mfma_f32_16x16x32_bf16(b2, A1[q], acc[1][2], 0, 0, 0); \
                { const u32x4 w0 = __builtin_bit_cast(u32x4, A0[q]), w1 = __builtin_bit_cast(u32x4, A1[q]); \
                  SQ_ACC(sq0, w0.x); SQ_ACC(sq0, w0.y); SQ_ACC(sq0, w0.z); SQ_ACC(sq0, w0.w); SQ_ACC(sq1, w1.x); SQ_ACC(sq1, w1.y); SQ_ACC(sq1, w1.z); SQ_ACC(sq1, w1.w); } } } while (0)
        RT_LOAD(c0, c1, 8); RT_COMP(a0, a1, 0); RT_LOAD(a0, a1, 16); RT_COMP(c0, c1, 8); RT_LOAD(c0, c1, 24); RT_COMP(a0, a1, 16); RT_COMP(c0, c1, 24);
#undef RT_LOAD
#undef RT_COMP
#undef SQ_ACC
        sq0 += __shfl_xor(sq0, 16); sq0 += __shfl_xor(sq0, 32); sq1 += __shfl_xor(sq1, 16); sq1 += __shfl_xor(sq1, 32);
#pragma unroll
        for (int tt = 0; tt < 2; ++tt) {
            const int tl = wid * 32 + tt * 16 + fr;
            const float rstd = rsqrtf((tt ? sq1 : sq0) * (1.0f / D) + EPS);
            const float mygl = acc[tt][2][0] * rstd + bg;
            float gl[4];
#pragma unroll
            for (int gg = 0; gg < 4; ++gg) gl[gg] = __shfl(mygl, fr + 16 * gg);
            int gs = 0; float gm = gl[0];
#pragma unroll
            for (int j = 1; j < 4; ++j) if (gl[j] > gm) { gm = gl[j]; gs = j; }
            float den = 0.f;
#pragma unroll
            for (int j = 0; j < 4; ++j) den += __expf(gl[j] - gm);
            const float psel = 1.0f / den;
            if (g == gs) {
                float el[8];
#pragma unroll
                for (int e = 0; e < 8; ++e) el[e] = acc[tt][e >> 2][e & 3] * rstd + br8[e];
                int i0 = 0; float v0 = el[0];
#pragma unroll
                for (int e = 1; e < 8; ++e) if (el[e] > v0) { v0 = el[e]; i0 = e; }
                int i1 = -1; float v1 = -3.0e38f;
#pragma unroll
                for (int e = 0; e < 8; ++e) if (e != i0 && el[e] > v1) { v1 = el[e]; i1 = e; }
                const float e1 = __expf(v1 - v0); const float w0 = psel / (1.0f + e1), w1 = psel * e1 / (1.0f + e1);
                const int ex0 = gs * 8 + i0, ex1 = gs * 8 + i1;
                ae[tl * 2] = ex0; al[tl * 2] = __hip_atomic_fetch_add(lcnt + ex0, 1, __ATOMIC_RELAXED, __HIP_MEMORY_SCOPE_WORKGROUP); aw[tl * 2] = w0; ars[tl * 2] = rstd * (1.0f / WGU_SCALE);
                ae[tl * 2 + 1] = ex1; al[tl * 2 + 1] = __hip_atomic_fetch_add(lcnt + ex1, 1, __ATOMIC_RELAXED, __HIP_MEMORY_SCOPE_WORKGROUP); aw[tl * 2 + 1] = w1; ars[tl * 2 + 1] = rstd * (1.0f / WGU_SCALE);
            }
        }
        __syncthreads();
        if (tid < 32) lbase[tid] = atomicAdd(counts + tid, lcnt[tid]);
        __syncthreads();
        { const int a = tid; const int e = ae[a]; const int pos = lbase[e] + al[a];
          ltk[(size_t)e * LCAP + pos] = (t0 + (a >> 1)) * 2 + (a & 1); lw[(size_t)e * LCAP + pos] = aw[a]; lrs[(size_t)e * LCAP + pos] = ars[a]; }
    }
}

__device__ void p8_final(const Params& P, int bid, int nb) {
    const int tid = threadIdx.x, wid = tid >> 6, lane = tid & 63;
    const bf16_t* h2 = (const bf16_t*)(P.ws + WS_H2); const unsigned char* yb = (const unsigned char*)(P.ws + WS_Y);
    f32x4 gq[4];
#pragma unroll
    for (int q = 0; q < 4; ++q) gq[q] = *(const f32x4*)(P.final_g + 256 * q + 4 * lane);
    for (int r0 = (bid * 8 + wid) * 4; r0 < NTOK; r0 += nb * 8 * 4) {
        u32x2 hv[4][4]; unsigned y0[4][4], y1[4][4];
#pragma unroll
        for (int rr = 0; rr < 4; ++rr) { const size_t r = (size_t)(r0 + rr);
#pragma unroll
            for (int q = 0; q < 4; ++q) { hv[rr][q] = *(const u32x2*)(h2 + r * D + 256 * q + 4 * lane);
                y0[rr][q] = *(const unsigned*)(yb + (r * 2) * D + 256 * q + 4 * lane); y1[rr][q] = *(const unsigned*)(yb + (r * 2 + 1) * D + 256 * q + 4 * lane); } }
#pragma unroll
        for (int rr = 0; rr < 4; ++rr) { f32x4 v[4]; float ss = 0.f;
#pragma unroll
            for (int q = 0; q < 4; ++q) {
                const f32x2 a01 = __builtin_amdgcn_cvt_pk_f32_fp8((int)y0[rr][q], false), a23 = __builtin_amdgcn_cvt_pk_f32_fp8((int)y0[rr][q], true), b01 = __builtin_amdgcn_cvt_pk_f32_fp8((int)y1[rr][q], false), b23 = __builtin_amdgcn_cvt_pk_f32_fp8((int)y1[rr][q], true);
                v[q][0] = bflo(hv[rr][q].x) + (a01[0] + b01[0]) * (1.0f / Y_SCALE); v[q][1] = bfhi(hv[rr][q].x) + (a01[1] + b01[1]) * (1.0f / Y_SCALE);
                v[q][2] = bflo(hv[rr][q].y) + (a23[0] + b23[0]) * (1.0f / Y_SCALE); v[q][3] = bfhi(hv[rr][q].y) + (a23[1] + b23[1]) * (1.0f / Y_SCALE);
                ss += v[q][0] * v[q][0] + v[q][1] * v[q][1] + v[q][2] * v[q][2] + v[q][3] * v[q][3]; }
            ss = wave_sum(ss); const float rstd = rsqrtf(ss * (1.0f / D) + EPS);
#pragma unroll
            for (int q = 0; q < 4; ++q) *(f32x4*)(P.out + (size_t)(r0 + rr) * D + 256 * q + 4 * lane) = v[q] * rstd * gq[q]; }
    }
}

__device__ __forceinline__ void moe_table(const Params& P, volatile LAS int* tpre) {
    if (threadIdx.x < 64) { const int lane = threadIdx.x; const int* counts = (const int*)(P.ws + WS_CTL + CTL_CNT);
        const int cnt = (lane < NE) ? counts[lane] : 0; const int nt = (cnt + 255) >> 8;
        int inc = nt;
#pragma unroll
        for (int o = 1; o < 32; o <<= 1) { const int v = __shfl_up(inc, o); if (lane >= o) inc += v; }
        if (lane < NE) { tpre[lane] = inc - nt; tpre[40 + lane] = cnt;
#pragma unroll 1
            for (int t = inc - nt; t < inc; ++t) tpre[T2E + t] = lane; }
        if (lane == NE - 1) tpre[NE] = inc; }
    __syncthreads();
}
}

__global__ void __launch_bounds__(NTHREADS, 2) fwd_kernel(Params P) {
    extern __shared__ __attribute__((aligned(16))) unsigned char lds_raw[];
    LAS unsigned char* lds = (LAS unsigned char*)lds_raw;
    const int bid = blockIdx.x, nb = gridDim.x;
    unsigned char* ws = P.ws;
    const int lo = P.ph_lo, hi = P.ph_hi;
    volatile LAS unsigned* xbw = (volatile LAS unsigned*)(lds + LDS_BYTES - 16);
    if (threadIdx.x == 0) { xbw[0] = 0u; xbw[1] = 0u; xbw[2] = 0u; xbw[3] = 0u; }
    __syncthreads();
    XcdBarrier bar; bar.bar = (unsigned*)(ws + WS_CTL + CTL_BAR); bar.x = 0; bar.st = xbw;
    if (hi - lo > 1) bar = xcd_barrier_post((unsigned*)(ws + WS_CTL + CTL_BAR), xbw);
#ifdef PROBE_MASK
    unsigned long long pr_t0 = __builtin_amdgcn_s_memrealtime();
#define SEAM(k) do { if ((PROBE_MASK >> (k)) & 1) { const unsigned long long t1 = __builtin_amdgcn_s_memrealtime(); const unsigned long long dt = t1 - pr_t0; \
        while (__builtin_amdgcn_s_memrealtime() - t1 < dt) __builtin_amdgcn_s_sleep(8); } \
        if (IN(k) && IN((k) + 1)) xcd_barrier(bar); pr_t0 = __builtin_amdgcn_s_memrealtime(); } while (0)
#else
#define SEAM(k) do { if (IN(k) && IN((k) + 1)) xcd_barrier(bar); } while (0)
#endif
#ifdef ONLY_PHASE
#define IN(k) ((k) == ONLY_PHASE && lo <= (k) && (k) < hi)
#else
#define IN(k) (lo <= (k) && (k) < hi)
#endif
    if (IN(0)) p0_prologue(P, lds, bid, nb);
    SEAM(0);
    if (IN(1)) { typedef DenseOrder<DIN / 256> DO1; DO1 S; S.init(ws + WS_HN, D * 2, ws + WS_WIN, D * 2, NTOK, DIN, nb, bid);
        EpiStoreBf16 E{(bf16_t*)(ws + WS_PROJ), DIN};
        if constexpr ((FAST_MASK >> 1) & 1) gemm_phase<EpiStoreBf16, DO1, false, 0>(lds, D * 2, D * 2, D, S, E); else gemm_simple<EpiStoreBf16, DO1, false, 0>(D * 2, D * 2, D, S, E); }
    SEAM(1);
    if (IN(2)) {
        if constexpr (((FAST_MASK >> 9) & 3) == 3) {
            volatile LAS int* shu = (volatile LAS int*)(lds + 141 * 1024);
            int* qhead = (int*)(ws + WS_CTL + CTL_CNT + 128);
            for (int u = bid;;) {
                if (u >= 128 + 256) break;
                const bool early = u >= 128;
                int nu = 0; if (early && threadIdx.x == 0) nu = nb + atomicAdd(qhead, 1);
#if defined(P2_REPEAT_H)
                if (u < 128) { hgrn_fast(P, lds, u); hgrn_fast(P, lds, u); } else lru_fast(P, lds, u - 128);
#elif defined(P2_REPEAT_L)
                if (u < 128) hgrn_fast(P, lds, u); else { lru_fast(P, lds, u - 128); lru_fast(P, lds, u - 128); }
#else
                if (u < 128) hgrn_fast(P, lds, u); else lru_fast(P, lds, u - 128);
#endif
                __syncthreads();
                if (threadIdx.x == 0) shu[0] = early ? nu : nb + atomicAdd(qhead, 1);
                __syncthreads();
                u = __builtin_amdgcn_readfirstlane(shu[0]); }
            for (;;) {
                __syncthreads();
                if (threadIdx.x == 0) shu[0] = atomicAdd(qhead + 1, 1);
                __syncthreads();
                const int task = __builtin_amdgcn_readfirstlane(shu[0]);
                if (task >= N_CONV_TASKS) break;
                const int wv = __builtin_amdgcn_readfirstlane(threadIdx.x >> 6);
#pragma unroll 1
                for (int q = wv * (CONV_TPT / 8); q < (wv + 1) * (CONV_TPT / 8); ++q) conv_tile(P, (LAS float*)lds + wv * (64 * 65), T_EARLY + task * CONV_TPT + q); }
        } else {
            for (int u = bid; u < 128 + 256; u += nb) {
                if (u < 128) { if constexpr ((FAST_MASK >> 10) & 1) hgrn_fast(P, lds, u); else hgrn_simple(P, lds, u); }
                else { if constexpr ((FAST_MASK >> 9) & 1) lru_fast(P, lds, u - 128); else lru_simple(P, lds, u - 128); } } } }
    SEAM(2);
    if (IN(3)) { typedef DenseOrder<D / 256> DO4; DO4 S; S.init(P.out, KUP * 2, ws + WS_WUP, KUP * 2, NTOK, D, nb, bid);
        EpiMerge E{(bf16_t*)(ws + WS_HN), (const bf16_t*)(ws + WS_PROJ)};
        if constexpr ((FAST_MASK >> 3) & 1) gemm_phase<EpiMerge, DO4, false, 512>(lds, KUP * 2, KUP * 2, KUP, S, E); else gemm_simple<EpiMerge, DO4, false, 512>(KUP * 2, KUP * 2, KUP, S, E); }
    SEAM(3);
    if (IN(4)) { typedef DenseOrder<D / 256> DO4; DO4 S; S.init(ws + WS_HN, D * 2, ws + WS_WOUT, D * 2, NTOK, D, nb, bid);
        EpiResid E{(bf16_t*)(ws + WS_H2), P.x, ws + WS_H2Q};
        if constexpr ((FAST_MASK >> 4) & 1) gemm_phase<EpiResid, DO4, false, 0>(lds, D * 2, D * 2, D, S, E); else gemm_simple<EpiResid, DO4, false, 0>(D * 2, D * 2, D, S, E); }
    SEAM(4);
    if (IN(5)) p5_router_fast(P, lds, bid, nb);
    SEAM(5);
    if (IN(6)) { volatile LAS int* tpre = (volatile LAS int*)(lds + 140 * 1024); __syncthreads(); moe_table(P, tpre);
        MoeOrder S; S.A = (const char*)(ws + WS_H2Q); S.B = (const char*)(ws + WS_WGU); S.ltk = (const int*)(ws + WS_LTK); S.lf = (const float*)(ws + WS_LRS); S.tpre = tpre; S.nN = 4; S.nunits = __builtin_amdgcn_readfirstlane(tpre[NE]) * 4; S.G = nb; S.c = bid;
        S.b_exp = (size_t)1024 * D; S.b_tile = (size_t)256 * D; S.a_row = D; S.gather = true;
        EpiAct E{(bf16_t*)(ws + WS_ACT), tpre};
        gemm_phase<EpiAct, MoeOrder, true, 0, true>(lds, D, D, D / 2, S, E); }
    SEAM(6);
    if (IN(7)) { volatile LAS int* tpre = (volatile LAS int*)(lds + 140 * 1024); __syncthreads(); moe_table(P, tpre);
        MoeOrder S; S.A = (const char*)(ws + WS_ACT); S.B = (const char*)(ws + WS_WD); S.ltk = (const int*)(ws + WS_LTK); S.lf = (const float*)(ws + WS_LW); S.tpre = tpre; S.nN = 4; S.nunits = __builtin_amdgcn_readfirstlane(tpre[NE]) * 4; S.G = nb; S.c = bid;
        S.b_exp = (size_t)D * DE; S.b_tile = (size_t)256 * DE; S.a_row = DE; S.gather = false;
        EpiDown E{(bf16_t*)(ws + WS_Y), tpre};
        gemm_phase<EpiDown, MoeOrder, true, 0, true>(lds, DE, DE, DE / 2, S, E); }
    SEAM(7);
    if (IN(8)) p8_final(P, bid, nb);
#ifdef PROBE_MASK
    SEAM(8);
#endif
#undef IN
#undef SEAM
}

extern "C" void kernel_launch(void* const* d_in, const int* in_sizes, int n_in, void* d_out, int out_size, void* d_ws, size_t ws_size, hipStream_t stream) {
    static int grid = 0;
    if (grid == 0) {
        if (n_in != 25 || in_sizes[0] != NTOK * D || out_size != NTOK * D || ws_size < WS_END) {
            fprintf(stderr, "kernel_launch: unexpected shapes (n_in %d, in0 %d, out %d, ws %zu < %zu); nothing launched\n", n_in, n_in > 0 ? in_sizes[0] : -1, out_size, ws_size, (size_t)WS_END); grid = -1; return; }
        int dev = 0, cus = 0;
        if (hipGetDevice(&dev) != hipSuccess || hipDeviceGetAttribute(&cus, hipDeviceAttributeMultiprocessorCount, dev) != hipSuccess) { grid = -1; return; }
        if (hipFuncSetAttribute((const void*)fwd_kernel, hipFuncAttributeMaxDynamicSharedMemorySize, LDS_BYTES) != hipSuccess) { fprintf(stderr, "kernel_launch: hipFuncSetAttribute failed\n"); grid = -1; return; }
        grid = cus;
    }
    if (grid < 0) return;
    (void)hipMemsetAsync((char*)d_ws + WS_CTL, 0, CTL_ZERO_BYTES, stream);
    Params p{};
    const float** f = (const float**)&p;
    for (int i = 0; i < 25; ++i) f[i] = (const float*)d_in[i];
    p.out = (float*)d_out; p.ws = (unsigned char*)d_ws;
#if NLAUNCH == 1
    p.ph_lo = 0; p.ph_hi = 9;
    hipLaunchKernelGGL(fwd_kernel, dim3(grid), dim3(NTHREADS), LDS_BYTES, stream, p);
#else
    for (int ph = 0; ph < 9; ++ph) { p.ph_lo = ph; p.ph_hi = ph + 1;
        hipLaunchKernelGGL(fwd_kernel, dim3(grid), dim3(NTHREADS), LDS_BYTES, stream, p); }
#endif
}
```
